# Optimizing an MI355X kernel written in HIP

```python
import jax
import jax.numpy as jnp
from jax import lax
import numpy as np

D_MODEL = 2048
BATCH = 2
SEQ = 4096
DEPTH = 1

GRID_W = 64
CTX_LEN = 256
GLA_HEADS = 4
GLA_DK = D_MODEL // 2 // GLA_HEADS
GLA_DV = D_MODEL // GLA_HEADS
GLA_GATE_RANK = 16
GLA_GATE_TEMP = 16.0
GLA_CHUNK = 64
NA_HEADS = 16
NA_DH = 64
NA_KR = 8
NA_KC = 16
D_FF = 256 * ((8 * D_MODEL // 3 + 255) // 256)
ROPE_THETA = 10000.0
EPS = 1e-6
NEG_INF = -1e30
QK_W = GLA_HEADS * GLA_DK
V_W = GLA_HEADS * GLA_DV
NA_W = NA_HEADS * NA_DH
IN_SPLITS = (QK_W, QK_W, V_W, V_W, GLA_GATE_RANK, GLA_GATE_RANK, NA_W, NA_W, NA_W, D_MODEL, D_MODEL)
IN_WIDTH = sum(IN_SPLITS)
SPLIT_AT = [int(s) for s in np.cumsum(IN_SPLITS)[:-1]]
N_MOD = 9

kernel_name = 'hybrid_gla_natten_macaron_dit_block'


def rmsnorm(x, g):
    xf = x.astype(jnp.float32)
    y = xf * lax.rsqrt(jnp.mean(xf * xf, axis=-1, keepdims=True) + EPS)
    return (y * g.astype(jnp.float32)).astype(x.dtype)


def modulate(x, mod, i, g):
    return rmsnorm(x, g) * (1 + mod[3 * i + 1]) + mod[3 * i]


def residual(x, y, mod, i, g, w):
    return x + w * mod[3 * i + 2] * rmsnorm(y, g)


def swiglu(h, wg, wu, wd):
    return (jax.nn.silu(h @ wg) * (h @ wu)) @ wd


def to_heads(a, n):
    b, t, _ = a.shape
    return a.reshape(b, t, n, -1).transpose(0, 2, 1, 3)


def from_heads(a):
    b, n, t, d = a.shape
    return a.transpose(0, 2, 1, 3).reshape(b, t, n * d)


def flip_t(a):
    return jnp.flip(a, axis=2)


def rope_axis(x, pos):
    half = x.shape[-1] // 2
    freqs = ROPE_THETA ** (-jnp.arange(half, dtype=jnp.float32) / half)
    ang = pos.astype(jnp.float32)[:, None] * freqs
    cos, sin = jnp.cos(ang), jnp.sin(ang)
    x1, x2 = x[..., :half], x[..., half:]
    return jnp.concatenate([x1 * cos - x2 * sin, x2 * cos + x1 * sin], axis=-1)


def rope_2d(x, row, col):
    h = x.shape[-1] // 2
    return jnp.concatenate([rope_axis(x[..., :h], row), rope_axis(x[..., h:], col)], axis=-1)


def gla_scan(q, k, v, log_a, s0):
    b, h, t, dk = q.shape
    dv = v.shape[-1]
    n = t // GLA_CHUNK
    rs = lambda a: a.reshape(b, h, n, GLA_CHUNK, a.shape[-1])
    q, k, v, log_a = rs(q), rs(k), rs(v), rs(log_a)
    cum = jnp.cumsum(log_a, axis=3)
    cum_last = cum[:, :, :, -1:, :]
    q_dec = q * jnp.exp(cum)
    k_inv = k * jnp.exp(-cum)
    k_to_end = k * jnp.exp(cum_last - cum)
    causal_in_chunk = jnp.tril(jnp.ones((GLA_CHUNK, GLA_CHUNK), dtype=bool))
    att = jnp.einsum('bhnid,bhnjd->bhnij', q_dec, k_inv)
    att = jnp.where(causal_in_chunk, att, 0.0)
    o_intra = jnp.einsum('bhnij,bhnjv->bhniv', att, v)
    kv_chunk = jnp.einsum('bhncd,bhncv->bhndv', k_to_end, v)
    decay_chunk = jnp.exp(cum_last[:, :, :, 0, :])

    def step(state, xs):
        qc, kvc, dc = xs
        o = jnp.einsum('bhcd,bhdv->bhcv', qc, state)
        return dc[..., None] * state + kvc, o

    xs = (jnp.moveaxis(q_dec, 2, 0), jnp.moveaxis(kv_chunk, 2, 0), jnp.moveaxis(decay_chunk, 2, 0))
    s_fin, o_inter = lax.scan(step, s0, xs)
    o = o_intra + jnp.moveaxis(o_inter, 0, 2)
    return o.reshape(b, h, t, dv), s_fin


def gla_streams(q, k, v, gf, gb, gla_wg, gla_bg, pos):
    q = to_heads(q, GLA_HEADS).astype(jnp.float32) * (GLA_DK ** -0.5)
    k = to_heads(k, GLA_HEADS).astype(jnp.float32)
    if pos is not None:
        q, k = rope_2d(q, pos[0], pos[1]), rope_2d(k, pos[0], pos[1])
    v = to_heads(v, GLA_HEADS).astype(jnp.float32)

    def log_decay(g, j):
        z = (g @ gla_wg[j] + gla_bg[j]).astype(jnp.float32)
        return to_heads(jax.nn.log_sigmoid(z) / GLA_GATE_TEMP, GLA_HEADS)

    return q, k, v, log_decay(gf, 0), log_decay(gb, 1)


def gla_readout(o, r, g, w_o):
    o = from_heads(rmsnorm(o, g)).astype(r.dtype)
    return (o * jax.nn.silu(r)) @ w_o


def neighbourhood_attention(q, k, v, kc, vc, rpb):
    b, t, _ = q.shape
    rows = t // GRID_W
    kr = min(NA_KR, rows)
    grid = lambda a: to_heads(a, NA_HEADS).reshape(b, NA_HEADS, rows, GRID_W, NA_DH)
    qg, kg, vg = grid(q), grid(k), grid(v)
    r = jnp.arange(rows)
    row_idx = jnp.clip(r - kr // 2, 0, rows - kr)[:, None] + jnp.arange(kr)[None, :]
    k_band = kg[:, :, row_idx]
    v_band = vg[:, :, row_idx]
    j = jnp.arange(GRID_W)
    col_start = jnp.clip(j - NA_KC // 2, 0, GRID_W - NA_KC)
    col_ok = (j[None, :] >= col_start[:, None]) & (j[None, :] < col_start[:, None] + NA_KC)
    di = row_idx - r[:, None]
    dj = jnp.clip(j[None, :] - j[:, None], -(NA_KC - 1), NA_KC - 1)
    bias = rpb[:, di[:, None, :, None] + NA_KR - 1, dj[None, :, None, :] + NA_KC - 1]
    scale = NA_DH ** -0.5
    s_lat = jnp.einsum('bhrqd,bhrakd->bhrqak', qg, k_band).astype(jnp.float32) * scale + bias.astype(jnp.float32)
    s_lat = jnp.where(col_ok[:, None, :], s_lat, NEG_INF)
    kch, vch = to_heads(kc, NA_HEADS), to_heads(vc, NA_HEADS)
    s_ctx = jnp.einsum('bhrqd,bhcd->bhrqc', qg, kch).astype(jnp.float32) * scale
    n_lat = kr * GRID_W
    s = jnp.concatenate([s_lat.reshape(b, NA_HEADS, rows, GRID_W, n_lat), s_ctx], axis=-1)
    p = jax.nn.softmax(s, axis=-1).astype(v.dtype)
    p_lat = p[..., :n_lat].reshape(b, NA_HEADS, rows, GRID_W, kr, GRID_W)
    o = jnp.einsum('bhrqak,bhrakd->bhrqd', p_lat, v_band) + jnp.einsum('bhrqc,bhcd->bhrqd', p[..., n_lat:], vch)
    return from_heads(o.reshape(b, NA_HEADS, t, NA_DH))


def context_attention(q, k, v):
    qh, kh, vh = to_heads(q, NA_HEADS), to_heads(k, NA_HEADS), to_heads(v, NA_HEADS)
    s = jnp.einsum('bhqd,bhkd->bhqk', qh, kh).astype(jnp.float32) * (NA_DH ** -0.5)
    p = jax.nn.softmax(s, axis=-1).astype(v.dtype)
    return from_heads(jnp.einsum('bhqk,bhkd->bhqd', p, vh))


def token_mixer(hl, hc, w_in, gla_wg, gla_bg, gla_norm_g, w_gla_o, na_rpb, w_na_o, w_out, row, col, ctx_out):
    ql, kl, vl, rl, gfl, gbl, nql, nkl, nvl, m1l, m2l = jnp.split(hl @ w_in, SPLIT_AT, axis=-1)
    qc, kc, vc, rc, gfc, gbc, nqc, nkc, nvc, m1c, m2c = jnp.split(hc @ w_in, SPLIT_AT, axis=-1)
    qc4, kc4, vc4, afc, abc = gla_streams(qc, kc, vc, gfc, gbc, gla_wg, gla_bg, None)
    ql4, kl4, vl4, afl, abl = gla_streams(ql, kl, vl, gfl, gbl, gla_wg, gla_bg, (row, col))
    s0 = jnp.zeros((hl.shape[0], GLA_HEADS, GLA_DK, GLA_DV), jnp.float32)
    oc_f, sc_f = gla_scan(qc4, kc4, vc4, afc, s0)
    oc_b, sc_b = gla_scan(flip_t(qc4), flip_t(kc4), flip_t(vc4), flip_t(abc), s0)
    ol_f, _ = gla_scan(ql4, kl4, vl4, afl, sc_f)
    ol_b, _ = gla_scan(flip_t(ql4), flip_t(kl4), flip_t(vl4), flip_t(abl), sc_b)
    a_l = gla_readout(ol_f + flip_t(ol_b), rl, gla_norm_g, w_gla_o)
    b_l = neighbourhood_attention(nql, nkl, nvl, nkc, nvc, na_rpb) @ w_na_o
    yl = (jax.nn.sigmoid(m1l) * a_l + jax.nn.sigmoid(m2l) * b_l) @ w_out
    if not ctx_out:
        return yl, None
    a_c = gla_readout(oc_f + flip_t(oc_b), rc, gla_norm_g, w_gla_o)
    b_c = context_attention(nqc, nkc, nvc) @ w_na_o
    yc = (jax.nn.sigmoid(m1c) * a_c + jax.nn.sigmoid(m2c) * b_c) @ w_out
    return yl, yc


def setup_inputs(seed: int = 0) -> dict:
    key = jax.random.key(seed)
    ks = jax.random.split(key, 18)
    nrm = lambda k, shape, s: jax.random.normal(k, shape, jnp.float32) * s
    D, L = D_MODEL, DEPTH
    return {
        'x': nrm(ks[0], (BATCH, SEQ, D), 1.0),
        'c': nrm(ks[1], (BATCH, D), 1.0),
        'ctx': nrm(ks[2], (BATCH, CTX_LEN, D), 1.0),
        'c_ctx': nrm(ks[3], (D,), 1.0),
        'w_ada': nrm(ks[4], (L, D, N_MOD * D), D ** -0.5),
        'b_ada': nrm(ks[5], (L, N_MOD * D), 0.02),
        'norm_g': 1.0 + nrm(ks[6], (L, 6, D), 0.02),
        'ffn_wg': nrm(ks[7], (L, 2, D, D_FF), D ** -0.5),
        'ffn_wu': nrm(ks[8], (L, 2, D, D_FF), D ** -0.5),
        'ffn_wd': nrm(ks[9], (L, 2, D_FF, D), D_FF ** -0.5),
        'w_in': nrm(ks[10], (L, D, IN_WIDTH), D ** -0.5),
        'gla_wg': nrm(ks[11], (L, 2, GLA_GATE_RANK, QK_W), GLA_GATE_RANK ** -0.5),
        'gla_bg': nrm(ks[12], (L, 2, QK_W), 0.1),
        'gla_norm_g': 1.0 + nrm(ks[13], (L, GLA_DV), 0.02),
        'w_gla_o': nrm(ks[14], (L, V_W, D), V_W ** -0.5),
        'na_rpb': nrm(ks[15], (L, NA_HEADS, 2 * NA_KR - 1, 2 * NA_KC - 1), 0.1),
        'w_na_o': nrm(ks[16], (L, NA_W, D), NA_W ** -0.5),
        'w_out': nrm(ks[17], (L, D, D), D ** -0.5),
    }


def reference(x, c, ctx, c_ctx, w_ada, b_ada, norm_g, ffn_wg, ffn_wu, ffn_wd, w_in, gla_wg, gla_bg,
              gla_norm_g, w_gla_o, na_rpb, w_na_o, w_out):
    t = jnp.arange(x.shape[1])
    row, col = t // GRID_W, t % GRID_W
    silu_c, silu_cc = jax.nn.silu(c), jax.nn.silu(c_ctx)
    h, hc = x, ctx
    for l in range(DEPTH):
        ctx_out = l < DEPTH - 1
        ml = jnp.moveaxis((silu_c @ w_ada[l] + b_ada[l]).reshape(-1, N_MOD, D_MODEL), 1, 0)[:, :, None, :]
        mc = (silu_cc @ w_ada[l] + b_ada[l]).reshape(N_MOD, D_MODEL)[:, None, None, :]
        g = norm_g[l]
        h = residual(h, swiglu(modulate(h, ml, 0, g[0]), ffn_wg[l, 0], ffn_wu[l, 0], ffn_wd[l, 0]), ml, 0, g[1], 0.5)
        hc = residual(hc, swiglu(modulate(hc, mc, 0, g[0]), ffn_wg[l, 0], ffn_wu[l, 0], ffn_wd[l, 0]), mc, 0, g[1], 0.5)
        yl, yc = token_mixer(modulate(h, ml, 1, g[2]), modulate(hc, mc, 1, g[2]), w_in[l], gla_wg[l], gla_bg[l],
                             gla_norm_g[l], w_gla_o[l], na_rpb[l], w_na_o[l], w_out[l], row, col, ctx_out)
        h = residual(h, yl, ml, 1, g[3], 1.0)
        h = residual(h, swiglu(modulate(h, ml, 2, g[4]), ffn_wg[l, 1], ffn_wu[l, 1], ffn_wd[l, 1]), ml, 2, g[5], 0.5)
        if ctx_out:
            hc = residual(hc, yc, mc, 1, g[3], 1.0)
            hc = residual(hc, swiglu(modulate(hc, mc, 2, g[4]), ffn_wg[l, 1], ffn_wu[l, 1], ffn_wd[l, 1]), mc, 2, g[5], 0.5)
    return h
```

```cpp
#include <hip/hip_runtime.h>
#ifndef MK_REP_MASK
#define MK_REP_MASK 0
#endif
#ifndef MK_EXTRA_SYNC
#define MK_EXTRA_SYNC 0
#endif
#include <hip/hip_cooperative_groups.h>
#include <cstdio>
namespace cg = cooperative_groups;

#define LAS __attribute__((address_space(3)))
typedef unsigned short bf16_t;
typedef unsigned char uchar;
typedef short bf16x8 __attribute__((ext_vector_type(8)));
typedef float f32x4 __attribute__((ext_vector_type(4)));
typedef float f32x16 __attribute__((ext_vector_type(16)));
typedef unsigned u32x4 __attribute__((ext_vector_type(4)));
typedef unsigned u32x2 __attribute__((ext_vector_type(2)));

constexpr int D = 2048, NB = 2, SEQ = 4096, CTXL = 256, DFF = 5632, NMODC = 9 * D;
constexpr int NLAT = NB * SEQ, NCTX = NB * CTXL, NTOK = NLAT + NCTX;
constexpr int INW = 13344;
constexpr int LDP = 13568;
constexpr int OFF_K = 0, OFF_V = 1024, OFF_NK = 3072, OFF_NV = 4096, OFF_GF = 5120, OFF_GB = 5136, OFF_Q = 5376, OFF_R = 6400, OFF_NQ = 8448, OFF_M1 = 9472, OFF_M2 = 11520;
constexpr int NCTXCOLS = 5376;
constexpr int NCH = 68;
constexpr float EPS = 1e-6f, LOG2E = 1.4426950408889634f;
constexpr int LDS_BYTES = 147456;
constexpr int NTHR = 512;

constexpr size_t SZ_WGU = (size_t)2 * DFF * D * 2, SZ_WD = (size_t)D * DFF * 2;
constexpr size_t WS_WGU2 = 0, WS_WD2 = WS_WGU2 + SZ_WGU, WS_WGLAO = WS_WD2 + SZ_WD, WS_WNAO = WS_WGLAO + (size_t)D * D * 2, WS_WOUT = WS_WNAO + (size_t)D * 1024 * 2,
                 WS_MODP = WS_WOUT + (size_t)D * D * 2, WS_CTR = WS_MODP + (size_t)2 * 3 * NMODC * 4, WS_BAR = WS_CTR + 256, WS_R1 = WS_BAR + 16384 - 256;
constexpr size_t WS_WGU1 = WS_R1, WS_WD1 = WS_WGU1 + SZ_WGU, WS_R2 = WS_WD1 + SZ_WD;
constexpr size_t WS_OF = WS_R1, WS_OB = WS_R1 + (size_t)NLAT * D * 2;
constexpr size_t WS_WIN = WS_R2, WS_R4 = WS_WIN + (size_t)LDP * D * 2;
constexpr size_t SZ_QD = (size_t)NB * 4 * 2 * NCH * 64 * 256 * 2;
constexpr size_t WS_QD = WS_R2, WS_NVTL = WS_QD + SZ_QD, WS_NVTC = WS_NVTL + (size_t)NB * 16 * 64 * 64 * 64 * 2, WS_AG = WS_R2;
constexpr size_t WS_PROJ = WS_R4, WS_R5 = WS_PROJ + (size_t)NTOK * LDP * 2;
constexpr size_t WS_Y = WS_R4, WS_YC = WS_Y + (size_t)NLAT * D * 4;
constexpr size_t WS_H = WS_R5, WS_R8 = WS_H + (size_t)NTOK * DFF * 2;
constexpr size_t WS_KET = WS_R5, WS_VT = WS_KET + SZ_QD, WS_PM = WS_VT + (size_t)NB * 4 * NCH * 512 * 64 * 2, WS_DEC = WS_PM + (size_t)NB * 4 * 2 * NCH * 4096 * 2, WS_G2 = WS_R5;
constexpr size_t WS_A = WS_R8, WS_NAO = WS_R8, WS_MG = WS_R8, WS_END = WS_A + (size_t)NTOK * D * 2;
static_assert(WS_DEC + (size_t)NB * 4 * 2 * NCH * 256 * 4 <= WS_R8, "R5 overlay");
static_assert(WS_NVTC + (size_t)NB * 16 * 64 * 256 * 2 <= WS_R4, "R2 overlay");
static_assert(WS_OB + (size_t)NLAT * D * 2 <= WS_R2, "R1 overlay");

struct Params {
    const float *x, *c, *ctx, *c_ctx, *w_ada, *b_ada, *norm_g, *ffn_wg, *ffn_wu, *ffn_wd, *w_in, *gla_wg, *gla_bg, *gla_norm_g, *w_gla_o, *na_rpb, *w_na_o, *w_out;
    float* out; uchar* ws; int ph_lo, ph_hi;
};

typedef float f32x2_t __attribute__((ext_vector_type(2)));
typedef __bf16 bf16x2_t __attribute__((ext_vector_type(2)));
__device__ __forceinline__ unsigned cvt_pk_bf16(float lo, float hi) { const f32x2_t v = {lo, hi}; union { bf16x2_t b; unsigned u; } x; x.b = __builtin_convertvector(v, bf16x2_t); return x.u; }
__device__ __forceinline__ float bf2f(bf16_t b) { return __uint_as_float(((unsigned)b) << 16); }
__device__ __forceinline__ float bflo(unsigned u) { return __uint_as_float(u << 16); }
__device__ __forceinline__ float bfhi(unsigned u) { return __uint_as_float(u & 0xffff0000u); }
__device__ __forceinline__ float fast_rcp(float x) { return __builtin_amdgcn_rcpf(x); }
__device__ __forceinline__ float sigmoidf_(float x) { return fast_rcp(1.0f + __expf(-x)); }
__device__ __forceinline__ float siluf_(float x) { return x * sigmoidf_(x); }
__device__ __forceinline__ float wave_sum(float v) {
#pragma unroll
    for (int o = 32; o >= 1; o >>= 1) v += __shfl_xor(v, o);
    return v;
}
__device__ __forceinline__ bf16x8 as_bf16x8(u32x4 v) { union { u32x4 u; bf16x8 b; } x; x.u = v; return x.b; }


#define XB_TMO      128
#define XB_XCNT(j)  (256  + 64 * (j))
#define XB_XSUB(j)  (1280 + 64 * (j))
#define XB_XGEN(j)  (2304 + 64 * (j))
#define XB_TOP      3328
#define XB_TOPGEN   3392
#define XCD_BAR_WORDS 3456
#define XB_SPIN_CAP (1u << 20)
__device__ __forceinline__ unsigned xb_ld(unsigned* p)              { return __hip_atomic_load(p, __ATOMIC_RELAXED, __HIP_MEMORY_SCOPE_AGENT); }
__device__ __forceinline__ unsigned xb_add(unsigned* p, unsigned v) { return __hip_atomic_fetch_add(p, v, __ATOMIC_RELAXED, __HIP_MEMORY_SCOPE_AGENT); }
__device__ __forceinline__ unsigned xb_xcc_id() { return (unsigned)__builtin_amdgcn_s_getreg((3 << 11) | 20) & 0xFu; }
#define XB_SPIN(cond, bar) do { unsigned _sp = 0; while (cond) { __builtin_amdgcn_s_sleep(1); \
    if ((++_sp & 255u) == 0u) { if (xb_ld(&(bar)[XB_TMO])) break; if (_sp > XB_SPIN_CAP) { atomicAdd(&(bar)[XB_TMO], 1u); break; } } } } while (0)
struct XcdBarrier { unsigned* bar; unsigned x; volatile LAS unsigned* st; };
__device__ __forceinline__ XcdBarrier xcd_barrier_post(unsigned* bar, volatile LAS unsigned* st) {
    XcdBarrier b; b.bar = bar; b.x = xb_xcc_id(); b.st = st;
    if (threadIdx.x == 0) (void)xb_add(&bar[XB_XCNT(b.x)], 1u);
    return b;
}
__device__ __forceinline__ void xcd_barrier_complete(unsigned* bar, unsigned x, unsigned& nloc, unsigned& nx) {
    const unsigned G = gridDim.x * gridDim.y * gridDim.z;
    unsigned sum, cnt, mine, sp = 0u;
    for (;;) {
        sum = 0u; cnt = 0u; mine = 0u;
#pragma unroll
        for (unsigned j = 0; j < 16; ++j) { const unsigned c = xb_ld(&bar[XB_XCNT(j)]); sum += c; cnt += (c > 0u) ? 1u : 0u; mine = (j == x) ? c : mine; }
        if (sum == G) break;
        __builtin_amdgcn_s_sleep(1);
        if ((++sp & 255u) == 0u) { if (xb_ld(&bar[XB_TMO])) break; if (sp > XB_SPIN_CAP) { atomicAdd(&bar[XB_TMO], 1u); break; } }
    }
    nloc = mine > 0u ? mine : 1u; nx = cnt > 0u ? cnt : 1u;
}
__device__ __forceinline__ void xcd_barrier(const XcdBarrier& b) {
    asm volatile("s_waitcnt vmcnt(0)" ::: "memory");
    __syncthreads();
    if (threadIdx.x == 0) {
        unsigned* bar = b.bar;
        __builtin_amdgcn_s_waitcnt(0);
        unsigned nloc = b.st[0], nx = b.st[1];
        if (nloc == 0u) { xcd_barrier_complete(bar, b.x, nloc, nx); b.st[0] = nloc; b.st[1] = nx; }
        const unsigned old = xb_add(&bar[XB_XSUB(b.x)], 1u);
        const unsigned gen = old / nloc;
        if (old + 1u == (gen + 1u) * nloc) {
            __builtin_amdgcn_fence(__ATOMIC_RELEASE, "agent");
            asm volatile("s_waitcnt vmcnt(0)" ::: "memory");
            const unsigned og = xb_add(&bar[XB_TOP], 1u);
            const unsigned tg = og / nx;
            if (og + 1u == (tg + 1u) * nx) xb_add(&bar[XB_TOPGEN], 1u);
            else XB_SPIN(xb_ld(&bar[XB_TOPGEN]) == tg, bar);
            __builtin_amdgcn_fence(__ATOMIC_ACQUIRE, "agent");
            xb_add(&bar[XB_XGEN(b.x)], 1u);
            asm volatile("s_waitcnt vmcnt(0)" ::: "memory");
        } else {
            XB_SPIN(xb_ld(&bar[XB_XGEN(b.x)]) == gen, bar);
            __builtin_amdgcn_fence(__ATOMIC_ACQUIRE, "agent");
            asm volatile("s_waitcnt vmcnt(0)" ::: "memory");
        }
    }
    __syncthreads();
}

namespace pg8 {
constexpr int BM = 256, BK = 64, HALF = 128, HTB = HALF * BK * 2, NXCD = 8, WGM = 8;
__device__ __forceinline__ int lds_byte(int r, int c) { const int st = (r >> 4) * 2 + (c >> 5), rr = r & 15, cc = c & 31, ob = rr * 64 + cc * 2; return st * 1024 + (ob ^ (((ob >> 9) & 1) << 5)); }
__device__ __forceinline__ void stage_rc(int b, int& R, int& C) { const int st = b / 1024, sb = b % 1024, swz = sb ^ (((sb >> 9) & 1) << 5); R = (st >> 1) * 16 + swz / 64; C = (st & 1) * 32 + (swz % 64) / 2; }
__device__ __forceinline__ int perm32(int rho) { const int n = rho >> 4, i = rho & 15; return 8 * (i >> 2) + 4 * n + (i & 3); }
struct Unit { int pm, pn; };
struct Gemm { const bf16_t* A; const bf16_t* Bt; int M, N, K, lda, ldb; };
struct StaticOrder {
    int nM, nN, nwg, G, c;
    __device__ void init(int M, int N, int G_, int c_) { nM = M / BM; nN = N / BM; nwg = nM * nN; G = G_; c = c_; }
    __device__ bool next(int i, Unit& u) const {
        const long L = (long)i * G + c; if (L >= nwg) return false;
        int wgid = (int)L; { const int q = nwg / NXCD, r = nwg % NXCD, xcd = wgid % NXCD, off = wgid / NXCD; wgid = (xcd < r ? xcd * (q + 1) : r * (q + 1) + (xcd - r) * q) + off; }
        const int nig = WGM * nN, gid = wgid / nig, fm = gid * WGM, gsz = (nM - fm) < WGM ? (nM - fm) : WGM;
        u.pm = fm + ((wgid % nig) % gsz); u.pn = (wgid % nig) / gsz; return true;
    }
};
struct EpiF32 {
    static constexpr bool PERM = false;
    float* C; int ldc;
    __device__ __forceinline__ void operator()(const f32x4 (&acc)[2][2][4][2], const Unit& u, int wr, int wc, int fr, int fq) const {
        const int row0 = u.pm * BM + wr * 64 + fr, col0 = u.pn * BM + wc * 32 + 4 * fq;
#pragma unroll
        for (int ai = 0; ai < 2; ++ai)
#pragma unroll
            for (int m = 0; m < 4; ++m) { float* rowp = C + (size_t)(row0 + ai * HALF + m * 16) * ldc + col0;
#pragma unroll
                for (int bj = 0; bj < 2; ++bj)
#pragma unroll
                    for (int n = 0; n < 2; ++n) *(f32x4*)(rowp + bj * HALF + n * 16) = acc[ai][bj][m][n]; }
    }
};
struct EpiBf16 {
    static constexpr bool PERM = true;
    bf16_t* O; int ldc;
    __device__ __forceinline__ void operator()(const f32x4 (&acc)[2][2][4][2], const Unit& u, int wr, int wc, int fr, int fq) const {
        const int row0 = u.pm * BM + wr * 64 + fr, col0 = u.pn * BM + wc * 32 + 8 * fq;
#pragma unroll
        for (int ai = 0; ai < 2; ++ai)
#pragma unroll
            for (int m = 0; m < 4; ++m) { bf16_t* rowp = O + (size_t)(row0 + ai * HALF + m * 16) * ldc + col0;
#pragma unroll
                for (int bj = 0; bj < 2; ++bj) { const f32x4 v0 = acc[ai][bj][m][0], v1 = acc[ai][bj][m][1];
                    u32x4 w; w.x = cvt_pk_bf16(v0[0], v0[1]); w.y = cvt_pk_bf16(v0[2], v0[3]); w.z = cvt_pk_bf16(v1[0], v1[1]); w.w = cvt_pk_bf16(v1[2], v1[3]);
                    *(u32x4*)(rowp + bj * HALF) = w; } }
    }
};
struct EpiSiluMul {
    static constexpr bool PERM = true;
    bf16_t* O; int ldc;
    __device__ __forceinline__ void operator()(const f32x4 (&acc)[2][2][4][2], const Unit& u, int wr, int wc, int fr, int fq) const {
        const int row0 = u.pm * BM + wr * 64 + fr, col0 = u.pn * HALF + wc * 32 + 8 * fq;
#pragma unroll
        for (int ai = 0; ai < 2; ++ai)
#pragma unroll
            for (int m = 0; m < 4; ++m) { bf16_t* rowp = O + (size_t)(row0 + ai * HALF + m * 16) * ldc + col0;
                float h[8];
#pragma unroll
                for (int n = 0; n < 2; ++n)
#pragma unroll
                    for (int j = 0; j < 4; ++j) h[n * 4 + j] = siluf_(acc[ai][0][m][n][j]) * acc[ai][1][m][n][j];
                u32x4 w; w.x = cvt_pk_bf16(h[0], h[1]); w.y = cvt_pk_bf16(h[2], h[3]); w.z = cvt_pk_bf16(h[4], h[5]); w.w = cvt_pk_bf16(h[6], h[7]);
                *(u32x4*)rowp = w; }
    }
};
struct EpiGate2 {
    static constexpr bool PERM = false;
    bf16_t* C; const bf16_t* gate;
    __device__ __forceinline__ void operator()(const f32x4 (&acc)[2][2][4][2], const Unit& u, int wr, int wc, int fr, int fq) const {
        const int row0 = u.pm * BM + wr * 64 + fr, col0 = u.pn * BM + wc * 32 + 4 * fq;
#pragma unroll
        for (int ai = 0; ai < 2; ++ai)
#pragma unroll
            for (int m = 0; m < 4; ++m) { const size_t row = (size_t)(row0 + ai * HALF + m * 16);
#pragma unroll
                for (int bj = 0; bj < 2; ++bj)
#pragma unroll
                    for (int n = 0; n < 2; ++n) { const int col = col0 + bj * HALF + n * 16;
                        const u32x2 gm = *(const u32x2*)(gate + row * LDP + col); const f32x4 a = acc[ai][bj][m][n];
                        f32x4 o; o[0] = sigmoidf_(bflo(gm.x)) * a[0]; o[1] = sigmoidf_(bfhi(gm.x)) * a[1]; o[2] = sigmoidf_(bflo(gm.y)) * a[2]; o[3] = sigmoidf_(bfhi(gm.y)) * a[3];
                        u32x2 ow; ow.x = cvt_pk_bf16(o[0], o[1]); ow.y = cvt_pk_bf16(o[2], o[3]); *(u32x2*)(C + row * D + col) = ow; } }
    }
};
struct EpiMerge {
    static constexpr bool PERM = true;
    bf16_t* O; const bf16_t* gate; const bf16_t* G2;
    __device__ __forceinline__ void operator()(const f32x4 (&acc)[2][2][4][2], const Unit& u, int wr, int wc, int fr, int fq) const {
        const int row0 = u.pm * BM + wr * 64 + fr, col0 = u.pn * BM + wc * 32 + 8 * fq;
#pragma unroll
        for (int ai = 0; ai < 2; ++ai)
#pragma unroll
            for (int m = 0; m < 4; ++m) { const size_t row = (size_t)(row0 + ai * HALF + m * 16);
#pragma unroll
                for (int bj = 0; bj < 2; ++bj) { const int col = col0 + bj * HALF;
                    const u32x4 gm = *(const u32x4*)(gate + row * LDP + col);
                    const u32x4 gq = *(const u32x4*)(G2 + row * D + col); const f32x4 ga = (f32x4){bflo(gq.x), bfhi(gq.x), bflo(gq.y), bfhi(gq.y)}, gb = (f32x4){bflo(gq.z), bfhi(gq.z), bflo(gq.w), bfhi(gq.w)};
                    const f32x4 v0 = acc[ai][bj][m][0], v1 = acc[ai][bj][m][1];
                    float o[8];
                    o[0] = sigmoidf_(bflo(gm.x)) * v0[0] + ga[0]; o[1] = sigmoidf_(bfhi(gm.x)) * v0[1] + ga[1]; o[2] = sigmoidf_(bflo(gm.y)) * v0[2] + ga[2]; o[3] = sigmoidf_(bfhi(gm.y)) * v0[3] + ga[3];
                    o[4] = sigmoidf_(bflo(gm.z)) * v1[0] + gb[0]; o[5] = sigmoidf_(bfhi(gm.z)) * v1[1] + gb[1]; o[6] = sigmoidf_(bflo(gm.w)) * v1[2] + gb[2]; o[7] = sigmoidf_(bfhi(gm.w)) * v1[3] + gb[3];
                    u32x4 w; w.x = cvt_pk_bf16(o[0], o[1]); w.y = cvt_pk_bf16(o[2], o[3]); w.z = cvt_pk_bf16(o[4], o[5]); w.w = cvt_pk_bf16(o[6], o[7]);
                    *(u32x4*)(O + row * D + col) = w; } }
    }
};

template <class Epi, bool ALIGN_EPI = true>
__device__ __forceinline__ void gemm_phase(LAS uchar* lds, const Gemm g, const StaticOrder& S, const Epi& E) {
    const int tid = threadIdx.x, wid = __builtin_amdgcn_readfirstlane(tid >> 6), lane = tid & 63, wr = wid >> 2, wc = wid & 3, fr = lane & 15, fq = lane >> 4;
    const int K = g.K, nt = K / BK;
    unsigned voffA[2], voffB[2];
#pragma unroll
    for (int i = 0; i < 2; ++i) { int R, C; stage_rc(tid * 16 + i * 8192, R, C); const int Rb = Epi::PERM ? ((R & ~31) + perm32(R & 31)) : R;
        voffA[i] = (unsigned)(R * g.lda + C) * 2u; voffB[i] = (unsigned)(Rb * g.ldb + C) * 2u; }
    const size_t kstep = (size_t)(BK * 2);
    const size_t hstepA = (size_t)HALF * g.lda * 2, hstepB = (size_t)HALF * g.ldb * 2;
    const size_t tstepA = 2 * hstepA, tstepB = 2 * hstepB;
    const unsigned ldsw = (unsigned)wid * 1024u;
    const int aoff = lds_byte(wr * 64 + fr, fq * 8), boff = lds_byte(wc * 32 + fr, fq * 8);
#define PG8_SA(b, h) (((b) * 2 + (h)) * HTB)
#define PG8_SB(b, h) ((4 + (b) * 2 + (h)) * HTB)
#define PG8_STAGE(bufoff, gbase, voff) do { _Pragma("unroll") for (int _i = 0; _i < 2; ++_i) \
        __builtin_amdgcn_global_load_lds((const unsigned*)((const char*)(gbase) + (voff)[_i]), (LAS unsigned*)(lds + (bufoff) + ldsw + _i * 8192), 16, 0, 0); } while (0)
#define PG8_LDA(dst, b, h) do { _Pragma("unroll") for (int m = 0; m < 4; ++m) _Pragma("unroll") for (int k = 0; k < 2; ++k) dst[m][k] = *(const LAS bf16x8*)(lds + PG8_SA(b, h) + aoff + m * 2048 + k * 1024); } while (0)
#define PG8_LDB(dst, b, h) do { _Pragma("unroll") for (int n = 0; n < 2; ++n) _Pragma("unroll") for (int k = 0; k < 2; ++k) dst[n][k] = *(const LAS bf16x8*)(lds + PG8_SB(b, h) + boff + n * 2048 + k * 1024); } while (0)
#define PG8_MMA(ai, bj, At, Bt) do { __builtin_amdgcn_s_setprio(1); _Pragma("unroll") for (int m = 0; m < 4; ++m) _Pragma("unroll") for (int n = 0; n < 2; ++n) _Pragma("unroll") for (int k = 0; k < 2; ++k) \
        acc[ai][bj][m][n] = __builtin_amdgcn_mfma_f32_16x16x32_bf16(Bt[n][k], At[m][k], acc[ai][bj][m][n], 0, 0, 0); __builtin_amdgcn_s_setprio(0); } while (0)
#define PG8_WAIT_V(n) asm volatile("s_waitcnt vmcnt(" #n ")" ::: "memory")
#define PG8_WAIT_L(n) asm volatile("s_waitcnt lgkmcnt(" #n ")" ::: "memory")
#define PG8_BAR __builtin_amdgcn_s_barrier()
#define PG8_SCHED __builtin_amdgcn_sched_barrier(0)
    Unit cur, nxt; int ui = 0;
    if (!S.next(0, cur)) return;
    f32x4 acc[2][2][4][2];
#pragma unroll
    for (int a = 0; a < 2; ++a)
#pragma unroll
        for (int b = 0; b < 2; ++b)
#pragma unroll
            for (int m = 0; m < 4; ++m)
#pragma unroll
                for (int n = 0; n < 2; ++n) acc[a][b][m][n] = (f32x4){0.f, 0.f, 0.f, 0.f};
    bf16x8 At[4][2], B0[2][2], B1[2][2];
    const char* cA = (const char*)g.A + (size_t)cur.pm * tstepA; const char* cB = (const char*)g.Bt + (size_t)cur.pn * tstepB;
    PG8_STAGE(PG8_SB(0, 0), cB, voffB); PG8_STAGE(PG8_SB(0, 1), cB + hstepB, voffB); PG8_STAGE(PG8_SA(0, 0), cA, voffA); PG8_STAGE(PG8_SA(0, 1), cA + hstepA, voffA);
    if (wr == 1) PG8_BAR;
    PG8_WAIT_V(2); PG8_BAR;
    PG8_STAGE(PG8_SB(1, 0), cB + kstep, voffB); PG8_STAGE(PG8_SA(1, 0), cA + kstep, voffA); PG8_STAGE(PG8_SB(1, 1), cB + hstepB + kstep, voffB);
    PG8_WAIT_V(6); PG8_BAR;
    for (;;) {
        const bool has_next = S.next(ui + 1, nxt);
        const char* nA = has_next ? (const char*)g.A + (size_t)nxt.pm * tstepA : cA; const char* nB = has_next ? (const char*)g.Bt + (size_t)nxt.pn * tstepB : cB;
        for (int t = 0; t < nt; t += 2) {
            const bool last = (t == nt - 2);
            const char* a1 = cA + (size_t)(t + 1) * kstep;
            const char* a2 = last ? nA : cA + (size_t)(t + 2) * kstep; const char* b2 = last ? nB : cB + (size_t)(t + 2) * kstep;
            const char* a3 = a2 + kstep; const char* b3 = b2 + kstep;
            PG8_LDB(B0, 0, 0); PG8_LDB(B1, 0, 1); PG8_SCHED; PG8_LDA(At, 0, 0); PG8_STAGE(PG8_SA(1, 1), a1 + hstepA, voffA);
            PG8_WAIT_V(8); PG8_WAIT_L(0); PG8_BAR; PG8_MMA(0, 0, At, B0); PG8_MMA(0, 1, At, B1); PG8_BAR; PG8_SCHED;
            PG8_LDA(At, 0, 1); PG8_STAGE(PG8_SB(0, 0), b2, voffB); PG8_STAGE(PG8_SB(0, 1), b2 + hstepB, voffB); PG8_STAGE(PG8_SA(0, 0), a2, voffA);
            PG8_WAIT_V(8); PG8_WAIT_L(0); PG8_BAR; PG8_MMA(1, 0, At, B0); PG8_MMA(1, 1, At, B1); PG8_BAR; PG8_SCHED;
            PG8_LDB(B0, 1, 0); PG8_LDB(B1, 1, 1); PG8_SCHED; PG8_LDA(At, 1, 0); PG8_STAGE(PG8_SA(0, 1), a2 + hstepA, voffA);
            PG8_WAIT_V(8); PG8_WAIT_L(0); PG8_BAR; PG8_MMA(0, 0, At, B0); PG8_MMA(0, 1, At, B1); PG8_BAR; PG8_SCHED;
            PG8_LDA(At, 1, 1); PG8_STAGE(PG8_SB(1, 0), b3, voffB); PG8_STAGE(PG8_SB(1, 1), b3 + hstepB, voffB); PG8_STAGE(PG8_SA(1, 0), a3, voffA);
            PG8_WAIT_V(8); PG8_WAIT_L(0); PG8_BAR; PG8_MMA(1, 0, At, B0); PG8_MMA(1, 1, At, B1); PG8_BAR; PG8_SCHED;
        }
        if constexpr (ALIGN_EPI) { if (wr == 0) PG8_BAR; }
        E(acc, cur, wr, wc, fr, fq);
        if (!has_next) break;
#pragma unroll
        for (int a = 0; a < 2; ++a)
#pragma unroll
            for (int b = 0; b < 2; ++b)
#pragma unroll
                for (int m = 0; m < 4; ++m)
#pragma unroll
                    for (int n = 0; n < 2; ++n) acc[a][b][m][n] = (f32x4){0.f, 0.f, 0.f, 0.f};
        cur = nxt; cA = nA; cB = nB; ++ui;
        if constexpr (ALIGN_EPI) { if (wr == 1) PG8_BAR; }
    }
    PG8_WAIT_V(0);
    if constexpr (!ALIGN_EPI) { if (wr == 0) PG8_BAR; }
    PG8_BAR;
#undef PG8_SA
#undef PG8_SB
#undef PG8_STAGE
#undef PG8_LDA
#undef PG8_LDB
#undef PG8_MMA
#undef PG8_WAIT_V
#undef PG8_WAIT_L
#undef PG8_BAR
#undef PG8_SCHED
}
}

struct CvtJob { const float* src; int ld, K, col0, ntn, valid; bf16_t* dst; int row0, mul; };
__device__ __forceinline__ int cvt_job(const Params& p, int j, CvtJob& o) {
    uchar* ws = p.ws;
    const size_t FW = (size_t)D * DFF;
    switch (j) {
    case 0: o = {p.ffn_wg, DFF, D, 0, 44, 5632, (bf16_t*)(ws + WS_WGU1), 0, 256}; break;
    case 1: o = {p.ffn_wu, DFF, D, 0, 44, 5632, (bf16_t*)(ws + WS_WGU1), 128, 256}; break;
    case 2: o = {p.ffn_wd, D, DFF, 0, 16, 2048, (bf16_t*)(ws + WS_WD1), 0, 128}; break;
    case 3: o = {p.w_in, INW, D, 1024, 8, 1024, (bf16_t*)(ws + WS_WIN), OFF_K, 128}; break;
    case 4: o = {p.w_in, INW, D, 2048, 16, 2048, (bf16_t*)(ws + WS_WIN), OFF_V, 128}; break;
    case 5: o = {p.w_in, INW, D, 7200, 8, 1024, (bf16_t*)(ws + WS_WIN), OFF_NK, 128}; break;
    case 6: o = {p.w_in, INW, D, 8224, 8, 1024, (bf16_t*)(ws + WS_WIN), OFF_NV, 128}; break;
    case 7: o = {p.w_in, INW, D, 6144, 2, 32, (bf16_t*)(ws + WS_WIN), OFF_GF, 128}; break;
    case 8: o = {p.w_in, INW, D, 0, 8, 1024, (bf16_t*)(ws + WS_WIN), OFF_Q, 128}; break;
    case 9: o = {p.w_in, INW, D, 4096, 16, 2048, (bf16_t*)(ws + WS_WIN), OFF_R, 128}; break;
    case 10: o = {p.w_in, INW, D, 6176, 8, 1024, (bf16_t*)(ws + WS_WIN), OFF_NQ, 128}; break;
    case 11: o = {p.w_in, INW, D, 9248, 16, 2048, (bf16_t*)(ws + WS_WIN), OFF_M1, 128}; break;
    case 12: o = {p.w_in, INW, D, 11296, 16, 2048, (bf16_t*)(ws + WS_WIN), OFF_M2, 128}; break;
    case 13: o = {p.w_gla_o, D, D, 0, 16, 2048, (bf16_t*)(ws + WS_WGLAO), 0, 128}; break;
    case 14: o = {p.w_na_o, D, 1024, 0, 16, 2048, (bf16_t*)(ws + WS_WNAO), 0, 128}; break;
    case 15: o = {p.w_out, D, D, 0, 16, 2048, (bf16_t*)(ws + WS_WOUT), 0, 128}; break;
    case 16: o = {p.ffn_wg + FW, DFF, D, 0, 44, 5632, (bf16_t*)(ws + WS_WGU2), 0, 256}; break;
    case 17: o = {p.ffn_wu + FW, DFF, D, 0, 44, 5632, (bf16_t*)(ws + WS_WGU2), 128, 256}; break;
    default: o = {p.ffn_wd + FW, D, DFF, 0, 16, 2048, (bf16_t*)(ws + WS_WD2), 0, 128}; break;
    }
    return (o.K / 128) * o.ntn;
}
constexpr int N_CVT_JOBS = 19;
constexpr int N_CVT_TILES = 6 * 704 + 16 * 106 + 256 + 128 + 256;

struct CvtRegs { f32x4 a[4], b[4]; bf16_t* dst; int K; };
__device__ __forceinline__ void cvt_load(const CvtJob& J, int tl, CvtRegs& R) {
    const int tid = threadIdx.x;
    const int ktiles = J.K / 128, nt = tl / ktiles, kt = tl % ktiles;
    const int k0 = kt * 128, c0 = nt * 128;
    const int n4 = tid & 31, kp = tid >> 5;
    const int col = c0 + 4 * n4;
    R.dst = J.dst + (size_t)(J.row0 + nt * J.mul) * J.K + k0; R.K = J.K;
#pragma unroll
    for (int it = 0; it < 4; ++it) {
        const int kpair = kp + 16 * it;
        R.a[it] = (f32x4){0.f, 0.f, 0.f, 0.f}; R.b[it] = R.a[it];
        if (col < J.valid) { const float* sp = J.src + (size_t)(k0 + 2 * kpair) * J.ld + J.col0 + col; R.a[it] = __builtin_nontemporal_load((const f32x4*)sp); R.b[it] = __builtin_nontemporal_load((const f32x4*)(sp + J.ld)); }
    }
}
__device__ __forceinline__ void cvt_store(LAS uchar* lds, const CvtRegs& R) {
    LAS unsigned* T = (LAS unsigned*)lds;
    const int tid = threadIdx.x, n4 = tid & 31, kp = tid >> 5;
#pragma unroll
    for (int it = 0; it < 4; ++it) {
        const int kpair = kp + 16 * it;
#pragma unroll
        for (int i = 0; i < 4; ++i) T[(4 * n4 + i) * 65 + kpair] = cvt_pk_bf16(R.a[it][i], R.b[it][i]);
    }
    __syncthreads();
#pragma unroll
    for (int it = 0; it < 4; ++it) {
        const int ch = tid + 512 * it, n = ch >> 4, c16 = ch & 15;
        u32x4 v; v.x = T[n * 65 + 4 * c16]; v.y = T[n * 65 + 4 * c16 + 1]; v.z = T[n * 65 + 4 * c16 + 2]; v.w = T[n * 65 + 4 * c16 + 3];
        *(u32x4*)(R.dst + (size_t)n * R.K + 8 * c16) = v;
    }
    __syncthreads();
}

__device__ __forceinline__ void ada_item(LAS uchar* lds, const Params& p, int item) {
    LAS float* sv = (LAS float*)lds;
    LAS float* red = (LAS float*)(lds + 12288);
    const int tid = threadIdx.x, w = tid >> 6, lane = tid & 63;
    const int cb = item >> 1, kh = item & 1;
    for (int i = tid; i < 3 * 1024; i += NTHR) { const int s = i >> 10, k = kh * 1024 + (i & 1023); const float v = s < 2 ? p.c[s * D + k] : p.c_ctx[k]; sv[i] = siluf_(v); }
    __syncthreads();
    f32x4 a0 = (f32x4){0.f, 0.f, 0.f, 0.f}, a1 = a0, a2 = a0;
    const float* wp = p.w_ada + (size_t)(kh * 1024 + w * 128) * NMODC + cb * 256 + lane * 4;
#pragma unroll 8
    for (int k = 0; k < 128; ++k) {
        const f32x4 wv = *(const f32x4*)(wp + (size_t)k * NMODC);
        const int kk = w * 128 + k;
        a0 += sv[kk] * wv; a1 += sv[1024 + kk] * wv; a2 += sv[2048 + kk] * wv;
    }
    *(LAS f32x4*)(red + (w * 3 + 0) * 256 + lane * 4) = a0; *(LAS f32x4*)(red + (w * 3 + 1) * 256 + lane * 4) = a1; *(LAS f32x4*)(red + (w * 3 + 2) * 256 + lane * 4) = a2;
    __syncthreads();
    float* modp = (float*)(p.ws + WS_MODP);
    for (int i = tid; i < 768; i += NTHR) { const int s = i >> 8, col = i & 255; float v = 0.f;
#pragma unroll
        for (int ww = 0; ww < 8; ++ww) v += red[(ww * 3 + s) * 256 + col];
        const int gc = cb * 256 + col; if (kh == 0) v += p.b_ada[gc];
        modp[(size_t)(kh * 3 + s) * NMODC + gc] = v; }
    __syncthreads();
}

__device__ __forceinline__ void phase_prologue(LAS uchar* lds, const Params& p) {
    const int G = gridDim.x, bx = blockIdx.x;
    int t_lo, t_hi;
    if (G == 256) {
        if (bx < 144) { ada_item(lds, p, bx); t_lo = (bx * 89) / 4; t_hi = ((bx + 1) * 89) / 4; }
        else { t_lo = 3204 + (bx - 144) * 30; t_hi = t_lo + 30; }
        if (t_hi > N_CVT_TILES) t_hi = N_CVT_TILES;
    } else {
        for (int i = bx; i < 144; i += G) ada_item(lds, p, i);
        const int per = (N_CVT_TILES + G - 1) / G; t_lo = bx * per; t_hi = t_lo + per; if (t_hi > N_CVT_TILES) t_hi = N_CVT_TILES;
    }
    int j = 0, base = 0; CvtJob J; int cnt = cvt_job(p, 0, J);
    if (t_lo < t_hi) {
        CvtRegs cur, nxt;
        while (t_lo >= base + cnt) { base += cnt; ++j; cnt = cvt_job(p, j, J); }
        cvt_load(J, t_lo - base, cur);
        for (int t = t_lo; t < t_hi; ++t) {
            if (t + 1 < t_hi) { while (t + 1 >= base + cnt) { base += cnt; ++j; cnt = cvt_job(p, j, J); } cvt_load(J, t + 1 - base, nxt); }
            cvt_store(lds, cur);
            cur = nxt;
        }
    }
}

__device__ __forceinline__ f32x4 ld_mod(const float* modp, int s, int idx, int col) {
    const float* a = modp + (size_t)s * NMODC + idx * D + col; const float* b = a + (size_t)3 * NMODC;
    return *(const f32x4*)a + *(const f32x4*)b;
}
__device__ __forceinline__ void st_bf16x4(bf16_t* dst, f32x4 v) { u32x2 w; w.x = cvt_pk_bf16(v[0], v[1]); w.y = cvt_pk_bf16(v[2], v[3]); *(u32x2*)dst = w; }

__device__ __forceinline__ void phase_prenorm1(const Params& p) {
    const int w = threadIdx.x >> 6, lane = threadIdx.x & 63;
    const float* modp = (const float*)(p.ws + WS_MODP); bf16_t* A = (bf16_t*)(p.ws + WS_A);
    for (int item = blockIdx.x; item < NTOK / 8; item += gridDim.x) {
        const int row = item * 8 + w; const int s = row < NLAT ? row / SEQ : 2;
        const float* src = row < NLAT ? p.x + (size_t)row * D : p.ctx + (size_t)(row - NLAT) * D;
        f32x4 v[8]; float ss = 0.f;
#pragma unroll
        for (int j = 0; j < 8; ++j) { v[j] = *(const f32x4*)(src + j * 256 + lane * 4); ss += v[j][0] * v[j][0] + v[j][1] * v[j][1] + v[j][2] * v[j][2] + v[j][3] * v[j][3]; }
        ss = wave_sum(ss); const float rstd = rsqrtf(ss * (1.0f / D) + EPS);
#pragma unroll
        for (int j = 0; j < 8; ++j) { const int col = j * 256 + lane * 4;
            const f32x4 g = *(const f32x4*)(p.norm_g + 0 * D + col), sh = ld_mod(modp, s, 0, col), sc = ld_mod(modp, s, 1, col);
            st_bf16x4(A + (size_t)row * D + col, (v[j] * rstd * g) * (1.0f + sc) + sh); }
    }
}
template <int MODE>
__device__ __forceinline__ void phase_post(const Params& p) {
    const int w = threadIdx.x >> 6, lane = threadIdx.x & 63;
    const float* modp = (const float*)(p.ws + WS_MODP); bf16_t* A = (bf16_t*)(p.ws + WS_A);
    const bf16_t* Y = (const bf16_t*)(p.ws + WS_Y); const bf16_t* YC = (const bf16_t*)(p.ws + WS_YC);
    constexpr int NROWS = MODE == 0 ? NTOK : NLAT;
    constexpr int GI = MODE == 0 ? 2 : (MODE == 1 ? 5 : 8), GP = MODE == 0 ? 1 : (MODE == 1 ? 3 : 5), GN = MODE == 0 ? 2 : 4, SI = MODE == 0 ? 3 : 6;
    constexpr float WRES = MODE == 1 ? 1.0f : 0.5f;
    for (int item = blockIdx.x; item < NROWS / 8; item += gridDim.x) {
        const int row = item * 8 + w; const int s = row < NLAT ? row / SEQ : 2;
        const float* xin = MODE == 0 ? (row < NLAT ? p.x + (size_t)row * D : p.ctx + (size_t)(row - NLAT) * D) : p.out + (size_t)row * D;
        f32x4 y[8], xv8[8]; float ss = 0.f;
#pragma unroll
        for (int j = 0; j < 8; ++j) xv8[j] = *(const f32x4*)(xin + j * 256 + lane * 4);
#pragma unroll
        for (int j = 0; j < 8; ++j) { const int col = j * 256 + lane * 4;
            if (MODE == 0 && row >= NLAT) { const bf16_t* yc = YC + (size_t)(row - NLAT) * D + col; f32x4 a = (f32x4){0.f, 0.f, 0.f, 0.f};
#pragma unroll
                for (int sp = 0; sp < 4; ++sp) { const u32x2 t = *(const u32x2*)(yc + (size_t)sp * NCTX * D); a += (f32x4){bflo(t.x), bfhi(t.x), bflo(t.y), bfhi(t.y)}; }
                y[j] = a; }
            else { const u32x2 t = *(const u32x2*)(Y + (size_t)row * D + col); y[j] = (f32x4){bflo(t.x), bfhi(t.x), bflo(t.y), bfhi(t.y)}; }
            ss += y[j][0] * y[j][0] + y[j][1] * y[j][1] + y[j][2] * y[j][2] + y[j][3] * y[j][3]; }
        ss = wave_sum(ss); const float rstd = rsqrtf(ss * (1.0f / D) + EPS);
        float ss2 = 0.f;
#pragma unroll
        for (int j = 0; j < 8; ++j) { const int col = j * 256 + lane * 4;
            const f32x4 g = *(const f32x4*)(p.norm_g + GP * D + col), gt = ld_mod(modp, s, GI, col), xv = xv8[j];
            const f32x4 x1 = xv + WRES * gt * (y[j] * rstd * g);
            y[j] = x1; ss2 += x1[0] * x1[0] + x1[1] * x1[1] + x1[2] * x1[2] + x1[3] * x1[3];
            if (row < NLAT) *(f32x4*)(p.out + (size_t)row * D + col) = x1; }
        if (MODE == 2) continue;
        ss2 = wave_sum(ss2); const float rstd2 = rsqrtf(ss2 * (1.0f / D) + EPS);
#pragma unroll
        for (int j = 0; j < 8; ++j) { const int col = j * 256 + lane * 4;
            const f32x4 g = *(const f32x4*)(p.norm_g + GN * D + col), sh = ld_mod(modp, s, SI, col), sc = ld_mod(modp, s, SI + 1, col);
            st_bf16x4(A + (size_t)row * D + col, (y[j] * rstd2 * g) * (1.0f + sc) + sh); }
    }
}

constexpr int PREP_PITCH = 264;
constexpr int PREP_TILE = 64 * PREP_PITCH * 2;
__device__ __forceinline__ size_t gla_idx(int b, int h, int dir, int cid) { return (size_t)(((b * 4 + h) * 2 + dir) * NCH + cid); }

__device__ __forceinline__ void gla_prep_item(LAS uchar* lds, const Params& p, int item) {
    const int tid = threadIdx.x, wv = tid >> 6, lane = tid & 63;
    int h, cid, b;
    if (item < NB * 64 * 4) { h = item & 3; const int bc = item >> 2; cid = 4 + (bc & 63); b = bc >> 6; }
    else { const int it2 = item - NB * 64 * 4; h = it2 & 3; const int bc = it2 >> 2; cid = bc & 3; b = bc >> 2; }
    const bool lat = cid >= 4;
    const int rowbase = lat ? b * SEQ + (cid - 4) * 64 : NLAT + b * CTXL + cid * 64;
    const bf16_t* PROJ = (const bf16_t*)(p.ws + WS_PROJ);
    LAS float* Gs = (LAS float*)lds;
    {
        const int i = tid >> 3, c4 = (tid & 7) * 4;
        const u32x2 g = *(const u32x2*)(PROJ + (size_t)(rowbase + i) * LDP + OFF_GF + c4);
        *(LAS f32x4*)(Gs + i * 32 + c4) = (f32x4){bflo(g.x), bfhi(g.x), bflo(g.y), bfhi(g.y)};
    }
    __syncthreads();
    const int d = tid & 255, dir = tid >> 8;
    float wg[16];
#pragma unroll
    for (int r = 0; r < 16; ++r) wg[r] = p.gla_wg[(size_t)(dir * 16 + r) * 1024 + h * 256 + d];
    const float bg = p.gla_bg[dir * 1024 + h * 256 + d];
    const int axis = d >> 7, dd = d & 127, fi = dd & 63; const bool first = dd < 64;
    const int dpart = first ? d + 64 : d - 64;
    const float freq = __expf(-(float)fi * (9.210340371976184f / 64.0f));
    const float ang_row = (float)(cid - 4) * freq;
    float cs_row, sn_row; __sincosf(ang_row, &sn_row, &cs_row);
    bf16_t* QD = (bf16_t*)(p.ws + WS_QD) + gla_idx(b, h, dir, cid) * (64 * 256);
    bf16_t* KET = (bf16_t*)(p.ws + WS_KET) + gla_idx(b, h, dir, cid) * (256 * 64);
    LAS bf16_t* QDs = (LAS bf16_t*)(lds + 8192 + dir * 2 * PREP_TILE);
    LAS bf16_t* KIs = (LAS bf16_t*)(lds + 8192 + dir * 2 * PREP_TILE + PREP_TILE);
    float cum = 0.f;
    unsigned short rk[8], rkp[8], rq[8], rqp[8], nk_[8], nkp[8], nq_[8], nqp[8];
    const bf16_t* pbase = PROJ + (size_t)rowbase * LDP + h * 256;
    const unsigned ok_ = OFF_K + d, okp_ = OFF_K + dpart, oq_ = OFF_Q + d, oqp_ = OFF_Q + dpart;
#define PREP_LOAD(dk_, dkp_, dq_, dqp_, n8_) do { _Pragma("unroll") for (int jj = 0; jj < 8; ++jj) { const int n_ = (n8_) * 8 + jj, i_ = dir ? 63 - n_ : n_; \
        const unsigned to_ = (unsigned)i_ * (unsigned)LDP; dk_[jj] = pbase[to_ + ok_]; \
        if (lat) { dkp_[jj] = pbase[to_ + okp_]; dq_[jj] = pbase[to_ + oq_]; dqp_[jj] = pbase[to_ + oqp_]; } else { dkp_[jj] = 0; dq_[jj] = 0; dqp_[jj] = 0; } } } while (0)
    PREP_LOAD(rk, rkp, rq, rqp, 0);
    for (int n8 = 0; n8 < 8; ++n8) {
        if (n8 < 7) PREP_LOAD(nk_, nkp, nq_, nqp, n8 + 1);
        float ke[8];
#pragma unroll
        for (int jj = 0; jj < 8; ++jj) {
            const int n = n8 * 8 + jj, i = dir ? 63 - n : n;
            const LAS f32x4* gp = (const LAS f32x4*)(Gs + i * 32 + dir * 16);
            float z = bg;
#pragma unroll
            for (int q4 = 0; q4 < 4; ++q4) { const f32x4 gv = gp[q4]; z += gv[0] * wg[q4 * 4] + gv[1] * wg[q4 * 4 + 1] + gv[2] * wg[q4 * 4 + 2] + gv[3] * wg[q4 * 4 + 3]; }
            { const float z2 = z * LOG2E; cum += (fminf(z2, 0.f) - __builtin_amdgcn_logf(1.0f + __builtin_amdgcn_exp2f(-fabsf(z2)))) * (1.0f / 16.0f); }
            float kv = bf2f(rk[jj]);
            if (lat) {
                float cs, sn;
                if (axis == 0) { cs = cs_row; sn = sn_row; } else { __sincosf((float)i * freq, &sn, &cs); }
                const float kp2 = bf2f(rkp[jj]);
                kv = first ? kv * cs - kp2 * sn : kv * cs + kp2 * sn;
                float qv = bf2f(rq[jj]); const float qp2 = bf2f(rqp[jj]);
                qv = (first ? qv * cs - qp2 * sn : qv * cs + qp2 * sn) * 0.0625f;
                const float qd = qv * __builtin_amdgcn_exp2f(cum);
                const bf16_t qb = (bf16_t)(cvt_pk_bf16(qd, 0.f) & 0xffffu);
                QD[(size_t)i * 256 + d] = qb; QDs[i * PREP_PITCH + d] = qb;
            }
            const float ki = kv * __builtin_amdgcn_exp2f(-cum);
            if (lat) KIs[i * PREP_PITCH + d] = (bf16_t)(cvt_pk_bf16(ki, 0.f) & 0xffffu);
            ke[jj] = ki;
        }
        u32x4 o;
        if (dir == 0) { o.x = cvt_pk_bf16(ke[0], ke[1]); o.y = cvt_pk_bf16(ke[2], ke[3]); o.z = cvt_pk_bf16(ke[4], ke[5]); o.w = cvt_pk_bf16(ke[6], ke[7]); *(u32x4*)(KET + (size_t)d * 64 + n8 * 8) = o; }
        else { o.x = cvt_pk_bf16(ke[7], ke[6]); o.y = cvt_pk_bf16(ke[5], ke[4]); o.z = cvt_pk_bf16(ke[3], ke[2]); o.w = cvt_pk_bf16(ke[1], ke[0]); *(u32x4*)(KET + (size_t)d * 64 + (7 - n8) * 8) = o; }
#pragma unroll
        for (int jj = 0; jj < 8; ++jj) { rk[jj] = nk_[jj]; rkp[jj] = nkp[jj]; rq[jj] = nq_[jj]; rqp[jj] = nqp[jj]; }
    }
#undef PREP_LOAD
    ((float*)(p.ws + WS_DEC))[gla_idx(b, h, dir, cid) * 256 + d] = __builtin_amdgcn_exp2f(cum);
    {
        bf16_t* VT = (bf16_t*)(p.ws + WS_VT) + (size_t)((b * 4 + h) * NCH + cid) * (512 * 64);
        const bf16_t* vsrc = PROJ + (size_t)rowbase * LDP + OFF_V + h * 512 + tid;
        unsigned short e[64];
#pragma unroll
        for (int t = 0; t < 64; ++t) e[t] = vsrc[(size_t)t * LDP];
#pragma unroll
        for (int n8 = 0; n8 < 8; ++n8) {
            u32x4 o; o.x = e[n8 * 8] | ((unsigned)e[n8 * 8 + 1] << 16); o.y = e[n8 * 8 + 2] | ((unsigned)e[n8 * 8 + 3] << 16); o.z = e[n8 * 8 + 4] | ((unsigned)e[n8 * 8 + 5] << 16); o.w = e[n8 * 8 + 6] | ((unsigned)e[n8 * 8 + 7] << 16);
            *(u32x4*)(VT + (size_t)tid * 64 + n8 * 8) = o;
        }
    }
    __syncthreads();
    if (lat) {
        const int wdir = wv >> 2, ib = wv & 3, fr = lane & 15, g = lane >> 4;
        const LAS bf16_t* Qs = (const LAS bf16_t*)(lds + 8192 + wdir * 2 * PREP_TILE);
        const LAS bf16_t* Ks = (const LAS bf16_t*)(lds + 8192 + wdir * 2 * PREP_TILE + PREP_TILE);
        f32x4 acc[4];
#pragma unroll
        for (int nb = 0; nb < 4; ++nb) acc[nb] = (f32x4){0.f, 0.f, 0.f, 0.f};
#pragma unroll
        for (int kk = 0; kk < 8; ++kk) {
            const bf16x8 qf = *(const LAS bf16x8*)(Qs + (16 * ib + fr) * PREP_PITCH + 32 * kk + 8 * g);
#pragma unroll
            for (int nb = 0; nb < 4; ++nb) {
                const bf16x8 kf = *(const LAS bf16x8*)(Ks + (16 * nb + fr) * PREP_PITCH + 32 * kk + 8 * g);
                acc[nb] = __builtin_amdgcn_mfma_f32_16x16x32_bf16(kf, qf, acc[nb], 0, 0, 0);
            }
        }
        bf16_t* PM = (bf16_t*)(p.ws + WS_PM) + gla_idx(b, h, wdir, cid) * 4096;
        const int i = 16 * ib + fr;
#pragma unroll
        for (int nb = 0; nb < 4; ++nb) {
            float v[4];
#pragma unroll
            for (int r = 0; r < 4; ++r) { const int j = 16 * nb + 4 * g + r; const bool keep = wdir ? (j >= i) : (j <= i); v[r] = keep ? acc[nb][r] : 0.f; }
            u32x2 o; o.x = cvt_pk_bf16(v[0], v[1]); o.y = cvt_pk_bf16(v[2], v[3]);
            *(u32x2*)(PM + (size_t)i * 64 + 16 * nb + 4 * g) = o;
        }
    }
    __syncthreads();
}
__device__ __forceinline__ void na_vt_item(const Params& p, int item) {
    const int tid = threadIdx.x; const int blk = item % NCH, b = item / NCH; const bool lat = blk >= 4;
    const int rowbase = lat ? b * SEQ + (blk - 4) * 64 : NLAT + b * CTXL + blk * 64;
    const bf16_t* PROJ = (const bf16_t*)(p.ws + WS_PROJ);
    const int c = 2 * tid, h = c >> 6, dv = c & 63;
    const bf16_t* src = PROJ + (size_t)rowbase * LDP + OFF_NV + c;
    bf16_t* dst; int pitch;
    if (lat) { dst = (bf16_t*)(p.ws + WS_NVTL) + ((size_t)((b * 16 + h) * 64 + (blk - 4)) * 64 + dv) * 64; pitch = 64; }
    else { dst = (bf16_t*)(p.ws + WS_NVTC) + ((size_t)(b * 16 + h) * 64 + dv) * 256 + blk * 64; pitch = 256; }
    unsigned e[64];
#pragma unroll
    for (int t = 0; t < 64; ++t) e[t] = *(const unsigned*)(src + (size_t)t * LDP);
#pragma unroll
    for (int n8 = 0; n8 < 8; ++n8) {
        const unsigned* q = e + n8 * 8;
        u32x4 lo, hi;
        lo.x = (q[0] & 0xffffu) | (q[1] << 16); lo.y = (q[2] & 0xffffu) | (q[3] << 16); lo.z = (q[4] & 0xffffu) | (q[5] << 16); lo.w = (q[6] & 0xffffu) | (q[7] << 16);
        hi.x = (q[0] >> 16) | (q[1] & 0xffff0000u); hi.y = (q[2] >> 16) | (q[3] & 0xffff0000u); hi.z = (q[4] >> 16) | (q[5] & 0xffff0000u); hi.w = (q[6] >> 16) | (q[7] & 0xffff0000u);
        *(u32x4*)(dst + n8 * 8) = lo; *(u32x4*)(dst + pitch + n8 * 8) = hi;
    }
}

constexpr int ST_PITCH = 264, VT_PITCH = 72;
constexpr int SC_ST = 0, SC_QD = 64 * ST_PITCH * 2, SC_VT = 2 * 64 * ST_PITCH * 2, SC_PM = SC_VT + 64 * VT_PITCH * 2, SC_KT = SC_PM + 64 * VT_PITCH * 2, SC_DC = SC_KT + 256 * VT_PITCH * 2;
__device__ __forceinline__ int scan_cid(int n, int dir) { return n < 4 ? (dir ? 3 - n : n) : (dir ? 67 - (n - 4) : n); }

__device__ __forceinline__ void gla_scan_task(LAS uchar* lds, const Params& p, int task) {
    const int tid = threadIdx.x, w = __builtin_amdgcn_readfirstlane(tid >> 6), lane = tid & 63;
    const int xcd = task & 7, jj = task >> 3, combo = xcd * 2 + (jj >> 3), sl = jj & 7;
    const int b = combo >> 3, h = (combo >> 1) & 3, dir = combo & 1, dv0 = sl * 64;
    const int l32 = lane & 31, hf = lane >> 5;
    const bool isU = w >= 4; const int u = w & 3;
    const int dvb = u >> 1, ibk = u & 1;
    LAS bf16_t* ST = (LAS bf16_t*)(lds + SC_ST); LAS bf16_t* QDs = (LAS bf16_t*)(lds + SC_QD); LAS bf16_t* VTs = (LAS bf16_t*)(lds + SC_VT); LAS bf16_t* PMs = (LAS bf16_t*)(lds + SC_PM);
    LAS bf16_t* KTs = (LAS bf16_t*)(lds + SC_KT); LAS float* DCs = (LAS float*)(lds + SC_DC);
    for (int i = tid; i < 64 * ST_PITCH / 2; i += NTHR) ((LAS unsigned*)lds)[i] = 0u;
    const bf16_t* QDb = (const bf16_t*)(p.ws + WS_QD); const bf16_t* KITb = (const bf16_t*)(p.ws + WS_KET); const bf16_t* PMb = (const bf16_t*)(p.ws + WS_PM);
    const float* DECb = (const float*)(p.ws + WS_DEC); const bf16_t* VTb = (const bf16_t*)(p.ws + WS_VT);
    bf16_t* Ob = (bf16_t*)(p.ws + (dir ? WS_OB : WS_OF));
    f32x16 S00, S01, S10, S11;
#pragma unroll
    for (int i = 0; i < 16; ++i) { S00[i] = 0.f; S01[i] = 0.f; S10[i] = 0.f; S11[i] = 0.f; }
    const int vrow = tid >> 3, vc = (tid & 7) * 8;
    u32x4 qd_r[4], vt_r, pm_r, kt_r[4]; f32x4 dc_r;
#define SC_FETCH(n_) do { const int cid_ = scan_cid((n_), dir); const size_t gi_ = gla_idx(b, h, dir, cid_); \
        vt_r = *(const u32x4*)(VTb + (size_t)((b * 4 + h) * NCH + cid_) * (512 * 64) + (size_t)(dv0 + vrow) * 64 + vc); \
        _Pragma("unroll") for (int k4 = 0; k4 < 4; ++k4) kt_r[k4] = *(const u32x4*)(KITb + gi_ * (256 * 64) + (size_t)(tid + 512 * k4) * 8); \
        if (tid < 64) dc_r = *(const f32x4*)(DECb + gi_ * 256 + 4 * tid); \
        if ((n_) >= 4) { pm_r = *(const u32x4*)(PMb + gi_ * 4096 + vrow * 64 + vc); \
            _Pragma("unroll") for (int k4 = 0; k4 < 4; ++k4) { const int ch_ = tid + 512 * k4; qd_r[k4] = *(const u32x4*)(QDb + gi_ * (64 * 256) + (size_t)(ch_ >> 5) * 256 + (ch_ & 31) * 8); } } } while (0)
#define SC_COMMIT(n_) do { *(LAS u32x4*)(VTs + vrow * VT_PITCH + vc) = vt_r; \
        _Pragma("unroll") for (int k4 = 0; k4 < 4; ++k4) { const int ch_ = tid + 512 * k4; *(LAS u32x4*)(KTs + (ch_ >> 3) * VT_PITCH + (ch_ & 7) * 8) = kt_r[k4]; } \
        if (tid < 64) *(LAS f32x4*)(DCs + 4 * tid) = dc_r; \
        if ((n_) >= 4) { *(LAS u32x4*)(PMs + vrow * VT_PITCH + vc) = pm_r; \
            _Pragma("unroll") for (int k4 = 0; k4 < 4; ++k4) { const int ch_ = tid + 512 * k4; *(LAS u32x4*)(QDs + (ch_ >> 5) * ST_PITCH + (ch_ & 31) * 8) = qd_r[k4]; } } } while (0)
    SC_FETCH(0);
    SC_COMMIT(0);
    __syncthreads();
    for (int n = 0; n < NCH; ++n) {
        if (n + 1 < NCH) SC_FETCH(n + 1);
        if (isU) {
            f32x4 dec[2][4]; bf16x8 kit[8];
#pragma unroll
            for (int rb = 0; rb < 2; ++rb)
#pragma unroll
                for (int j4 = 0; j4 < 4; ++j4) dec[rb][j4] = *(const LAS f32x4*)(DCs + 64 * u + 32 * rb + 8 * j4 + 4 * hf);
#pragma unroll
            for (int rb = 0; rb < 2; ++rb)
#pragma unroll
                for (int kk = 0; kk < 4; ++kk) kit[rb * 4 + kk] = *(const LAS bf16x8*)(KTs + (64 * u + 32 * rb + l32) * VT_PITCH + 16 * kk + 8 * hf);
            const LAS bf16_t* vb0 = VTs + l32 * VT_PITCH + 8 * hf; const LAS bf16_t* vb1 = vb0 + 32 * VT_PITCH;
            bf16x8 ua[4], ub[4];
#pragma unroll
            for (int kk = 0; kk < 4; ++kk) { ua[kk] = *(const LAS bf16x8*)(vb0 + 16 * kk); ub[kk] = *(const LAS bf16x8*)(vb1 + 16 * kk); }
#pragma unroll
            for (int kk = 0; kk < 4; ++kk) {
                S00 = __builtin_amdgcn_mfma_f32_32x32x16_bf16(kit[kk], ua[kk], S00, 0, 0, 0);
                S01 = __builtin_amdgcn_mfma_f32_32x32x16_bf16(kit[kk], ub[kk], S01, 0, 0, 0);
                S10 = __builtin_amdgcn_mfma_f32_32x32x16_bf16(kit[4 + kk], ua[kk], S10, 0, 0, 0);
                S11 = __builtin_amdgcn_mfma_f32_32x32x16_bf16(kit[4 + kk], ub[kk], S11, 0, 0, 0); }
#pragma unroll
            for (int j4 = 0; j4 < 4; ++j4)
#pragma unroll
                for (int r = 0; r < 4; ++r) { S00[j4 * 4 + r] *= dec[0][j4][r]; S01[j4 * 4 + r] *= dec[0][j4][r]; S10[j4 * 4 + r] *= dec[1][j4][r]; S11[j4 * 4 + r] *= dec[1][j4][r]; }
        } else if (n >= 4) {
            const int cid = scan_cid(n, dir);
            f32x16 o;
#pragma unroll
            for (int i = 0; i < 16; ++i) o[i] = 0.f;
            const LAS bf16_t* sa = ST + (32 * dvb + l32) * ST_PITCH + 8 * hf; const LAS bf16_t* qb_ = QDs + (32 * ibk + l32) * ST_PITCH + 8 * hf;
            const LAS bf16_t* va = VTs + (32 * dvb + l32) * VT_PITCH + 8 * hf; const LAS bf16_t* pb = PMs + (32 * ibk + l32) * VT_PITCH + 8 * hf;
#pragma unroll
            for (int half = 0; half < 2; ++half) {
                bf16x8 fa[8], fb[8];
#pragma unroll
                for (int kk = 0; kk < 8; ++kk) { fa[kk] = *(const LAS bf16x8*)(sa + 16 * (half * 8 + kk)); fb[kk] = *(const LAS bf16x8*)(qb_ + 16 * (half * 8 + kk)); }
#pragma unroll
                for (int kk = 0; kk < 8; ++kk) o = __builtin_amdgcn_mfma_f32_32x32x16_bf16(fa[kk], fb[kk], o, 0, 0, 0);
            }
            {
                bf16x8 fa[4], fb[4];
#pragma unroll
                for (int q = 0; q < 4; ++q) { fa[q] = *(const LAS bf16x8*)(va + 16 * q); fb[q] = *(const LAS bf16x8*)(pb + 16 * q); }
#pragma unroll
                for (int q = 0; q < 4; ++q) o = __builtin_amdgcn_mfma_f32_32x32x16_bf16(fa[q], fb[q], o, 0, 0, 0);
            }
            bf16_t* op = Ob + (size_t)(b * SEQ + (cid - 4) * 64 + 32 * ibk + l32) * D + h * 512 + dv0 + 32 * dvb + 4 * hf;
#pragma unroll
            for (int j4 = 0; j4 < 4; ++j4) { u32x2 ov; ov.x = cvt_pk_bf16(o[j4 * 4], o[j4 * 4 + 1]); ov.y = cvt_pk_bf16(o[j4 * 4 + 2], o[j4 * 4 + 3]); *(u32x2*)(op + 8 * j4) = ov; }
        }
        __syncthreads();
        if (isU) {
            LAS bf16_t* stw = ST + l32 * ST_PITCH + 64 * u + 4 * hf;
#pragma unroll
            for (int j4 = 0; j4 < 4; ++j4) { u32x2 sv;
                sv.x = cvt_pk_bf16(S00[j4 * 4], S00[j4 * 4 + 1]); sv.y = cvt_pk_bf16(S00[j4 * 4 + 2], S00[j4 * 4 + 3]); *(LAS u32x2*)(stw + 8 * j4) = sv;
                sv.x = cvt_pk_bf16(S01[j4 * 4], S01[j4 * 4 + 1]); sv.y = cvt_pk_bf16(S01[j4 * 4 + 2], S01[j4 * 4 + 3]); *(LAS u32x2*)(stw + 32 * ST_PITCH + 8 * j4) = sv;
                sv.x = cvt_pk_bf16(S10[j4 * 4], S10[j4 * 4 + 1]); sv.y = cvt_pk_bf16(S10[j4 * 4 + 2], S10[j4 * 4 + 3]); *(LAS u32x2*)(stw + 32 + 8 * j4) = sv;
                sv.x = cvt_pk_bf16(S11[j4 * 4], S11[j4 * 4 + 1]); sv.y = cvt_pk_bf16(S11[j4 * 4 + 2], S11[j4 * 4 + 3]); *(LAS u32x2*)(stw + 32 * ST_PITCH + 32 + 8 * j4) = sv; }
        }
        if (n + 1 < NCH) SC_COMMIT(n + 1);
        __syncthreads();
    }
#undef SC_FETCH
#undef SC_COMMIT
}

constexpr int NA_KV = 24576, NA_KP = 72, NA_CP = 264;
constexpr int NA_QW = 20480;
__device__ __forceinline__ void na_item(LAS uchar* lds, const Params& p, int it) {
    const int tid = threadIdx.x, w = tid >> 6, lane = tid & 63, fr = lane & 15, g = lane >> 4;
    const int r = it & 63, h = (it >> 6) & 15, b = it >> 10;
    const int qb = w & 3, kind = w >> 2;
    LAS float* rpbS = (LAS float*)lds;
    LAS float* CBm = (LAS float*)(lds + 2048);
    LAS float* CBl = (LAS float*)(lds + 2048 + 256);
    LAS float* CBo = (LAS float*)(lds + 4096);
    LAS bf16_t* KL = (LAS bf16_t*)(lds + NA_KV);
    LAS bf16_t* KC = (LAS bf16_t*)(lds + NA_KV + 512 * NA_KP * 2);
    const bf16_t* PROJ = (const bf16_t*)(p.ws + WS_PROJ);
    const int rs = min(max(r - 4, 0), 56);
    u32x4 st[12];
    {
        const int c8 = (tid & 7) * 8;
#pragma unroll
        for (int k = 0; k < 8; ++k) { const int key = (tid >> 3) + 64 * k; st[k] = *(const u32x4*)(PROJ + (size_t)(b * SEQ + (rs + k) * 64 + (tid >> 3)) * LDP + OFF_NK + h * 64 + c8); (void)key; }
#pragma unroll
        for (int k = 0; k < 4; ++k) st[8 + k] = *(const u32x4*)(PROJ + (size_t)(NLAT + b * CTXL + (tid >> 3) + 64 * k) * LDP + OFF_NK + h * 64 + c8);
    }
    const int c0 = qb == 0 ? 0 : (qb == 1 ? 8 : (qb == 2 ? 24 : 32));
    const int j = 16 * qb + fr;
    const int cs = min(max(j - 8, 0), 48);
    const bf16_t* qrow = PROJ + (size_t)(b * SEQ + r * 64 + j) * LDP + OFF_NQ + h * 64 + 8 * g;
    const bf16x8 q0 = *(const bf16x8*)qrow, q1 = *(const bf16x8*)(qrow + 32);
    if (tid < 480) { const int rw = tid >> 5, cc = tid & 31; rpbS[tid] = cc < 31 ? p.na_rpb[h * 465 + rw * 31 + cc] * LOG2E : -1e30f; }
    {
        const int c8 = (tid & 7) * 8, kr = tid >> 3;
#pragma unroll
        for (int k = 0; k < 8; ++k) *(LAS u32x4*)(KL + (kr + 64 * k) * NA_KP + c8) = st[k];
#pragma unroll
        for (int k = 0; k < 4; ++k) *(LAS u32x4*)(KC + (kr + 64 * k) * NA_KP + c8) = st[8 + k];
    }
    __syncthreads();
    {
        const bf16_t* vl = (const bf16_t*)(p.ws + WS_NVTL) + (size_t)((b * 16 + h) * 64 + rs) * (64 * 64);
#pragma unroll
        for (int k = 0; k < 8; ++k) st[k] = *(const u32x4*)(vl + (size_t)(tid + 512 * k) * 8);
        const bf16_t* vc = (const bf16_t*)(p.ws + WS_NVTC) + (size_t)(b * 16 + h) * (64 * 256);
#pragma unroll
        for (int k = 0; k < 4; ++k) st[8 + k] = *(const u32x4*)(vc + (size_t)(tid + 512 * k) * 8);
    }
    const int mk = 8 * (fr >> 2) + (fr & 3);
    f32x4 s[16];
#pragma unroll
    for (int kb = 0; kb < 16; ++kb) {
        const int pp = kb >> 1, e = kb & 1;
        const LAS bf16_t* krow = kind == 0 ? KL + (pp * 64 + c0 + mk + 4 * e) * NA_KP + 8 * g : KC + (32 * pp + mk + 4 * e) * NA_KP + 8 * g;
        const bf16x8 k0 = *(const LAS bf16x8*)krow, k1 = *(const LAS bf16x8*)(krow + 32);
        f32x4 a = (f32x4){0.f, 0.f, 0.f, 0.f};
        a = __builtin_amdgcn_mfma_f32_16x16x32_bf16(k0, q0, a, 0, 0, 0);
        a = __builtin_amdgcn_mfma_f32_16x16x32_bf16(k1, q1, a, 0, 0, 0);
        s[kb] = a;
    }
    const float sc = 0.125f * LOG2E;
    float mx = -1e30f;
    if (kind == 0) {
        int colb[8];
        const int rowbase = (rs - r + 7) * 32;
#pragma unroll
        for (int x = 0; x < 8; ++x) { const int kc = c0 + 8 * g + x; const bool ok = (kc >= cs) && (kc < cs + 16); colb[x] = rowbase + (ok ? kc - j + 15 : 31); }
#pragma unroll
        for (int kb = 0; kb < 16; ++kb) {
            const int pp = kb >> 1, e = kb & 1;
#pragma unroll
            for (int i = 0; i < 4; ++i) { const float t = s[kb][i] * sc + rpbS[colb[4 * e + i] + pp * 32]; s[kb][i] = t; mx = fmaxf(mx, t); }
        }
    } else {
#pragma unroll
        for (int kb = 0; kb < 16; ++kb)
#pragma unroll
            for (int i = 0; i < 4; ++i) { const float t = s[kb][i] * sc; s[kb][i] = t; mx = fmaxf(mx, t); }
    }
    mx = fmaxf(mx, __shfl_xor(mx, 16)); mx = fmaxf(mx, __shfl_xor(mx, 32));
    float l = 0.f;
#pragma unroll
    for (int kb = 0; kb < 16; ++kb)
#pragma unroll
        for (int i = 0; i < 4; ++i) { const float e2 = __builtin_amdgcn_exp2f(s[kb][i] - mx); s[kb][i] = e2; l += e2; }
    l += __shfl_xor(l, 16); l += __shfl_xor(l, 32);
    __syncthreads();
    {
#pragma unroll
        for (int k = 0; k < 8; ++k) { const int ch = tid + 512 * k; *(LAS u32x4*)(KL + (ch >> 3) * NA_KP + (ch & 7) * 8) = st[k]; }
#pragma unroll
        for (int k = 0; k < 4; ++k) { const int ch = tid + 512 * k; *(LAS u32x4*)(KC + (ch >> 5) * NA_CP + (ch & 31) * 8) = st[8 + k]; }
    }
    __syncthreads();
    f32x4 o[4];
#pragma unroll
    for (int dvb = 0; dvb < 4; ++dvb) o[dvb] = (f32x4){0.f, 0.f, 0.f, 0.f};
#pragma unroll
    for (int pp = 0; pp < 8; ++pp) {
        u32x4 pk; pk.x = cvt_pk_bf16(s[2 * pp][0], s[2 * pp][1]); pk.y = cvt_pk_bf16(s[2 * pp][2], s[2 * pp][3]); pk.z = cvt_pk_bf16(s[2 * pp + 1][0], s[2 * pp + 1][1]); pk.w = cvt_pk_bf16(s[2 * pp + 1][2], s[2 * pp + 1][3]);
        const bf16x8 pf = as_bf16x8(pk);
#pragma unroll
        for (int dvb = 0; dvb < 4; ++dvb) {
            const LAS bf16_t* vp = kind == 0 ? KL + (pp * 64 + 16 * dvb + fr) * NA_KP + c0 + 8 * g : KC + (16 * dvb + fr) * NA_CP + 32 * pp + 8 * g;
            o[dvb] = __builtin_amdgcn_mfma_f32_16x16x32_bf16(*(const LAS bf16x8*)vp, pf, o[dvb], 0, 0, 0);
        }
    }
    if (kind == 1) {
        if (g == 0) { CBm[qb * 16 + fr] = mx; CBl[qb * 16 + fr] = l; }
#pragma unroll
        for (int dvb = 0; dvb < 4; ++dvb) *(LAS f32x4*)(CBo + (qb * 64 + lane) * 16 + dvb * 4) = o[dvb];
    }
    __syncthreads();
    if (kind == 0) {
        const float m2 = CBm[qb * 16 + fr], l2 = CBl[qb * 16 + fr];
        const float M = fmaxf(mx, m2), a1 = __builtin_amdgcn_exp2f(mx - M), a2 = __builtin_amdgcn_exp2f(m2 - M);
        const float inv = fast_rcp(l * a1 + l2 * a2);
        bf16_t* op = (bf16_t*)(p.ws + WS_NAO) + (size_t)(b * SEQ + r * 64 + j) * 1024 + h * 64 + 4 * g;
#pragma unroll
        for (int dvb = 0; dvb < 4; ++dvb) {
            const f32x4 o2 = *(const LAS f32x4*)(CBo + (qb * 64 + lane) * 16 + dvb * 4);
            const f32x4 v = (o[dvb] * a1 + o2 * a2) * inv;
            u32x2 ov; ov.x = cvt_pk_bf16(v[0], v[1]); ov.y = cvt_pk_bf16(v[2], v[3]); *(u32x2*)(op + 16 * dvb) = ov;
        }
    }
    __syncthreads();
}

__device__ __forceinline__ void phase_readout(const Params& p) {
    const int w = threadIdx.x >> 6, lane = threadIdx.x & 63;
    const bf16_t* OF = (const bf16_t*)(p.ws + WS_OF); const bf16_t* OB = (const bf16_t*)(p.ws + WS_OB); const bf16_t* PROJ = (const bf16_t*)(p.ws + WS_PROJ);
    bf16_t* AG = (bf16_t*)(p.ws + WS_AG);
    for (int item = blockIdx.x; item < NLAT / 8; item += gridDim.x) {
        const int row = item * 8 + w;
        u32x4 av[4], bv[4], rv4[4];
#pragma unroll
        for (int h = 0; h < 4; ++h) { const int col = h * 512 + lane * 8;
            av[h] = *(const u32x4*)(OF + (size_t)row * D + col); bv[h] = *(const u32x4*)(OB + (size_t)row * D + col); rv4[h] = *(const u32x4*)(PROJ + (size_t)row * LDP + OFF_R + col); }
        const f32x4 g0 = *(const f32x4*)(p.gla_norm_g + lane * 8), g1 = *(const f32x4*)(p.gla_norm_g + lane * 8 + 4);
#pragma unroll
        for (int h = 0; h < 4; ++h) {
            const int col = h * 512 + lane * 8;
            const u32x4 a = av[h], bq = bv[h], rr = rv4[h];
            float o[8];
            o[0] = bflo(a.x) + bflo(bq.x); o[1] = bfhi(a.x) + bfhi(bq.x); o[2] = bflo(a.y) + bflo(bq.y); o[3] = bfhi(a.y) + bfhi(bq.y);
            o[4] = bflo(a.z) + bflo(bq.z); o[5] = bfhi(a.z) + bfhi(bq.z); o[6] = bflo(a.w) + bflo(bq.w); o[7] = bfhi(a.w) + bfhi(bq.w);
            float ss = 0.f;
#pragma unroll
            for (int i = 0; i < 8; ++i) ss += o[i] * o[i];
            ss = wave_sum(ss); const float rstd = rsqrtf(ss * (1.0f / 512.0f) + EPS);
            const float rv[8] = {bflo(rr.x), bfhi(rr.x), bflo(rr.y), bfhi(rr.y), bflo(rr.z), bfhi(rr.z), bflo(rr.w), bfhi(rr.w)};
            float v[8];
#pragma unroll
            for (int i = 0; i < 8; ++i) v[i] = o[i] * rstd * (i < 4 ? g0[i] : g1[i - 4]) * siluf_(rv[i]);
            u32x4 ov; ov.x = cvt_pk_bf16(v[0], v[1]); ov.y = cvt_pk_bf16(v[2], v[3]); ov.z = cvt_pk_bf16(v[4], v[5]); ov.w = cvt_pk_bf16(v[6], v[7]);
            *(u32x4*)(AG + (size_t)row * D + col) = ov;
        }
    }
}

constexpr int N_PHASES = 15;
__global__ void __launch_bounds__(NTHR, 2) mk_fwd(Params p) {
    extern __shared__ __attribute__((aligned(16))) uchar lds_raw[];
    LAS uchar* lds = (LAS uchar*)lds_raw;
    const int G = gridDim.x, bx = blockIdx.x;
    uchar* ws = p.ws;
#define IN(k) (p.ph_lo <= (k) && (k) < p.ph_hi)
    LAS unsigned* xbst = (LAS unsigned*)(lds + LDS_BYTES - 16);
    if (threadIdx.x == 0) { xbst[0] = 0u; xbst[1] = 0u; xbst[2] = 0u; xbst[3] = 0u; }
    __syncthreads();
    const XcdBarrier xbar = xcd_barrier_post((unsigned*)(ws + WS_BAR), (volatile LAS unsigned*)xbst);
    if (p.ph_lo < 0) cg::this_grid().sync();
#define SEAM(k) do { if (IN(k) && IN((k) + 1)) { xcd_barrier(xbar); for (int xs_ = 0; xs_ < MK_EXTRA_SYNC; ++xs_) xcd_barrier(xbar); } } while (0)
#define REPS(k) for (int rep_ = 0; rep_ < 1 + ((MK_REP_MASK >> (k)) & 1); ++rep_)
    bf16_t* A = (bf16_t*)(ws + WS_A); bf16_t* H = (bf16_t*)(ws + WS_H); bf16_t* Y = (bf16_t*)(ws + WS_Y); bf16_t* YC = (bf16_t*)(ws + WS_YC);
    bf16_t* PROJ = (bf16_t*)(ws + WS_PROJ);

    if (IN(0)) REPS(0) { phase_prologue(lds, p); } SEAM(0);
    if (IN(1)) REPS(1) { phase_prenorm1(p); } SEAM(1);
    if (IN(2)) REPS(2) {
        { pg8::Gemm g{A, (const bf16_t*)(ws + WS_WGU1), NLAT, 2 * DFF, D, D, D}; pg8::StaticOrder S; S.init(NLAT, 2 * DFF, G, bx); pg8::EpiSiluMul E{H, DFF}; pg8::gemm_phase(lds, g, S, E); }
        { pg8::Gemm g{A + (size_t)NLAT * D, (const bf16_t*)(ws + WS_WGU1), NCTX, 2 * DFF, D, D, D}; pg8::StaticOrder S; S.init(NCTX, 2 * DFF, G, G - 1 - bx); pg8::EpiSiluMul E{H + (size_t)NLAT * DFF, DFF}; pg8::gemm_phase(lds, g, S, E); }
    } SEAM(2);
    if (IN(3)) REPS(3) {
        { pg8::Gemm g{H, (const bf16_t*)(ws + WS_WD1), NLAT, D, DFF, DFF, DFF}; pg8::StaticOrder S; S.init(NLAT, D, G, bx); pg8::EpiBf16 E{Y, D}; pg8::gemm_phase(lds, g, S, E); }
        for (int sp = 0; sp < 4; ++sp) { pg8::Gemm g{H + (size_t)NLAT * DFF + sp * 1408, (const bf16_t*)(ws + WS_WD1) + sp * 1408, NCTX, D, 1408, DFF, DFF}; pg8::StaticOrder S; S.init(NCTX, D, G, (bx + G - 16 * sp) % G);
            pg8::EpiBf16 E{YC + (size_t)sp * NCTX * D, D}; pg8::gemm_phase(lds, g, S, E); }
    } SEAM(3);
    if (IN(4)) REPS(4) { phase_post<0>(p); } SEAM(4);
    if (IN(5)) REPS(5) {
        { pg8::Gemm g{A, (const bf16_t*)(ws + WS_WIN), NLAT, LDP, D, D, D}; pg8::StaticOrder S; S.init(NLAT, LDP, G, bx); pg8::EpiBf16 E{PROJ, LDP}; pg8::gemm_phase(lds, g, S, E); }
        { pg8::Gemm g{A + (size_t)NLAT * D, (const bf16_t*)(ws + WS_WIN), NCTX, NCTXCOLS, D, D, D}; pg8::StaticOrder S; S.init(NCTX, NCTXCOLS, G, G - 1 - bx); pg8::EpiBf16 E{PROJ + (size_t)NLAT * LDP, LDP}; pg8::gemm_phase(lds, g, S, E); }
    } SEAM(5);
    if (IN(6)) REPS(6) {
        const int n_items = NB * NCH * 4 + NB * NCH;
        for (int it = bx; it < n_items; it += G) { if (it < NB * NCH * 4) gla_prep_item(lds, p, it); else na_vt_item(p, it - NB * NCH * 4); }
    } SEAM(6);
    if (IN(7)) REPS(7) {
        for (int t = bx; t < 128; t += G) gla_scan_task(lds, p, t);
        __syncthreads();
        {
            unsigned* qhead = (unsigned*)(ws + WS_CTR);
            if (threadIdx.x == 0) *(LAS unsigned*)(lds + NA_QW) = atomicAdd(qhead, 1u);
            __syncthreads();
            unsigned it = *(LAS unsigned*)(lds + NA_QW);
            __syncthreads();
            while (it < (unsigned)(NB * 16 * 64)) {
                unsigned nxt = 0u;
                if (threadIdx.x == 0) nxt = atomicAdd(qhead, 1u);
                na_item(lds, p, (int)it);
                if (threadIdx.x == 0) *(LAS unsigned*)(lds + NA_QW) = nxt;
                __syncthreads();
                it = *(LAS unsigned*)(lds + NA_QW);
                __syncthreads();
            }
        }
    } SEAM(7);
    if (IN(8)) REPS(8) {
        phase_readout(p);
        { pg8::Gemm g{(const bf16_t*)(ws + WS_NAO), (const bf16_t*)(ws + WS_WNAO), NLAT, D, 1024, 1024, 1024}; pg8::StaticOrder S; S.init(NLAT, D, G, bx); pg8::EpiGate2 E{(bf16_t*)(ws + WS_G2), PROJ + OFF_M2}; pg8::gemm_phase(lds, g, S, E); }
    } SEAM(8);
    if (IN(9)) REPS(9) { pg8::Gemm g{(const bf16_t*)(ws + WS_AG), (const bf16_t*)(ws + WS_WGLAO), NLAT, D, D, D, D}; pg8::StaticOrder S; S.init(NLAT, D, G, bx); pg8::EpiMerge E{(bf16_t*)(ws + WS_MG), PROJ + OFF_M1, (const bf16_t*)(ws + WS_G2)}; pg8::gemm_phase(lds, g, S, E); } SEAM(9);
    if (IN(10)) REPS(10) { pg8::Gemm g{(const bf16_t*)(ws + WS_MG), (const bf16_t*)(ws + WS_WOUT), NLAT, D, D, D, D}; pg8::StaticOrder S; S.init(NLAT, D, G, bx); pg8::EpiBf16 E{Y, D}; pg8::gemm_phase(lds, g, S, E); } SEAM(10);
    if (IN(11)) REPS(11) { phase_post<1>(p); } SEAM(11);
    if (IN(12)) REPS(12) { pg8::Gemm g{A, (const bf16_t*)(ws + WS_WGU2), NLAT, 2 * DFF, D, D, D}; pg8::StaticOrder S; S.init(NLAT, 2 * DFF, G, bx); pg8::EpiSiluMul E{H, DFF}; pg8::gemm_phase(lds, g, S, E); } SEAM(12);
    if (IN(13)) REPS(13) { pg8::Gemm g{H, (const bf16_t*)(ws + WS_WD2), NLAT, D, DFF, DFF, DFF}; pg8::StaticOrder S; S.init(NLAT, D, G, bx); pg8::EpiBf16 E{Y, D}; pg8::gemm_phase(lds, g, S, E); } SEAM(13);
    if (IN(14)) REPS(14) { phase_post<2>(p); }
#undef IN
#undef SEAM
}


#ifndef MK_RUN
#define MK_RUN N_PHASES
#endif
#ifndef MK_COOP
#define MK_COOP 1
#endif
extern "C" void kernel_launch(void* const* d_in, const int* in_sizes, int n_in, void* d_out, int out_size, void* d_ws, size_t ws_size, hipStream_t stream) {
    static int grid = 0;
    if (grid == 0) {
        if (n_in != 18 || ws_size < WS_END) { fprintf(stderr, "kernel_launch: need 18 inputs and %zu bytes of workspace (got %d, %zu)\n", (size_t)WS_END, n_in, ws_size); grid = -1; return; }
        int dev = 0, cus = 0, per_cu = 0;
        hipGetDevice(&dev); hipDeviceGetAttribute(&cus, hipDeviceAttributeMultiprocessorCount, dev);
        if (hipFuncSetAttribute((const void*)mk_fwd, hipFuncAttributeMaxDynamicSharedMemorySize, LDS_BYTES) != hipSuccess) { fprintf(stderr, "kernel_launch: hipFuncSetAttribute failed\n"); grid = -1; return; }
        if (hipOccupancyMaxActiveBlocksPerMultiprocessor(&per_cu, (const void*)mk_fwd, NTHR, LDS_BYTES) != hipSuccess || per_cu < 1) { fprintf(stderr, "kernel_launch: occupancy query gave %d\n", per_cu); per_cu = 1; }
        (void)hipGetLastError();
        grid = cus * 1;
    }
    if (grid < 0) return;
    if (hipMemsetAsync((char*)d_ws + WS_CTR, 0, 16384, stream) != hipSuccess) { fprintf(stderr, "kernel_launch: memset failed\n"); return; }
    Params p{};
    const float** f = (const float**)&p;
    for (int i = 0; i < 18; ++i) f[i] = (const float*)d_in[i];
    p.out = (float*)d_out; p.ws = (uchar*)d_ws;
#if MK_COOP
    p.ph_lo = 0; p.ph_hi = MK_RUN;
    void* args[] = {&p};
    hipError_t e = hipLaunchCooperativeKernel((const void*)mk_fwd, dim3(grid), dim3(NTHR), args, LDS_BYTES, stream);
    if (e != hipSuccess) fprintf(stderr, "cooperative launch failed: %s (grid %d)\n", hipGetErrorString(e), grid);
#else
    for (int ph = 0; ph < MK_RUN; ++ph) { p.ph_lo = ph; p.ph_hi = ph + 1; hipLaunchKernelGGL(mk_fwd, dim3(grid), dim3(NTHR), LDS_BYTES, stream, p); }
#endif
}
```

```cpp
#include <hip/hip_runtime.h>
#ifndef MK_REP_MASK
#define MK_REP_MASK 0
#endif
#ifndef MK_EXTRA_SYNC
#define MK_EXTRA_SYNC 0
#endif
#include <hip/hip_cooperative_groups.h>
#include <cstdio>
namespace cg = cooperative_groups;

#define LAS __attribute__((address_space(3)))
typedef unsigned short bf16_t;
typedef unsigned char uchar;
typedef short bf16x8 __attribute__((ext_vector_type(8)));
typedef float f32x4 __attribute__((ext_vector_type(4)));
typedef float f32x16 __attribute__((ext_vector_type(16)));
typedef unsigned u32x4 __attribute__((ext_vector_type(4)));
typedef unsigned u32x2 __attribute__((ext_vector_type(2)));

constexpr int D = 2048, NB = 2, SEQ = 4096, CTXL = 256, DFF = 5632, NMODC = 9 * D;
constexpr int NLAT = NB * SEQ, NCTX = NB * CTXL, NTOK = NLAT + NCTX;
constexpr int INW = 13344;
constexpr int LDP = 13568;
constexpr int OFF_K = 0, OFF_V = 1024, OFF_NK = 3072, OFF_NV = 4096, OFF_GF = 5120, OFF_GB = 5136, OFF_Q = 5376, OFF_R = 6400, OFF_NQ = 8448, OFF_M1 = 9472, OFF_M2 = 11520;
constexpr int NCTXCOLS = 5376;
constexpr int NCH = 68;
constexpr float EPS = 1e-6f, LOG2E = 1.4426950408889634f;
constexpr int LDS_BYTES = 147456;
constexpr int NTHR = 512;

constexpr size_t SZ_WGU = (size_t)2 * DFF * D * 2, SZ_WD = (size_t)D * DFF * 2;
constexpr size_t WS_WGU2 = 0, WS_WD2 = WS_WGU2 + SZ_WGU, WS_WGLAO = WS_WD2 + SZ_WD, WS_WNAO = WS_WGLAO + (size_t)D * D * 2, WS_WOUT = WS_WNAO + (size_t)D * 1024 * 2,
                 WS_MODP = WS_WOUT + (size_t)D * D * 2, WS_CTR = WS_MODP + (size_t)2 * 3 * NMODC * 4, WS_BAR = WS_CTR + 256, WS_R1 = WS_BAR + 16384 - 256;
constexpr size_t WS_WGU1 = WS_R1, WS_WD1 = WS_WGU1 + SZ_WGU, WS_R2 = WS_WD1 + SZ_WD;
constexpr size_t WS_OF = WS_R1, WS_OB = WS_R1 + (size_t)NLAT * D * 2;
constexpr size_t WS_WIN = WS_R2, WS_R4 = WS_WIN + (size_t)LDP * D * 2;
constexpr size_t SZ_QD = (size_t)NB * 4 * 2 * NCH * 64 * 256 * 2;
constexpr size_t WS_QD = WS_R2, WS_NVTL = WS_QD + SZ_QD, WS_NVTC = WS_NVTL + (size_t)NB * 16 * 64 * 64 * 64 * 2, WS_AG = WS_R2;
constexpr size_t WS_PROJ = WS_R4, WS_R5 = WS_PROJ + (size_t)NTOK * LDP * 2;
constexpr size_t WS_Y = WS_R4, WS_YC = WS_Y + (size_t)NLAT * D * 4;
constexpr size_t WS_H = WS_R5, WS_R8 = WS_H + (size_t)NTOK * DFF * 2;
constexpr size_t WS_KET = WS_R5, WS_VT = WS_KET + SZ_QD, WS_PM = WS_VT + (size_t)NB * 4 * NCH * 512 * 64 * 2, WS_DEC = WS_PM + (size_t)NB * 4 * 2 * NCH * 4096 * 2, WS_G2 = WS_R5;
constexpr size_t WS_A = WS_R8, WS_NAO = WS_R8, WS_MG = WS_R8, WS_END = WS_A + (size_t)NTOK * D * 2;
static_assert(WS_DEC + (size_t)NB * 4 * 2 * NCH * 256 * 4 <= WS_R8, "R5 overlay");
static_assert(WS_NVTC + (size_t)NB * 16 * 64 * 256 * 2 <= WS_R4, "R2 overlay");
static_assert(WS_OB + (size_t)NLAT * D * 2 <= WS_R2, "R1 overlay");

struct Params {
    const float *x, *c, *ctx, *c_ctx, *w_ada, *b_ada, *norm_g, *ffn_wg, *ffn_wu, *ffn_wd, *w_in, *gla_wg, *gla_bg, *gla_norm_g, *w_gla_o, *na_rpb, *w_na_o, *w_out;
    float* out; uchar* ws; int ph_lo, ph_hi;
};

typedef float f32x2_t __attribute__((ext_vector_type(2)));
typedef __bf16 bf16x2_t __attribute__((ext_vector_type(2)));
__device__ __forceinline__ unsigned cvt_pk_bf16(float lo, float hi) { const f32x2_t v = {lo, hi}; union { bf16x2_t b; unsigned u; } x; x.b = __builtin_convertvector(v, bf16x2_t); return x.u; }
__device__ __forceinline__ float bf2f(bf16_t b) { return __uint_as_float(((unsigned)b) << 16); }
__device__ __forceinline__ float bflo(unsigned u) { return __uint_as_float(u << 16); }
__device__ __forceinline__ float bfhi(unsigned u) { return __uint_as_float(u & 0xffff0000u); }
__device__ __forceinline__ float fast_rcp(float x) { return __builtin_amdgcn_rcpf(x); }
__device__ __forceinline__ float sigmoidf_(float x) { return fast_rcp(1.0f + __expf(-x)); }
__device__ __forceinline__ float siluf_(float x) { return x * sigmoidf_(x); }
__device__ __forceinline__ float wave_sum(float v) {
#pragma unroll
    for (int o = 32; o >= 1; o >>= 1) v += __shfl_xor(v, o);
    return v;
}
__device__ __forceinline__ bf16x8 as_bf16x8(u32x4 v) { union { u32x4 u; bf16x8 b; } x; x.u = v; return x.b; }


#define XB_TMO      128
#define XB_XCNT(j)  (256  + 64 * (j))
#define XB_XSUB(j)  (1280 + 64 * (j))
#define XB_XGEN(j)  (2304 + 64 * (j))
#define XB_TOP      3328
#define XB_TOPGEN   3392
#define XCD_BAR_WORDS 3456
#define XB_SPIN_CAP (1u << 20)
__device__ __forceinline__ unsigned xb_ld(unsigned* p)              { return __hip_atomic_load(p, __ATOMIC_RELAXED, __HIP_MEMORY_SCOPE_AGENT); }
__device__ __forceinline__ unsigned xb_add(unsigned* p, unsigned v) { return __hip_atomic_fetch_add(p, v, __ATOMIC_RELAXED, __HIP_MEMORY_SCOPE_AGENT); }
__device__ __forceinline__ unsigned xb_xcc_id() { return (unsigned)__builtin_amdgcn_s_getreg((3 << 11) | 20) & 0xFu; }
#define XB_SPIN(cond, bar) do { unsigned _sp = 0; while (cond) { __builtin_amdgcn_s_sleep(1); \
    if ((++_sp & 255u) == 0u) { if (xb_ld(&(bar)[XB_TMO])) break; if (_sp > XB_SPIN_CAP) { atomicAdd(&(bar)[XB_TMO], 1u); break; } } } } while (0)
struct XcdBarrier { unsigned* bar; unsigned x; volatile LAS unsigned* st; };
__device__ __forceinline__ XcdBarrier xcd_barrier_post(unsigned* bar, volatile LAS unsigned* st) {
    XcdBarrier b; b.bar = bar; b.x = xb_xcc_id(); b.st = st;
    if (threadIdx.x == 0) (void)xb_add(&bar[XB_XCNT(b.x)], 1u);
    return b;
}
__device__ __forceinline__ void xcd_barrier_complete(unsigned* bar, unsigned x, unsigned& nloc, unsigned& nx) {
    const unsigned G = gridDim.x * gridDim.y * gridDim.z;
    unsigned sum, cnt, mine, sp = 0u;
    for (;;) {
        sum = 0u; cnt = 0u; mine = 0u;
#pragma unroll
        for (unsigned j = 0; j < 16; ++j) { const unsigned c = xb_ld(&bar[XB_XCNT(j)]); sum += c; cnt += (c > 0u) ? 1u : 0u; mine = (j == x) ? c : mine; }
        if (sum == G) break;
        __builtin_amdgcn_s_sleep(1);
        if ((++sp & 255u) == 0u) { if (xb_ld(&bar[XB_TMO])) break; if (sp > XB_SPIN_CAP) { atomicAdd(&bar[XB_TMO], 1u); break; } }
    }
    nloc = mine > 0u ? mine : 1u; nx = cnt > 0u ? cnt : 1u;
}
__device__ __forceinline__ void xcd_barrier(const XcdBarrier& b) {
    asm volatile("s_waitcnt vmcnt(0)" ::: "memory");
    __syncthreads();
    if (threadIdx.x == 0) {
        unsigned* bar = b.bar;
        __builtin_amdgcn_s_waitcnt(0);
        unsigned nloc = b.st[0], nx = b.st[1];
        if (nloc == 0u) { xcd_barrier_complete(bar, b.x, nloc, nx); b.st[0] = nloc; b.st[1] = nx; }
        const unsigned old = xb_add(&bar[XB_XSUB(b.x)], 1u);
        const unsigned gen = old / nloc;
        if (old + 1u == (gen + 1u) * nloc) {
            __builtin_amdgcn_fence(__ATOMIC_RELEASE, "agent");
            asm volatile("s_waitcnt vmcnt(0)" ::: "memory");
            const unsigned og = xb_add(&bar[XB_TOP], 1u);
            const unsigned tg = og / nx;
            if (og + 1u == (tg + 1u) * nx) xb_add(&bar[XB_TOPGEN], 1u);
            else XB_SPIN(xb_ld(&bar[XB_TOPGEN]) == tg, bar);
            __builtin_amdgcn_fence(__ATOMIC_ACQUIRE, "agent");
            xb_add(&bar[XB_XGEN(b.x)], 1u);
            asm volatile("s_waitcnt vmcnt(0)" ::: "memory");
        } else {
            XB_SPIN(xb_ld(&bar[XB_XGEN(b.x)]) == gen, bar);
            __builtin_amdgcn_fence(__ATOMIC_ACQUIRE, "agent");
            asm volatile("s_waitcnt vmcnt(0)" ::: "memory");
        }
    }
    __syncthreads();
}

namespace pg8 {
constexpr int BM = 256, BK = 64, HALF = 128, HTB = HALF * BK * 2, NXCD = 8, WGM = 8;
__device__ __forceinline__ int lds_byte(int r, int c) { const int st = (r >> 4) * 2 + (c >> 5), rr = r & 15, cc = c & 31, ob = rr * 64 + cc * 2; return st * 1024 + (ob ^ (((ob >> 9) & 1) << 5)); }
__device__ __forceinline__ void stage_rc(int b, int& R, int& C) { const int st = b / 1024, sb = b % 1024, swz = sb ^ (((sb >> 9) & 1) << 5); R = (st >> 1) * 16 + swz / 64; C = (st & 1) * 32 + (swz % 64) / 2; }
__device__ __forceinline__ int perm32(int rho) { const int n = rho >> 4, i = rho & 15; return 8 * (i >> 2) + 4 * n + (i & 3); }
struct Unit { int pm, pn; };
struct Gemm { const bf16_t* A; const bf16_t* Bt; int M, N, K, lda, ldb; };
struct StaticOrder {
    int nM, nN, nwg, G, c;
    __device__ void init(int M, int N, int G_, int c_) { nM = M / BM; nN = N / BM; nwg = nM * nN; G = G_; c = c_; }
    __device__ bool next(int i, Unit& u) const {
        const long L = (long)i * G + c; if (L >= nwg) return false;
        int wgid = (int)L; { const int q = nwg / NXCD, r = nwg % NXCD, xcd = wgid % NXCD, off = wgid / NXCD; wgid = (xcd < r ? xcd * (q + 1) : r * (q + 1) + (xcd - r) * q) + off; }
        const int nig = WGM * nN, gid = wgid / nig, fm = gid * WGM, gsz = (nM - fm) < WGM ? (nM - fm) : WGM;
        u.pm = fm + ((wgid % nig) % gsz); u.pn = (wgid % nig) / gsz; return true;
    }
};
struct EpiF32 {
    static constexpr bool PERM = false;
    float* C; int ldc;
    __device__ __forceinline__ void operator()(const f32x4 (&acc)[2][2][4][2], const Unit& u, int wr, int wc, int fr, int fq) const {
        const int row0 = u.pm * BM + wr * 64 + fr, col0 = u.pn * BM + wc * 32 + 4 * fq;
#pragma unroll
        for (int ai = 0; ai < 2; ++ai)
#pragma unroll
            for (int m = 0; m < 4; ++m) { float* rowp = C + (size_t)(row0 + ai * HALF + m * 16) * ldc + col0;
#pragma unroll
                for (int bj = 0; bj < 2; ++bj)
#pragma unroll
                    for (int n = 0; n < 2; ++n) *(f32x4*)(rowp + bj * HALF + n * 16) = acc[ai][bj][m][n]; }
    }
};
struct EpiBf16 {
    static constexpr bool PERM = true;
    bf16_t* O; int ldc;
    __device__ __forceinline__ void operator()(const f32x4 (&acc)[2][2][4][2], const Unit& u, int wr, int wc, int fr, int fq) const {
        const int row0 = u.pm * BM + wr * 64 + fr, col0 = u.pn * BM + wc * 32 + 8 * fq;
#pragma unroll
        for (int ai = 0; ai < 2; ++ai)
#pragma unroll
            for (int m = 0; m < 4; ++m) { bf16_t* rowp = O + (size_t)(row0 + ai * HALF + m * 16) * ldc + col0;
#pragma unroll
                for (int bj = 0; bj < 2; ++bj) { const f32x4 v0 = acc[ai][bj][m][0], v1 = acc[ai][bj][m][1];
                    u32x4 w; w.x = cvt_pk_bf16(v0[0], v0[1]); w.y = cvt_pk_bf16(v0[2], v0[3]); w.z = cvt_pk_bf16(v1[0], v1[1]); w.w = cvt_pk_bf16(v1[2], v1[3]);
                    *(u32x4*)(rowp + bj * HALF) = w; } }
    }
};
struct EpiSiluMul {
    static constexpr bool PERM = true;
    bf16_t* O; int ldc;
    __device__ __forceinline__ void operator()(const f32x4 (&acc)[2][2][4][2], const Unit& u, int wr, int wc, int fr, int fq) const {
        const int row0 = u.pm * BM + wr * 64 + fr, col0 = u.pn * HALF + wc * 32 + 8 * fq;
#pragma unroll
        for (int ai = 0; ai < 2; ++ai)
#pragma unroll
            for (int m = 0; m < 4; ++m) { bf16_t* rowp = O + (size_t)(row0 + ai * HALF + m * 16) * ldc + col0;
                float h[8];
#pragma unroll
                for (int n = 0; n < 2; ++n)
#pragma unroll
                    for (int j = 0; j < 4; ++j) h[n * 4 + j] = siluf_(acc[ai][0][m][n][j]) * acc[ai][1][m][n][j];
                u32x4 w; w.x = cvt_pk_bf16(h[0], h[1]); w.y = cvt_pk_bf16(h[2], h[3]); w.z = cvt_pk_bf16(h[4], h[5]); w.w = cvt_pk_bf16(h[6], h[7]);
                *(u32x4*)rowp = w; }
    }
};
struct EpiGate2 {
    static constexpr bool PERM = false;
    bf16_t* C; const bf16_t* gate;
    __device__ __forceinline__ void operator()(const f32x4 (&acc)[2][2][4][2], const Unit& u, int wr, int wc, int fr, int fq) const {
        const int row0 = u.pm * BM + wr * 64 + fr, col0 = u.pn * BM + wc * 32 + 4 * fq;
#pragma unroll
        for (int ai = 0; ai < 2; ++ai)
#pragma unroll
            for (int m = 0; m < 4; ++m) { const size_t row = (size_t)(row0 + ai * HALF + m * 16);
#pragma unroll
                for (int bj = 0; bj < 2; ++bj)
#pragma unroll
                    for (int n = 0; n < 2; ++n) { const int col = col0 + bj * HALF + n * 16;
                        const u32x2 gm = *(const u32x2*)(gate + row * LDP + col); const f32x4 a = acc[ai][bj][m][n];
                        f32x4 o; o[0] = sigmoidf_(bflo(gm.x)) * a[0]; o[1] = sigmoidf_(bfhi(gm.x)) * a[1]; o[2] = sigmoidf_(bflo(gm.y)) * a[2]; o[3] = sigmoidf_(bfhi(gm.y)) * a[3];
                        u32x2 ow; ow.x = cvt_pk_bf16(o[0], o[1]); ow.y = cvt_pk_bf16(o[2], o[3]); *(u32x2*)(C + row * D + col) = ow; } }
    }
};
struct EpiMerge {
    static constexpr bool PERM = true;
    bf16_t* O; const bf16_t* gate; const bf16_t* G2;
    __device__ __forceinline__ void operator()(const f32x4 (&acc)[2][2][4][2], const Unit& u, int wr, int wc, int fr, int fq) const {
        const int row0 = u.pm * BM + wr * 64 + fr, col0 = u.pn * BM + wc * 32 + 8 * fq;
#pragma unroll
        for (int ai = 0; ai < 2; ++ai)
#pragma unroll
            for (int m = 0; m < 4; ++m) { const size_t row = (size_t)(row0 + ai * HALF + m * 16);
#pragma unroll
                for (int bj = 0; bj < 2; ++bj) { const int col = col0 + bj * HALF;
                    const u32x4 gm = *(const u32x4*)(gate + row * LDP + col);
                    const u32x4 gq = *(const u32x4*)(G2 + row * D + col); const f32x4 ga = (f32x4){bflo(gq.x), bfhi(gq.x), bflo(gq.y), bfhi(gq.y)}, gb = (f32x4){bflo(gq.z), bfhi(gq.z), bflo(gq.w), bfhi(gq.w)};
                    const f32x4 v0 = acc[ai][bj][m][0], v1 = acc[ai][bj][m][1];
                    float o[8];
                    o[0] = sigmoidf_(bflo(gm.x)) * v0[0] + ga[0]; o[1] = sigmoidf_(bfhi(gm.x)) * v0[1] + ga[1]; o[2] = sigmoidf_(bflo(gm.y)) * v0[2] + ga[2]; o[3] = sigmoidf_(bfhi(gm.y)) * v0[3] + ga[3];
                    o[4] = sigmoidf_(bflo(gm.z)) * v1[0] + gb[0]; o[5] = sigmoidf_(bfhi(gm.z)) * v1[1] + gb[1]; o[6] = sigmoidf_(bflo(gm.w)) * v1[2] + gb[2]; o[7] = sigmoidf_(bfhi(gm.w)) * v1[3] + gb[3];
                    u32x4 w; w.x = cvt_pk_bf16(o[0], o[1]); w.y = cvt_pk_bf16(o[2], o[3]); w.z = cvt_pk_bf16(o[4], o[5]); w.w = cvt_pk_bf16(o[6], o[7]);
                    *(u32x4*)(O + row * D + col) = w; } }
    }
};

template <class Epi, bool ALIGN_EPI = true>
__device__ __forceinline__ void gemm_phase(LAS uchar* lds, const Gemm g, const StaticOrder& S, const Epi& E) {
    const int tid = threadIdx.x, wid = __builtin_amdgcn_readfirstlane(tid >> 6), lane = tid & 63, wr = wid >> 2, wc = wid & 3, fr = lane & 15, fq = lane >> 4;
    const int K = g.K, nt = K / BK;
    unsigned voffA[2], voffB[2];
#pragma unroll
    for (int i = 0; i < 2; ++i) { int R, C; stage_rc(tid * 16 + i * 8192, R, C); const int Rb = Epi::PERM ? ((R & ~31) + perm32(R & 31)) : R;
        voffA[i] = (unsigned)(R * g.lda + C) * 2u; voffB[i] = (unsigned)(Rb * g.ldb + C) * 2u; }
    const size_t kstep = (size_t)(BK * 2);
    const size_t hstepA = (size_t)HALF * g.lda * 2, hstepB = (size_t)HALF * g.ldb * 2;
    const size_t tstepA = 2 * hstepA, tstepB = 2 * hstepB;
    const unsigned ldsw = (unsigned)wid * 1024u;
    const int aoff = lds_byte(wr * 64 + fr, fq * 8), boff = lds_byte(wc * 32 + fr, fq * 8);
#define PG8_SA(b, h) (((b) * 2 + (h)) * HTB)
#define PG8_SB(b, h) ((4 + (b) * 2 + (h)) * HTB)
#define PG8_STAGE(bufoff, gbase, voff) do { _Pragma("unroll") for (int _i = 0; _i < 2; ++_i) \
        __builtin_amdgcn_global_load_lds((const unsigned*)((const char*)(gbase) + (voff)[_i]), (LAS unsigned*)(lds + (bufoff) + ldsw + _i * 8192), 16, 0, 0); } while (0)
#define PG8_LDA(dst, b, h) do { _Pragma("unroll") for (int m = 0; m < 4; ++m) _Pragma("unroll") for (int k = 0; k < 2; ++k) dst[m][k] = *(const LAS bf16x8*)(lds + PG8_SA(b, h) + aoff + m * 2048 + k * 1024); } while (0)
#define PG8_LDB(dst, b, h) do { _Pragma("unroll") for (int n = 0; n < 2; ++n) _Pragma("unroll") for (int k = 0; k < 2; ++k) dst[n][k] = *(const LAS bf16x8*)(lds + PG8_SB(b, h) + boff + n * 2048 + k * 1024); } while (0)
#define PG8_MMA(ai, bj, At, Bt) do { __builtin_amdgcn_s_setprio(1); _Pragma("unroll") for (int m = 0; m < 4; ++m) _Pragma("unroll") for (int n = 0; n < 2; ++n) _Pragma("unroll") for (int k = 0; k < 2; ++k) \
        acc[ai][bj][m][n] = __builtin_amdgcn_mfma_f32_16x16x32_bf16(Bt[n][k], At[m][k], acc[ai][bj][m][n], 0, 0, 0); __builtin_amdgcn_s_setprio(0); } while (0)
#define PG8_WAIT_V(n) asm volatile("s_waitcnt vmcnt(" #n ")" ::: "memory")
#define PG8_WAIT_L(n) asm volatile("s_waitcnt lgkmcnt(" #n ")" ::: "memory")
#define PG8_BAR __builtin_amdgcn_s_barrier()
#define PG8_SCHED __builtin_amdgcn_sched_barrier(0)
    Unit cur, nxt; int ui = 0;
    if (!S.next(0, cur)) return;
    f32x4 acc[2][2][4][2];
#pragma unroll
    for (int a = 0; a < 2; ++a)
#pragma unroll
        for (int b = 0; b < 2; ++b)
#pragma unroll
            for (int m = 0; m < 4; ++m)
#pragma unroll
                for (int n = 0; n < 2; ++n) acc[a][b][m][n] = (f32x4){0.f, 0.f, 0.f, 0.f};
    bf16x8 At[4][2], B0[2][2], B1[2][2];
    const char* cA = (const char*)g.A + (size_t)cur.pm * tstepA; const char* cB = (const char*)g.Bt + (size_t)cur.pn * tstepB;
    PG8_STAGE(PG8_SB(0, 0), cB, voffB); PG8_STAGE(PG8_SB(0, 1), cB + hstepB, voffB); PG8_STAGE(PG8_SA(0, 0), cA, voffA); PG8_STAGE(PG8_SA(0, 1), cA + hstepA, voffA);
    if (wr == 1) PG8_BAR;
    PG8_WAIT_V(2); PG8_BAR;
    PG8_STAGE(PG8_SB(1, 0), cB + kstep, voffB); PG8_STAGE(PG8_SA(1, 0), cA + kstep, voffA); PG8_STAGE(PG8_SB(1, 1), cB + hstepB + kstep, voffB);
    PG8_WAIT_V(6); PG8_BAR;
    for (;;) {
        const bool has_next = S.next(ui + 1, nxt);
        const char* nA = has_next ? (const char*)g.A + (size_t)nxt.pm * tstepA : cA; const char* nB = has_next ? (const char*)g.Bt + (size_t)nxt.pn * tstepB : cB;
        for (int t = 0; t < nt; t += 2) {
            const bool last = (t == nt - 2);
            const char* a1 = cA + (size_t)(t + 1) * kstep;
            const char* a2 = last ? nA : cA + (size_t)(t + 2) * kstep; const char* b2 = last ? nB : cB + (size_t)(t + 2) * kstep;
            const char* a3 = a2 + kstep; const char* b3 = b2 + kstep;
            PG8_LDB(B0, 0, 0); PG8_LDB(B1, 0, 1); PG8_SCHED; PG8_LDA(At, 0, 0); PG8_STAGE(PG8_SA(1, 1), a1 + hstepA, voffA);
            PG8_WAIT_V(8); PG8_WAIT_L(0); PG8_BAR; PG8_MMA(0, 0, At, B0); PG8_MMA(0, 1, At, B1); PG8_BAR; PG8_SCHED;
            PG8_LDA(At, 0, 1); PG8_STAGE(PG8_SB(0, 0), b2, voffB); PG8_STAGE(PG8_SB(0, 1), b2 + hstepB, voffB); PG8_STAGE(PG8_SA(0, 0), a2, voffA);
            PG8_WAIT_V(8); PG8_WAIT_L(0); PG8_BAR; PG8_MMA(1, 0, At, B0); PG8_MMA(1, 1, At, B1); PG8_BAR; PG8_SCHED;
            PG8_LDB(B0, 1, 0); PG8_LDB(B1, 1, 1); PG8_SCHED; PG8_LDA(At, 1, 0); PG8_STAGE(PG8_SA(0, 1), a2 + hstepA, voffA);
            PG8_WAIT_V(8); PG8_WAIT_L(0); PG8_BAR; PG8_MMA(0, 0, At, B0); PG8_MMA(0, 1, At, B1); PG8_BAR; PG8_SCHED;
            PG8_LDA(At, 1, 1); PG8_STAGE(PG8_SB(1, 0), b3, voffB); PG8_STAGE(PG8_SB(1, 1), b3 + hstepB, voffB); PG8_STAGE(PG8_SA(1, 0), a3, voffA);
            PG8_WAIT_V(8); PG8_WAIT_L(0); PG8_BAR; PG8_MMA(1, 0, At, B0); PG8_MMA(1, 1, At, B1); PG8_BAR; PG8_SCHED;
        }
        if constexpr (ALIGN_EPI) { if (wr == 0) PG8_BAR; }
        E(acc, cur, wr, wc, fr, fq);
        if (!has_next) break;
#pragma unroll
        for (int a = 0; a < 2; ++a)
#pragma unroll
            for (int b = 0; b < 2; ++b)
#pragma unroll
                for (int m = 0; m < 4; ++m)
#pragma unroll
                    for (int n = 0; n < 2; ++n) acc[a][b][m][n] = (f32x4){0.f, 0.f, 0.f, 0.f};
        cur = nxt; cA = nA; cB = nB; ++ui;
        if constexpr (ALIGN_EPI) { if (wr == 1) PG8_BAR; }
    }
    PG8_WAIT_V(0);
    if constexpr (!ALIGN_EPI) { if (wr == 0) PG8_BAR; }
    PG8_BAR;
#undef PG8_SA
#undef PG8_SB
#undef PG8_STAGE
#undef PG8_LDA
#undef PG8_LDB
#undef PG8_MMA
#undef PG8_WAIT_V
#undef PG8_WAIT_L
#undef PG8_BAR
#undef PG8_SCHED
}
}

struct CvtJob { const float* src; int ld, K, col0, ntn, valid; bf16_t* dst; int row0, mul; };
__device__ __forceinline__ int cvt_job(const Params& p, int j, CvtJob& o) {
    uchar* ws = p.ws;
    const size_t FW = (size_t)D * DFF;
    switch (j) {
    case 0: o = {p.ffn_wg, DFF, D, 0, 44, 5632, (bf16_t*)(ws + WS_WGU1), 0, 256}; break;
    case 1: o = {p.ffn_wu, DFF, D, 0, 44, 5632, (bf16_t*)(ws + WS_WGU1), 128, 256}; break;
    case 2: o = {p.ffn_wd, D, DFF, 0, 16, 2048, (bf16_t*)(ws + WS_WD1), 0, 128}; break;
    case 3: o = {p.w_in, INW, D, 1024, 8, 1024, (bf16_t*)(ws + WS_WIN), OFF_K, 128}; break;
    case 4: o = {p.w_in, INW, D, 2048, 16, 2048, (bf16_t*)(ws + WS_WIN), OFF_V, 128}; break;
    case 5: o = {p.w_in, INW, D, 7200, 8, 1024, (bf16_t*)(ws + WS_WIN), OFF_NK, 128}; break;
    case 6: o = {p.w_in, INW, D, 8224, 8, 1024, (bf16_t*)(ws + WS_WIN), OFF_NV, 128}; break;
    case 7: o = {p.w_in, INW, D, 6144, 2, 32, (bf16_t*)(ws + WS_WIN), OFF_GF, 128}; break;
    case 8: o = {p.w_in, INW, D, 0, 8, 1024, (bf16_t*)(ws + WS_WIN), OFF_Q, 128}; break;
    case 9: o = {p.w_in, INW, D, 4096, 16, 2048, (bf16_t*)(ws + WS_WIN), OFF_R, 128}; break;
    case 10: o = {p.w_in, INW, D, 6176, 8, 1024, (bf16_t*)(ws + WS_WIN), OFF_NQ, 128}; break;
    case 11: o = {p.w_in, INW, D, 9248, 16, 2048, (bf16_t*)(ws + WS_WIN), OFF_M1, 128}; break;
    case 12: o = {p.w_in, INW, D, 11296, 16, 2048, (bf16_t*)(ws + WS_WIN), OFF_M2, 128}; break;
    case 13: o = {p.w_gla_o, D, D, 0, 16, 2048, (bf16_t*)(ws + WS_WGLAO), 0, 128}; break;
    case 14: o = {p.w_na_o, D, 1024, 0, 16, 2048, (bf16_t*)(ws + WS_WNAO), 0, 128}; break;
    case 15: o = {p.w_out, D, D, 0, 16, 2048, (bf16_t*)(ws + WS_WOUT), 0, 128}; break;
    case 16: o = {p.ffn_wg + FW, DFF, D, 0, 44, 5632, (bf16_t*)(ws + WS_WGU2), 0, 256}; break;
    case 17: o = {p.ffn_wu + FW, DFF, D, 0, 44, 5632, (bf16_t*)(ws + WS_WGU2), 128, 256}; break;
    default: o = {p.ffn_wd + FW, D, DFF, 0, 16, 2048, (bf16_t*)(ws + WS_WD2), 0, 128}; break;
    }
    return (o.K / 128) * o.ntn;
}
constexpr int N_CVT_JOBS = 19;
constexpr int N_CVT_TILES = 6 * 704 + 16 * 106 + 256 + 128 + 256;

struct CvtRegs { f32x4 a[4], b[4]; bf16_t* dst; int K; };
__device__ __forceinline__ void cvt_load(const CvtJob& J, int tl, CvtRegs& R) {
    const int tid = threadIdx.x;
    const int ktiles = J.K / 128, nt = tl / ktiles, kt = tl % ktiles;
    const int k0 = kt * 128, c0 = nt * 128;
    const int n4 = tid & 31, kp = tid >> 5;
    const int col = c0 + 4 * n4;
    R.dst = J.dst + (size_t)(J.row0 + nt * J.mul) * J.K + k0; R.K = J.K;
#pragma unroll
    for (int it = 0; it < 4; ++it) {
        const int kpair = kp + 16 * it;
        R.a[it] = (f32x4){0.f, 0.f, 0.f, 0.f}; R.b[it] = R.a[it];
        if (col < J.valid) { const float* sp = J.src + (size_t)(k0 + 2 * kpair) * J.ld + J.col0 + col; R.a[it] = __builtin_nontemporal_load((const f32x4*)sp); R.b[it] = __builtin_nontemporal_load((const f32x4*)(sp + J.ld)); }
    }
}
__device__ __forceinline__ void cvt_store(LAS uchar* lds, const CvtRegs& R) {
    LAS unsigned* T = (LAS unsigned*)lds;
    const int tid = threadIdx.x, n4 = tid & 31, kp = tid >> 5;
#pragma unroll
    for (int it = 0; it < 4; ++it) {
        const int kpair = kp + 16 * it;
#pragma unroll
        for (int i = 0; i < 4; ++i) T[(4 * n4 + i) * 65 + kpair] = cvt_pk_bf16(R.a[it][i], R.b[it][i]);
    }
    __syncthreads();
#pragma unroll
    for (int it = 0; it < 4; ++it) {
        const int ch = tid + 512 * it, n = ch >> 4, c16 = ch & 15;
        u32x4 v; v.x = T[n * 65 + 4 * c16]; v.y = T[n * 65 + 4 * c16 + 1]; v.z = T[n * 65 + 4 * c16 + 2]; v.w = T[n * 65 + 4 * c16 + 3];
        *(u32x4*)(R.dst + (size_t)n * R.K + 8 * c16) = v;
    }
    __syncthreads();
}

__device__ __forceinline__ void ada_item(LAS uchar* lds, const Params& p, int item) {
    LAS float* sv = (LAS float*)lds;
    LAS float* red = (LAS float*)(lds + 12288);
    const int tid = threadIdx.x, w = tid >> 6, lane = tid & 63;
    const int cb = item >> 1, kh = item & 1;
    for (int i = tid; i < 3 * 1024; i += NTHR) { const int s = i >> 10, k = kh * 1024 + (i & 1023); const float v = s < 2 ? p.c[s * D + k] : p.c_ctx[k]; sv[i] = siluf_(v); }
    __syncthreads();
    f32x4 a0 = (f32x4){0.f, 0.f, 0.f, 0.f}, a1 = a0, a2 = a0;
    const float* wp = p.w_ada + (size_t)(kh * 1024 + w * 128) * NMODC + cb * 256 + lane * 4;
#pragma unroll 8
    for (int k = 0; k < 128; ++k) {
        const f32x4 wv = *(const f32x4*)(wp + (size_t)k * NMODC);
        const int kk = w * 128 + k;
        a0 += sv[kk] * wv; a1 += sv[1024 + kk] * wv; a2 += sv[2048 + kk] * wv;
    }
    *(LAS f32x4*)(red + (w * 3 + 0) * 256 + lane * 4) = a0; *(LAS f32x4*)(red + (w * 3 + 1) * 256 + lane * 4) = a1; *(LAS f32x4*)(red + (w * 3 + 2) * 256 + lane * 4) = a2;
    __syncthreads();
    float* modp = (float*)(p.ws + WS_MODP);
    for (int i = tid; i < 768; i += NTHR) { const int s = i >> 8, col = i & 255; float v = 0.f;
#pragma unroll
        for (int ww = 0; ww < 8; ++ww) v += red[(ww * 3 + s) * 256 + col];
        const int gc = cb * 256 + col; if (kh == 0) v += p.b_ada[gc];
        modp[(size_t)(kh * 3 + s) * NMODC + gc] = v; }
    __syncthreads();
}

__device__ __forceinline__ void phase_prologue(LAS uchar* lds, const Params& p) {
    const int G = gridDim.x, bx = blockIdx.x;
    int t_lo, t_hi;
    if (G == 256) {
        if (bx < 144) { ada_item(lds, p, bx); t_lo = (bx * 89) / 4; t_hi = ((bx + 1) * 89) / 4; }
        else { t_lo = 3204 + (bx - 144) * 30; t_hi = t_lo + 30; }
        if (t_hi > N_CVT_TILES) t_hi = N_CVT_TILES;
    } else {
        for (int i = bx; i < 144; i += G) ada_item(lds, p, i);
        const int per = (N_CVT_TILES + G - 1) / G; t_lo = bx * per; t_hi = t_lo + per; if (t_hi > N_CVT_TILES) t_hi = N_CVT_TILES;
    }
    int j = 0, base = 0; CvtJob J; int cnt = cvt_job(p, 0, J);
    if (t_lo < t_hi) {
        CvtRegs cur, nxt;
        while (t_lo >= base + cnt) { base += cnt; ++j; cnt = cvt_job(p, j, J); }
        cvt_load(J, t_lo - base, cur);
        for (int t = t_lo; t < t_hi; ++t) {
            if (t + 1 < t_hi) { while (t + 1 >= base + cnt) { base += cnt; ++j; cnt = cvt_job(p, j, J); } cvt_load(J, t + 1 - base, nxt); }
            cvt_store(lds, cur);
            cur = nxt;
        }
    }
}

__device__ __forceinline__ f32x4 ld_mod(const float* modp, int s, int idx, int col) {
    const float* a = modp + (size_t)s * NMODC + idx * D + col; const float* b = a + (size_t)3 * NMODC;
    return *(const f32x4*)a + *(const f32x4*)b;
}
__device__ __forceinline__ void st_bf16x4(bf16_t* dst, f32x4 v) { u32x2 w; w.x = cvt_pk_bf16(v[0], v[1]); w.y = cvt_pk_bf16(v[2], v[3]); *(u32x2*)dst = w; }

__device__ __forceinline__ void phase_prenorm1(const Params& p) {
    const int w = threadIdx.x >> 6, lane = threadIdx.x & 63;
    const float* modp = (const float*)(p.ws + WS_MODP); bf16_t* A = (bf16_t*)(p.ws + WS_A);
    for (int item = blockIdx.x; item < NTOK / 8; item += gridDim.x) {
        const int row = item * 8 + w; const int s = row < NLAT ? row / SEQ : 2;
        const float* src = row < NLAT ? p.x + (size_t)row * D : p.ctx + (size_t)(row - NLAT) * D;
        f32x4 v[8]; float ss = 0.f;
#pragma unroll
        for (int j = 0; j < 8; ++j) { v[j] = *(const f32x4*)(src + j * 256 + lane * 4); ss += v[j][0] * v[j][0] + v[j][1] * v[j][1] + v[j][2] * v[j][2] + v[j][3] * v[j][3]; }
        ss = wave_sum(ss); const float rstd = rsqrtf(ss * (1.0f / D) + EPS);
#pragma unroll
        for (int j = 0; j < 8; ++j) { const int col = j * 256 + lane * 4;
            const f32x4 g = *(const f32x4*)(p.norm_g + 0 * D + col), sh = ld_mod(modp, s, 0, col), sc = ld_mod(modp, s, 1, col);
            st_bf16x4(A + (size_t)row * D + col, (v[j] * rstd * g) * (1.0f + sc) + sh); }
    }
}
template <int MODE>
__device__ __forceinline__ void phase_post(const Params& p) {
    const int w = threadIdx.x >> 6, lane = threadIdx.x & 63;
    const float* modp = (const float*)(p.ws + WS_MODP); bf16_t* A = (bf16_t*)(p.ws + WS_A);
    const bf16_t* Y = (const bf16_t*)(p.ws + WS_Y); const bf16_t* YC = (const bf16_t*)(p.ws + WS_YC);
    constexpr int NROWS = MODE == 0 ? NTOK : NLAT;
    constexpr int GI = MODE == 0 ? 2 : (MODE == 1 ? 5 : 8), GP = MODE == 0 ? 1 : (MODE == 1 ? 3 : 5), GN = MODE == 0 ? 2 : 4, SI = MODE == 0 ? 3 : 6;
    constexpr float WRES = MODE == 1 ? 1.0f : 0.5f;
    for (int item = blockIdx.x; item < NROWS / 8; item += gridDim.x) {
        const int row = item * 8 + w; const int s = row < NLAT ? row / SEQ : 2;
        const float* xin = MODE == 0 ? (row < NLAT ? p.x + (size_t)row * D : p.ctx + (size_t)(row - NLAT) * D) : p.out + (size_t)row * D;
        f32x4 y[8], xv8[8]; float ss = 0.f;
#pragma unroll
        for (int j = 0; j < 8; ++j) xv8[j] = *(const f32x4*)(xin + j * 256 + lane * 4);
#pragma unroll
        for (int j = 0; j < 8; ++j) { const int col = j * 256 + lane * 4;
            if (MODE == 0 && row >= NLAT) { const bf16_t* yc = YC + (size_t)(row - NLAT) * D + col; f32x4 a = (f32x4){0.f, 0.f, 0.f, 0.f};
#pragma unroll
                for (int sp = 0; sp < 4; ++sp) { const u32x2 t = *(const u32x2*)(yc + (size_t)sp * NCTX * D); a += (f32x4){bflo(t.x), bfhi(t.x), bflo(t.y), bfhi(t.y)}; }
                y[j] = a; }
            else { const u32x2 t = *(const u32x2*)(Y + (size_t)row * D + col); y[j] = (f32x4){bflo(t.x), bfhi(t.x), bflo(t.y), bfhi(t.y)}; }
            ss += y[j][0] * y[j][0] + y[j][1] * y[j][1] + y[j][2] * y[j][2] + y[j][3] * y[j][3]; }
        ss = wave_sum(ss); const float rstd = rsqrtf(ss * (1.0f / D) + EPS);
        float ss2 = 0.f;
#pragma unroll
        for (int j = 0; j < 8; ++j) { const int col = j * 256 + lane * 4;
            const f32x4 g = *(const f32x4*)(p.norm_g + GP * D + col), gt = ld_mod(modp, s, GI, col), xv = xv8[j];
            const f32x4 x1 = xv + WRES * gt * (y[j] * rstd * g);
            y[j] = x1; ss2 += x1[0] * x1[0] + x1[1] * x1[1] + x1[2] * x1[2] + x1[3] * x1[3];
            if (row < NLAT) *(f32x4*)(p.out + (size_t)row * D + col) = x1; }
        if (MODE == 2) continue;
        ss2 = wave_sum(ss2); const float rstd2 = rsqrtf(ss2 * (1.0f / D) + EPS);
#pragma unroll
        for (int j = 0; j < 8; ++j) { const int col = j * 256 + lane * 4;
            const f32x4 g = *(const f32x4*)(p.norm_g + GN * D + col), sh = ld_mod(modp, s, SI, col), sc = ld_mod(modp, s, SI + 1, col);
            st_bf16x4(A + (size_t)row * D + col, (y[j] * rstd2 * g) * (1.0f + sc) + sh); }
    }
}

constexpr int PREP_PITCH = 264;
constexpr int PREP_TILE = 64 * PREP_PITCH * 2;
__device__ __forceinline__ size_t gla_idx(int b, int h, int dir, int cid) { return (size_t)(((b * 4 + h) * 2 + dir) * NCH + cid); }

__device__ __forceinline__ void gla_prep_item(LAS uchar* lds, const Params& p, int item) {
    const int tid = threadIdx.x, wv = tid >> 6, lane = tid & 63;
    int h, cid, b;
    if (item < NB * 64 * 4) { h = item & 3; const int bc = item >> 2; cid = 4 + (bc & 63); b = bc >> 6; }
    else { const int it2 = item - NB * 64 * 4; h = it2 & 3; const int bc = it2 >> 2; cid = bc & 3; b = bc >> 2; }
    const bool lat = cid >= 4;
    const int rowbase = lat ? b * SEQ + (cid - 4) * 64 : NLAT + b * CTXL + cid * 64;
    const bf16_t* PROJ = (const bf16_t*)(p.ws + WS_PROJ);
    LAS float* Gs = (LAS float*)lds;
    {
        const int i = tid >> 3, c4 = (tid & 7) * 4;
        const u32x2 g = *(const u32x2*)(PROJ + (size_t)(rowbase + i) * LDP + OFF_GF + c4);
        *(LAS f32x4*)(Gs + i * 32 + c4) = (f32x4){bflo(g.x), bfhi(g.x), bflo(g.y), bfhi(g.y)};
    }
    __syncthreads();
    const int wvu = __builtin_amdgcn_readfirstlane(tid >> 6);
    const int d = tid & 255, dir = wvu >> 2;
    float wg[16];
#pragma unroll
    for (int r = 0; r < 16; ++r) wg[r] = p.gla_wg[(size_t)(dir * 16 + r) * 1024 + h * 256 + d];
    const float bg = p.gla_bg[dir * 1024 + h * 256 + d];
    const int axis = (wvu >> 1) & 1, fi = d & 63; const bool first = (wvu & 1) == 0;
    const int dpart = first ? d + 64 : d - 64;
    const float freq = __expf(-(float)fi * (9.210340371976184f / 64.0f));
    const float ang_row = (float)(cid - 4) * freq;
    float cs_row, sn_row; __sincosf(ang_row, &sn_row, &cs_row);
    if (!first) sn_row = -sn_row; sn_row = -sn_row;
    const float freq_rev = freq * 0.15915494309189535f;
    bf16_t* QD = (bf16_t*)(p.ws + WS_QD) + gla_idx(b, h, dir, cid) * (64 * 256);
    bf16_t* KET = (bf16_t*)(p.ws + WS_KET) + gla_idx(b, h, dir, cid) * (256 * 64);
    LAS bf16_t* QDs = (LAS bf16_t*)(lds + 8192 + dir * 2 * PREP_TILE);
    LAS bf16_t* KIs = (LAS bf16_t*)(lds + 8192 + dir * 2 * PREP_TILE + PREP_TILE);
    float cum = 0.f;
    unsigned short rk[8], rkp[8], rq[8], rqp[8], nk_[8], nkp[8], nq_[8], nqp[8];
    const bf16_t* pbase = PROJ + (size_t)rowbase * LDP + h * 256;
    const unsigned ok_ = OFF_K + d, okp_ = OFF_K + dpart, oq_ = OFF_Q + d, oqp_ = OFF_Q + dpart;
#define PREP_LOAD(dk_, dkp_, dq_, dqp_, n8_) do { _Pragma("unroll") for (int jj = 0; jj < 8; ++jj) { const int n_ = (n8_) * 8 + jj, i_ = dir ? 63 - n_ : n_; \
        const unsigned to_ = (unsigned)i_ * (unsigned)LDP; dk_[jj] = pbase[to_ + ok_]; \
        if (lat) { dkp_[jj] = pbase[to_ + okp_]; dq_[jj] = pbase[to_ + oq_]; dqp_[jj] = pbase[to_ + oqp_]; } else { dkp_[jj] = 0; dq_[jj] = 0; dqp_[jj] = 0; } } } while (0)
    PREP_LOAD(rk, rkp, rq, rqp, 0);
    for (int n8 = 0; n8 < 8; ++n8) {
        if (n8 < 7) PREP_LOAD(nk_, nkp, nq_, nqp, n8 + 1);
        float ke[8];
#pragma unroll
        for (int jj = 0; jj < 8; ++jj) {
            const int n = n8 * 8 + jj, i = dir ? 63 - n : n;
            const LAS f32x4* gp = (const LAS f32x4*)(Gs + i * 32 + dir * 16);
            float z = bg;
#pragma unroll
            for (int q4 = 0; q4 < 4; ++q4) { const f32x4 gv = gp[q4]; z += gv[0] * wg[q4 * 4] + gv[1] * wg[q4 * 4 + 1] + gv[2] * wg[q4 * 4 + 2] + gv[3] * wg[q4 * 4 + 3]; }
            { const float z2 = z * LOG2E; cum += (fminf(z2, 0.f) - __builtin_amdgcn_logf(1.0f + __builtin_amdgcn_exp2f(-fabsf(z2)))) * (1.0f / 16.0f); }
            float kv = bf2f(rk[jj]);
            if (lat) {
                float cs, sn;
                if (axis == 0) { cs = cs_row; sn = sn_row; } else { const float a = (float)i * freq_rev; cs = __builtin_amdgcn_cosf(a); sn = __builtin_amdgcn_sinf(a); if (first) sn = -sn; }
                const float kp2 = bf2f(rkp[jj]);
                kv = kv * cs + kp2 * sn;
                float qv = bf2f(rq[jj]); const float qp2 = bf2f(rqp[jj]);
                qv = (qv * cs + qp2 * sn) * 0.0625f;
                const float qd = qv * __builtin_amdgcn_exp2f(cum);
                const bf16_t qb = (bf16_t)(cvt_pk_bf16(qd, 0.f) & 0xffffu);
                QD[(size_t)i * 256 + d] = qb; QDs[i * PREP_PITCH + d] = qb;
            }
            const float ki = kv * __builtin_amdgcn_exp2f(-cum);
            if (lat) KIs[i * PREP_PITCH + d] = (bf16_t)(cvt_pk_bf16(ki, 0.f) & 0xffffu);
            ke[jj] = ki;
        }
        u32x4 o;
        if (dir == 0) { o.x = cvt_pk_bf16(ke[0], ke[1]); o.y = cvt_pk_bf16(ke[2], ke[3]); o.z = cvt_pk_bf16(ke[4], ke[5]); o.w = cvt_pk_bf16(ke[6], ke[7]); *(u32x4*)(KET + (size_t)d * 64 + n8 * 8) = o; }
        else { o.x = cvt_pk_bf16(ke[7], ke[6]); o.y = cvt_pk_bf16(ke[5], ke[4]); o.z = cvt_pk_bf16(ke[3], ke[2]); o.w = cvt_pk_bf16(ke[1], ke[0]); *(u32x4*)(KET + (size_t)d * 64 + (7 - n8) * 8) = o; }
#pragma unroll
        for (int jj = 0; jj < 8; ++jj) { rk[jj] = nk_[jj]; rkp[jj] = nkp[jj]; rq[jj] = nq_[jj]; rqp[jj] = nqp[jj]; }
    }
#undef PREP_LOAD
    ((float*)(p.ws + WS_DEC))[gla_idx(b, h, dir, cid) * 256 + d] = __builtin_amdgcn_exp2f(cum);
    {
        bf16_t* VT = (bf16_t*)(p.ws + WS_VT) + (size_t)((b * 4 + h) * NCH + cid) * (512 * 64);
        const bf16_t* vsrc = PROJ + (size_t)rowbase * LDP + OFF_V + h * 512 + tid;
        unsigned short e[64];
#pragma unroll
        for (int t = 0; t < 64; ++t) e[t] = vsrc[(size_t)t * LDP];
#pragma unroll
        for (int n8 = 0; n8 < 8; ++n8) {
            u32x4 o; o.x = e[n8 * 8] | ((unsigned)e[n8 * 8 + 1] << 16); o.y = e[n8 * 8 + 2] | ((unsigned)e[n8 * 8 + 3] << 16); o.z = e[n8 * 8 + 4] | ((unsigned)e[n8 * 8 + 5] << 16); o.w = e[n8 * 8 + 6] | ((unsigned)e[n8 * 8 + 7] << 16);
            *(u32x4*)(VT + (size_t)tid * 64 + n8 * 8) = o;
        }
    }
    __syncthreads();
    if (lat) {
        const int wdir = wv >> 2, ib = wv & 3, fr = lane & 15, g = lane >> 4;
        const LAS bf16_t* Qs = (const LAS bf16_t*)(lds + 8192 + wdir * 2 * PREP_TILE);
        const LAS bf16_t* Ks = (const LAS bf16_t*)(lds + 8192 + wdir * 2 * PREP_TILE + PREP_TILE);
        f32x4 acc[4];
#pragma unroll
        for (int nb = 0; nb < 4; ++nb) acc[nb] = (f32x4){0.f, 0.f, 0.f, 0.f};
#pragma unroll
        for (int kk = 0; kk < 8; ++kk) {
            const bf16x8 qf = *(const LAS bf16x8*)(Qs + (16 * ib + fr) * PREP_PITCH + 32 * kk + 8 * g);
#pragma unroll
            for (int nb = 0; nb < 4; ++nb) {
                const bf16x8 kf = *(const LAS bf16x8*)(Ks + (16 * nb + fr) * PREP_PITCH + 32 * kk + 8 * g);
                acc[nb] = __builtin_amdgcn_mfma_f32_16x16x32_bf16(kf, qf, acc[nb], 0, 0, 0);
            }
        }
        bf16_t* PM = (bf16_t*)(p.ws + WS_PM) + gla_idx(b, h, wdir, cid) * 4096;
        const int i = 16 * ib + fr;
#pragma unroll
        for (int nb = 0; nb < 4; ++nb) {
            float v[4];
#pragma unroll
            for (int r = 0; r < 4; ++r) { const int j = 16 * nb + 4 * g + r; const bool keep = wdir ? (j >= i) : (j <= i); v[r] = keep ? acc[nb][r] : 0.f; }
            u32x2 o; o.x = cvt_pk_bf16(v[0], v[1]); o.y = cvt_pk_bf16(v[2], v[3]);
            *(u32x2*)(PM + (size_t)i * 64 + 16 * nb + 4 * g) = o;
        }
    }
    __syncthreads();
}
__device__ __forceinline__ void na_vt_item(const Params& p, int item) {
    const int tid = threadIdx.x; const int blk = item % NCH, b = item / NCH; const bool lat = blk >= 4;
    const int rowbase = lat ? b * SEQ + (blk - 4) * 64 : NLAT + b * CTXL + blk * 64;
    const bf16_t* PROJ = (const bf16_t*)(p.ws + WS_PROJ);
    const int c = 2 * tid, h = c >> 6, dv = c & 63;
    const bf16_t* src = PROJ + (size_t)rowbase * LDP + OFF_NV + c;
    bf16_t* dst; int pitch;
    if (lat) { dst = (bf16_t*)(p.ws + WS_NVTL) + ((size_t)((b * 16 + h) * 64 + (blk - 4)) * 64 + dv) * 64; pitch = 64; }
    else { dst = (bf16_t*)(p.ws + WS_NVTC) + ((size_t)(b * 16 + h) * 64 + dv) * 256 + blk * 64; pitch = 256; }
    unsigned e[64];
#pragma unroll
    for (int t = 0; t < 64; ++t) e[t] = *(const unsigned*)(src + (size_t)t * LDP);
#pragma unroll
    for (int n8 = 0; n8 < 8; ++n8) {
        const unsigned* q = e + n8 * 8;
        u32x4 lo, hi;
        lo.x = (q[0] & 0xffffu) | (q[1] << 16); lo.y = (q[2] & 0xffffu) | (q[3] << 16); lo.z = (q[4] & 0xffffu) | (q[5] << 16); lo.w = (q[6] & 0xffffu) | (q[7] << 16);
        hi.x = (q[0] >> 16) | (q[1] & 0xffff0000u); hi.y = (q[2] >> 16) | (q[3] & 0xffff0000u); hi.z = (q[4] >> 16) | (q[5] & 0xffff0000u); hi.w = (q[6] >> 16) | (q[7] & 0xffff0000u);
        *(u32x4*)(dst + n8 * 8) = lo; *(u32x4*)(dst + pitch + n8 * 8) = hi;
    }
}

constexpr int ST_PITCH = 264, VT_PITCH = 72;
constexpr int SC_ST = 0, SC_QD = 64 * ST_PITCH * 2, SC_VT = 2 * 64 * ST_PITCH * 2, SC_PM = SC_VT + 64 * VT_PITCH * 2, SC_KT = SC_PM + 64 * VT_PITCH * 2, SC_DC = SC_KT + 256 * VT_PITCH * 2;
__device__ __forceinline__ int scan_cid(int n, int dir) { return n < 4 ? (dir ? 3 - n : n) : (dir ? 67 - (n - 4) : n); }

__device__ __forceinline__ void gla_scan_task(LAS uchar* lds, const Params& p, int task) {
    const int tid = threadIdx.x, w = __builtin_amdgcn_readfirstlane(tid >> 6), lane = tid & 63;
    const int xcd = task & 7, jj = task >> 3, combo = xcd * 2 + (jj >> 3), sl = jj & 7;
    const int b = combo >> 3, h = (combo >> 1) & 3, dir = combo & 1, dv0 = sl * 64;
    const int l32 = lane & 31, hf = lane >> 5;
    const bool isU = w >= 4; const int u = w & 3;
    const int dvb = u >> 1, ibk = u & 1;
    LAS bf16_t* ST = (LAS bf16_t*)(lds + SC_ST); LAS bf16_t* QDs = (LAS bf16_t*)(lds + SC_QD); LAS bf16_t* VTs = (LAS bf16_t*)(lds + SC_VT); LAS bf16_t* PMs = (LAS bf16_t*)(lds + SC_PM);
    LAS bf16_t* KTs = (LAS bf16_t*)(lds + SC_KT); LAS float* DCs = (LAS float*)(lds + SC_DC);
    for (int i = tid; i < 64 * ST_PITCH / 2; i += NTHR) ((LAS unsigned*)lds)[i] = 0u;
    const bf16_t* QDb = (const bf16_t*)(p.ws + WS_QD); const bf16_t* KITb = (const bf16_t*)(p.ws + WS_KET); const bf16_t* PMb = (const bf16_t*)(p.ws + WS_PM);
    const float* DECb = (const float*)(p.ws + WS_DEC); const bf16_t* VTb = (const bf16_t*)(p.ws + WS_VT);
    bf16_t* Ob = (bf16_t*)(p.ws + (dir ? WS_OB : WS_OF));
    f32x16 S00, S01, S10, S11;
#pragma unroll
    for (int i = 0; i < 16; ++i) { S00[i] = 0.f; S01[i] = 0.f; S10[i] = 0.f; S11[i] = 0.f; }
    const int vrow = tid >> 3, vc = (tid & 7) * 8;
    u32x4 qd_r[4], vt_r, pm_r, kt_r[4]; f32x4 dc_r;
#define SC_FETCH(n_) do { const int cid_ = scan_cid((n_), dir); const size_t gi_ = gla_idx(b, h, dir, cid_); \
        vt_r = *(const u32x4*)(VTb + (size_t)((b * 4 + h) * NCH + cid_) * (512 * 64) + (size_t)(dv0 + vrow) * 64 + vc); \
        _Pragma("unroll") for (int k4 = 0; k4 < 4; ++k4) kt_r[k4] = *(const u32x4*)(KITb + gi_ * (256 * 64) + (size_t)(tid + 512 * k4) * 8); \
        if (tid < 64) dc_r = *(const f32x4*)(DECb + gi_ * 256 + 4 * tid); \
        if ((n_) >= 4) { pm_r = *(const u32x4*)(PMb + gi_ * 4096 + vrow * 64 + vc); \
            _Pragma("unroll") for (int k4 = 0; k4 < 4; ++k4) { const int ch_ = tid + 512 * k4; qd_r[k4] = *(const u32x4*)(QDb + gi_ * (64 * 256) + (size_t)(ch_ >> 5) * 256 + (ch_ & 31) * 8); } } } while (0)
#define SC_COMMIT(n_) do { *(LAS u32x4*)(VTs + vrow * VT_PITCH + vc) = vt_r; \
        _Pragma("unroll") for (int k4 = 0; k4 < 4; ++k4) { const int ch_ = tid + 512 * k4; *(LAS u32x4*)(KTs + (ch_ >> 3) * VT_PITCH + (ch_ & 7) * 8) = kt_r[k4]; } \
        if (tid < 64) *(LAS f32x4*)(DCs + 4 * tid) = dc_r; \
        if ((n_) >= 4) { *(LAS u32x4*)(PMs + vrow * VT_PITCH + vc) = pm_r; \
            _Pragma("unroll") for (int k4 = 0; k4 < 4; ++k4) { const int ch_ = tid + 512 * k4; *(LAS u32x4*)(QDs + (ch_ >> 5) * ST_PITCH + (ch_ & 31) * 8) = qd_r[k4]; } } } while (0)
    SC_FETCH(0);
    SC_COMMIT(0);
    __syncthreads();
    for (int n = 0; n < NCH; ++n) {
        if (n + 1 < NCH) SC_FETCH(n + 1);
        if (isU) {
            f32x4 dec[2][4]; bf16x8 kit[8];
#pragma unroll
            for (int rb = 0; rb < 2; ++rb)
#pragma unroll
                for (int j4 = 0; j4 < 4; ++j4) dec[rb][j4] = *(const LAS f32x4*)(DCs + 64 * u + 32 * rb + 8 * j4 + 4 * hf);
#pragma unroll
            for (int rb = 0; rb < 2; ++rb)
#pragma unroll
                for (int kk = 0; kk < 4; ++kk) kit[rb * 4 + kk] = *(const LAS bf16x8*)(KTs + (64 * u + 32 * rb + l32) * VT_PITCH + 16 * kk + 8 * hf);
            const LAS bf16_t* vb0 = VTs + l32 * VT_PITCH + 8 * hf; const LAS bf16_t* vb1 = vb0 + 32 * VT_PITCH;
            bf16x8 ua[4], ub[4];
#pragma unroll
            for (int kk = 0; kk < 4; ++kk) { ua[kk] = *(const LAS bf16x8*)(vb0 + 16 * kk); ub[kk] = *(const LAS bf16x8*)(vb1 + 16 * kk); }
#pragma unroll
            for (int kk = 0; kk < 4; ++kk) {
                S00 = __builtin_amdgcn_mfma_f32_32x32x16_bf16(kit[kk], ua[kk], S00, 0, 0, 0);
                S01 = __builtin_amdgcn_mfma_f32_32x32x16_bf16(kit[kk], ub[kk], S01, 0, 0, 0);
                S10 = __builtin_amdgcn_mfma_f32_32x32x16_bf16(kit[4 + kk], ua[kk], S10, 0, 0, 0);
                S11 = __builtin_amdgcn_mfma_f32_32x32x16_bf16(kit[4 + kk], ub[kk], S11, 0, 0, 0); }
#pragma unroll
            for (int j4 = 0; j4 < 4; ++j4)
#pragma unroll
                for (int r = 0; r < 4; ++r) { S00[j4 * 4 + r] *= dec[0][j4][r]; S01[j4 * 4 + r] *= dec[0][j4][r]; S10[j4 * 4 + r] *= dec[1][j4][r]; S11[j4 * 4 + r] *= dec[1][j4][r]; }
        } else if (n >= 4) {
            const int cid = scan_cid(n, dir);
            f32x16 o;
#pragma unroll
            for (int i = 0; i < 16; ++i) o[i] = 0.f;
            const LAS bf16_t* sa = ST + (32 * dvb + l32) * ST_PITCH + 8 * hf; const LAS bf16_t* qb_ = QDs + (32 * ibk + l32) * ST_PITCH + 8 * hf;
            const LAS bf16_t* va = VTs + (32 * dvb + l32) * VT_PITCH + 8 * hf; const LAS bf16_t* pb = PMs + (32 * ibk + l32) * VT_PITCH + 8 * hf;
#pragma unroll
            for (int half = 0; half < 2; ++half) {
                bf16x8 fa[8], fb[8];
#pragma unroll
                for (int kk = 0; kk < 8; ++kk) { fa[kk] = *(const LAS bf16x8*)(sa + 16 * (half * 8 + kk)); fb[kk] = *(const LAS bf16x8*)(qb_ + 16 * (half * 8 + kk)); }
#pragma unroll
                for (int kk = 0; kk < 8; ++kk) o = __builtin_amdgcn_mfma_f32_32x32x16_bf16(fa[kk], fb[kk], o, 0, 0, 0);
            }
            {
                bf16x8 fa[4], fb[4];
#pragma unroll
                for (int q = 0; q < 4; ++q) { fa[q] = *(const LAS bf16x8*)(va + 16 * q); fb[q] = *(const LAS bf16x8*)(pb + 16 * q); }
#pragma unroll
                for (int q = 0; q < 4; ++q) o = __builtin_amdgcn_mfma_f32_32x32x16_bf16(fa[q], fb[q], o, 0, 0, 0);
            }
            bf16_t* op = Ob + (size_t)(b * SEQ + (cid - 4) * 64 + 32 * ibk + l32) * D + h * 512 + dv0 + 32 * dvb + 4 * hf;
#pragma unroll
            for (int j4 = 0; j4 < 4; ++j4) { u32x2 ov; ov.x = cvt_pk_bf16(o[j4 * 4], o[j4 * 4 + 1]); ov.y = cvt_pk_bf16(o[j4 * 4 + 2], o[j4 * 4 + 3]); *(u32x2*)(op + 8 * j4) = ov; }
        }
        __syncthreads();
        if (isU) {
            LAS bf16_t* stw = ST + l32 * ST_PITCH + 64 * u + 4 * hf;
#pragma unroll
            for (int j4 = 0; j4 < 4; ++j4) { u32x2 sv;
                sv.x = cvt_pk_bf16(S00[j4 * 4], S00[j4 * 4 + 1]); sv.y = cvt_pk_bf16(S00[j4 * 4 + 2], S00[j4 * 4 + 3]); *(LAS u32x2*)(stw + 8 * j4) = sv;
                sv.x = cvt_pk_bf16(S01[j4 * 4], S01[j4 * 4 + 1]); sv.y = cvt_pk_bf16(S01[j4 * 4 + 2], S01[j4 * 4 + 3]); *(LAS u32x2*)(stw + 32 * ST_PITCH + 8 * j4) = sv;
                sv.x = cvt_pk_bf16(S10[j4 * 4], S10[j4 * 4 + 1]); sv.y = cvt_pk_bf16(S10[j4 * 4 + 2], S10[j4 * 4 + 3]); *(LAS u32x2*)(stw + 32 + 8 * j4) = sv;
                sv.x = cvt_pk_bf16(S11[j4 * 4], S11[j4 * 4 + 1]); sv.y = cvt_pk_bf16(S11[j4 * 4 + 2], S11[j4 * 4 + 3]); *(LAS u32x2*)(stw + 32 * ST_PITCH + 32 + 8 * j4) = sv; }
        }
        if (n + 1 < NCH) SC_COMMIT(n + 1);
        __syncthreads();
    }
#undef SC_FETCH
#undef SC_COMMIT
}

constexpr int NA_KV = 24576, NA_KP = 72, NA_CP = 264;
constexpr int NA_QW = 20480;
__device__ __forceinline__ void na_item(LAS uchar* lds, const Params& p, int it) {
    const int tid = threadIdx.x, w = tid >> 6, lane = tid & 63, fr = lane & 15, g = lane >> 4;
    const int r = it & 63, h = (it >> 6) & 15, b = it >> 10;
    const int qb = w & 3, kind = w >> 2;
    LAS float* rpbS = (LAS float*)lds;
    LAS float* CBm = (LAS float*)(lds + 2048);
    LAS float* CBl = (LAS float*)(lds + 2048 + 256);
    LAS float* CBo = (LAS float*)(lds + 4096);
    LAS bf16_t* KL = (LAS bf16_t*)(lds + NA_KV);
    LAS bf16_t* KC = (LAS bf16_t*)(lds + NA_KV + 512 * NA_KP * 2);
    const bf16_t* PROJ = (const bf16_t*)(p.ws + WS_PROJ);
    const int rs = min(max(r - 4, 0), 56);
    u32x4 st[12];
    {
        const int c8 = (tid & 7) * 8;
#pragma unroll
        for (int k = 0; k < 8; ++k) { const int key = (tid >> 3) + 64 * k; st[k] = *(const u32x4*)(PROJ + (size_t)(b * SEQ + (rs + k) * 64 + (tid >> 3)) * LDP + OFF_NK + h * 64 + c8); (void)key; }
#pragma unroll
        for (int k = 0; k < 4; ++k) st[8 + k] = *(const u32x4*)(PROJ + (size_t)(NLAT + b * CTXL + (tid >> 3) + 64 * k) * LDP + OFF_NK + h * 64 + c8);
    }
    const int c0 = qb == 0 ? 0 : (qb == 1 ? 8 : (qb == 2 ? 24 : 32));
    const int j = 16 * qb + fr;
    const int cs = min(max(j - 8, 0), 48);
    const bf16_t* qrow = PROJ + (size_t)(b * SEQ + r * 64 + j) * LDP + OFF_NQ + h * 64 + 8 * g;
    const bf16x8 q0 = *(const bf16x8*)qrow, q1 = *(const bf16x8*)(qrow + 32);
    if (tid < 480) { const int rw = tid >> 5, cc = tid & 31; rpbS[tid] = cc < 31 ? p.na_rpb[h * 465 + rw * 31 + cc] * LOG2E : -1e30f; }
    {
        const int c8 = (tid & 7) * 8, kr = tid >> 3;
#pragma unroll
        for (int k = 0; k < 8; ++k) *(LAS u32x4*)(KL + (kr + 64 * k) * NA_KP + c8) = st[k];
#pragma unroll
        for (int k = 0; k < 4; ++k) *(LAS u32x4*)(KC + (kr + 64 * k) * NA_KP + c8) = st[8 + k];
    }
    __syncthreads();
    {
        const bf16_t* vl = (const bf16_t*)(p.ws + WS_NVTL) + (size_t)((b * 16 + h) * 64 + rs) * (64 * 64);
#pragma unroll
        for (int k = 0; k < 8; ++k) st[k] = *(const u32x4*)(vl + (size_t)(tid + 512 * k) * 8);
        const bf16_t* vc = (const bf16_t*)(p.ws + WS_NVTC) + (size_t)(b * 16 + h) * (64 * 256);
#pragma unroll
        for (int k = 0; k < 4; ++k) st[8 + k] = *(const u32x4*)(vc + (size_t)(tid + 512 * k) * 8);
    }
    const int mk = 8 * (fr >> 2) + (fr & 3);
    f32x4 s[16];
#pragma unroll
    for (int kb = 0; kb < 16; ++kb) {
        const int pp = kb >> 1, e = kb & 1;
        const LAS bf16_t* krow = kind == 0 ? KL + (pp * 64 + c0 + mk + 4 * e) * NA_KP + 8 * g : KC + (32 * pp + mk + 4 * e) * NA_KP + 8 * g;
        const bf16x8 k0 = *(const LAS bf16x8*)krow, k1 = *(const LAS bf16x8*)(krow + 32);
        f32x4 a = (f32x4){0.f, 0.f, 0.f, 0.f};
        a = __builtin_amdgcn_mfma_f32_16x16x32_bf16(k0, q0, a, 0, 0, 0);
        a = __builtin_amdgcn_mfma_f32_16x16x32_bf16(k1, q1, a, 0, 0, 0);
        s[kb] = a;
    }
    const float sc = 0.125f * LOG2E;
    float mx = -1e30f;
    if (kind == 0) {
        int colb[8];
        const int rowbase = (rs - r + 7) * 32;
#pragma unroll
        for (int x = 0; x < 8; ++x) { const int kc = c0 + 8 * g + x; const bool ok = (kc >= cs) && (kc < cs + 16); colb[x] = rowbase + (ok ? kc - j + 15 : 31); }
#pragma unroll
        for (int kb = 0; kb < 16; ++kb) {
            const int pp = kb >> 1, e = kb & 1;
#pragma unroll
            for (int i = 0; i < 4; ++i) { const float t = s[kb][i] * sc + rpbS[colb[4 * e + i] + pp * 32]; s[kb][i] = t; mx = fmaxf(mx, t); }
        }
    } else {
#pragma unroll
        for (int kb = 0; kb < 16; ++kb)
#pragma unroll
            for (int i = 0; i < 4; ++i) { const float t = s[kb][i] * sc; s[kb][i] = t; mx = fmaxf(mx, t); }
    }
    mx = fmaxf(mx, __shfl_xor(mx, 16)); mx = fmaxf(mx, __shfl_xor(mx, 32));
    float l = 0.f;
#pragma unroll
    for (int kb = 0; kb < 16; ++kb)
#pragma unroll
        for (int i = 0; i < 4; ++i) { const float e2 = __builtin_amdgcn_exp2f(s[kb][i] - mx); s[kb][i] = e2; l += e2; }
    l += __shfl_xor(l, 16); l += __shfl_xor(l, 32);
    __syncthreads();
    {
#pragma unroll
        for (int k = 0; k < 8; ++k) { const int ch = tid + 512 * k; *(LAS u32x4*)(KL + (ch >> 3) * NA_KP + (ch & 7) * 8) = st[k]; }
#pragma unroll
        for (int k = 0; k < 4; ++k) { const int ch = tid + 512 * k; *(LAS u32x4*)(KC + (ch >> 5) * NA_CP + (ch & 31) * 8) = st[8 + k]; }
    }
    __syncthreads();
    f32x4 o[4];
#pragma unroll
    for (int dvb = 0; dvb < 4; ++dvb) o[dvb] = (f32x4){0.f, 0.f, 0.f, 0.f};
#pragma unroll
    for (int pp = 0; pp < 8; ++pp) {
        u32x4 pk; pk.x = cvt_pk_bf16(s[2 * pp][0], s[2 * pp][1]); pk.y = cvt_pk_bf16(s[2 * pp][2], s[2 * pp][3]); pk.z = cvt_pk_bf16(s[2 * pp + 1][0], s[2 * pp + 1][1]); pk.w = cvt_pk_bf16(s[2 * pp + 1][2], s[2 * pp + 1][3]);
        const bf16x8 pf = as_bf16x8(pk);
#pragma unroll
        for (int dvb = 0; dvb < 4; ++dvb) {
            const LAS bf16_t* vp = kind == 0 ? KL + (pp * 64 + 16 * dvb + fr) * NA_KP + c0 + 8 * g : KC + (16 * dvb + fr) * NA_CP + 32 * pp + 8 * g;
            o[dvb] = __builtin_amdgcn_mfma_f32_16x16x32_bf16(*(const LAS bf16x8*)vp, pf, o[dvb], 0, 0, 0);
        }
    }
    if (kind == 1) {
        if (g == 0) { CBm[qb * 16 + fr] = mx; CBl[qb * 16 + fr] = l; }
#pragma unroll
        for (int dvb = 0; dvb < 4; ++dvb) *(LAS f32x4*)(CBo + (qb * 64 + lane) * 16 + dvb * 4) = o[dvb];
    }
    __syncthreads();
    if (kind == 0) {
        const float m2 = CBm[qb * 16 + fr], l2 = CBl[qb * 16 + fr];
        const float M = fmaxf(mx, m2), a1 = __builtin_amdgcn_exp2f(mx - M), a2 = __builtin_amdgcn_exp2f(m2 - M);
        const float inv = fast_rcp(l * a1 + l2 * a2);
        bf16_t* op = (bf16_t*)(p.ws + WS_NAO) + (size_t)(b * SEQ + r * 64 + j) * 1024 + h * 64 + 4 * g;
#pragma unroll
        for (int dvb = 0; dvb < 4; ++dvb) {
            const f32x4 o2 = *(const LAS f32x4*)(CBo + (qb * 64 + lane) * 16 + dvb * 4);
            const f32x4 v = (o[dvb] * a1 + o2 * a2) * inv;
            u32x2 ov; ov.x = cvt_pk_bf16(v[0], v[1]); ov.y = cvt_pk_bf16(v[2], v[3]); *(u32x2*)(op + 16 * dvb) = ov;
        }
    }
    __syncthreads();
}

__device__ __forceinline__ void phase_readout(const Params& p) {
    const int w = threadIdx.x >> 6, lane = threadIdx.x & 63;
    const bf16_t* OF = (const bf16_t*)(p.ws + WS_OF); const bf16_t* OB = (const bf16_t*)(p.ws + WS_OB); const bf16_t* PROJ = (const bf16_t*)(p.ws + WS_PROJ);
    bf16_t* AG = (bf16_t*)(p.ws + WS_AG);
    for (int item = blockIdx.x; item < NLAT / 8; item += gridDim.x) {
        const int row = item * 8 + w;
        u32x4 av[4], bv[4], rv4[4];
#pragma unroll
        for (int h = 0; h < 4; ++h) { const int col = h * 512 + lane * 8;
            av[h] = *(const u32x4*)(OF + (size_t)row * D + col); bv[h] = *(const u32x4*)(OB + (size_t)row * D + col); rv4[h] = *(const u32x4*)(PROJ + (size_t)row * LDP + OFF_R + col); }
        const f32x4 g0 = *(const f32x4*)(p.gla_norm_g + lane * 8), g1 = *(const f32x4*)(p.gla_norm_g + lane * 8 + 4);
#pragma unroll
        for (int h = 0; h < 4; ++h) {
            const int col = h * 512 + lane * 8;
            const u32x4 a = av[h], bq = bv[h], rr = rv4[h];
            float o[8];
            o[0] = bflo(a.x) + bflo(bq.x); o[1] = bfhi(a.x) + bfhi(bq.x); o[2] = bflo(a.y) + bflo(bq.y); o[3] = bfhi(a.y) + bfhi(bq.y);
            o[4] = bflo(a.z) + bflo(bq.z); o[5] = bfhi(a.z) + bfhi(bq.z); o[6] = bflo(a.w) + bflo(bq.w); o[7] = bfhi(a.w) + bfhi(bq.w);
            float ss = 0.f;
#pragma unroll
            for (int i = 0; i < 8; ++i) ss += o[i] * o[i];
            ss = wave_sum(ss); const float rstd = rsqrtf(ss * (1.0f / 512.0f) + EPS);
            const float rv[8] = {bflo(rr.x), bfhi(rr.x), bflo(rr.y), bfhi(rr.y), bflo(rr.z), bfhi(rr.z), bflo(rr.w), bfhi(rr.w)};
            float v[8];
#pragma unroll
            for (int i = 0; i < 8; ++i) v[i] = o[i] * rstd * (i < 4 ? g0[i] : g1[i - 4]) * siluf_(rv[i]);
            u32x4 ov; ov.x = cvt_pk_bf16(v[0], v[1]); ov.y = cvt_pk_bf16(v[2], v[3]); ov.z = cvt_pk_bf16(v[4], v[5]); ov.w = cvt_pk_bf16(v[6], v[7]);
            *(u32x4*)(AG + (size_t)row * D + col) = ov;
        }
    }
}

constexpr int N_PHASES = 15;
__global__ void __launch_bounds__(NTHR, 2) mk_fwd(Params p) {
    extern __shared__ __attribute__((aligned(16))) uchar lds_raw[];
    LAS uchar* lds = (LAS uchar*)lds_raw;
    const int G = gridDim.x, bx = blockIdx.x;
    uchar* ws = p.ws;
#define IN(k) (p.ph_lo <= (k) && (k) < p.ph_hi)
    LAS unsigned* xbst = (LAS unsigned*)(lds + LDS_BYTES - 16);
    if (threadIdx.x == 0) { xbst[0] = 0u; xbst[1] = 0u; xbst[2] = 0u; xbst[3] = 0u; }
    __syncthreads();
    const XcdBarrier xbar = xcd_barrier_post((unsigned*)(ws + WS_BAR), (volatile LAS unsigned*)xbst);
    if (p.ph_lo < 0) cg::this_grid().sync();
#define SEAM(k) do { if (IN(k) && IN((k) + 1)) { xcd_barrier(xbar); for (int xs_ = 0; xs_ < MK_EXTRA_SYNC; ++xs_) xcd_barrier(xbar); } } while (0)
#define REPS(k) for (int rep_ = 0; rep_ < 1 + ((MK_REP_MASK >> (k)) & 1); ++rep_)
    bf16_t* A = (bf16_t*)(ws + WS_A); bf16_t* H = (bf16_t*)(ws + WS_H); bf16_t* Y = (bf16_t*)(ws + WS_Y); bf16_t* YC = (bf16_t*)(ws + WS_YC);
    bf16_t* PROJ = (bf16_t*)(ws + WS_PROJ);

    if (IN(0)) REPS(0) { phase_prologue(lds, p); } SEAM(0);
    if (IN(1)) REPS(1) { phase_prenorm1(p); } SEAM(1);
    if (IN(2)) REPS(2) {
        { pg8::Gemm g{A, (const bf16_t*)(ws + WS_WGU1), NLAT, 2 * DFF, D, D, D}; pg8::StaticOrder S; S.init(NLAT, 2 * DFF, G, bx); pg8::EpiSiluMul E{H, DFF}; pg8::gemm_phase(lds, g, S, E); }
        { pg8::Gemm g{A + (size_t)NLAT * D, (const bf16_t*)(ws + WS_WGU1), NCTX, 2 * DFF, D, D, D}; pg8::StaticOrder S; S.init(NCTX, 2 * DFF, G, G - 1 - bx); pg8::EpiSiluMul E{H + (size_t)NLAT * DFF, DFF}; pg8::gemm_phase(lds, g, S, E); }
    } SEAM(2);
    if (IN(3)) REPS(3) {
        { pg8::Gemm g{H, (const bf16_t*)(ws + WS_WD1), NLAT, D, DFF, DFF, DFF}; pg8::StaticOrder S; S.init(NLAT, D, G, bx); pg8::EpiBf16 E{Y, D}; pg8::gemm_phase(lds, g, S, E); }
        for (int sp = 0; sp < 4; ++sp) { pg8::Gemm g{H + (size_t)NLAT * DFF + sp * 1408, (const bf16_t*)(ws + WS_WD1) + sp * 1408, NCTX, D, 1408, DFF, DFF}; pg8::StaticOrder S; S.init(NCTX, D, G, (bx + G - 16 * sp) % G);
            pg8::EpiBf16 E{YC + (size_t)sp * NCTX * D, D}; pg8::gemm_phase(lds, g, S, E); }
    } SEAM(3);
    if (IN(4)) REPS(4) { phase_post<0>(p); } SEAM(4);
    if (IN(5)) REPS(5) {
        { pg8::Gemm g{A, (const bf16_t*)(ws + WS_WIN), NLAT, LDP, D, D, D}; pg8::StaticOrder S; S.init(NLAT, LDP, G, bx); pg8::EpiBf16 E{PROJ, LDP}; pg8::gemm_phase(lds, g, S, E); }
        { pg8::Gemm g{A + (size_t)NLAT * D, (const bf16_t*)(ws + WS_WIN), NCTX, NCTXCOLS, D, D, D}; pg8::StaticOrder S; S.init(NCTX, NCTXCOLS, G, G - 1 - bx); pg8::EpiBf16 E{PROJ + (size_t)NLAT * LDP, LDP}; pg8::gemm_phase(lds, g, S, E); }
    } SEAM(5);
    if (IN(6)) REPS(6) {
        const int n_items = NB * NCH * 4 + NB * NCH;
        for (int it = bx; it < n_items; it += G) { if (it < NB * NCH * 4) gla_prep_item(lds, p, it); else na_vt_item(p, it - NB * NCH * 4); }
    } SEAM(6);
    if (IN(7)) REPS(7) {
        for (int t = bx; t < 128; t += G) gla_scan_task(lds, p, t);
        __syncthreads();
        {
            unsigned* qhead = (unsigned*)(ws + WS_CTR);
            if (threadIdx.x == 0) *(LAS unsigned*)(lds + NA_QW) = atomicAdd(qhead, 1u);
            __syncthreads();
            unsigned it = *(LAS unsigned*)(lds + NA_QW);
            __syncthreads();
            while (it < (unsigned)(NB * 16 * 64)) {
                unsigned nxt = 0u;
                if (threadIdx.x == 0) nxt = atomicAdd(qhead, 1u);
                na_item(lds, p, (int)it);
                if (threadIdx.x == 0) *(LAS unsigned*)(lds + NA_QW) = nxt;
                __syncthreads();
                it = *(LAS unsigned*)(lds + NA_QW);
                __syncthreads();
            }
        }
    } SEAM(7);
    if (IN(8)) REPS(8) {
        phase_readout(p);
        { pg8::Gemm g{(const bf16_t*)(ws + WS_NAO), (const bf16_t*)(ws + WS_WNAO), NLAT, D, 1024, 1024, 1024}; pg8::StaticOrder S; S.init(NLAT, D, G, bx); pg8::EpiGate2 E{(bf16_t*)(ws + WS_G2), PROJ + OFF_M2}; pg8::gemm_phase(lds, g, S, E); }
    } SEAM(8);
    if (IN(9)) REPS(9) { pg8::Gemm g{(const bf16_t*)(ws + WS_AG), (const bf16_t*)(ws + WS_WGLAO), NLAT, D, D, D, D}; pg8::StaticOrder S; S.init(NLAT, D, G, bx); pg8::EpiMerge E{(bf16_t*)(ws + WS_MG), PROJ + OFF_M1, (const bf16_t*)(ws + WS_G2)}; pg8::gemm_phase(lds, g, S, E); } SEAM(9);
    if (IN(10)) REPS(10) { pg8::Gemm g{(const bf16_t*)(ws + WS_MG), (const bf16_t*)(ws + WS_WOUT), NLAT, D, D, D, D}; pg8::StaticOrder S; S.init(NLAT, D, G, bx); pg8::EpiBf16 E{Y, D}; pg8::gemm_phase(lds, g, S, E); } SEAM(10);
    if (IN(11)) REPS(11) { phase_post<1>(p); } SEAM(11);
    if (IN(12)) REPS(12) { pg8::Gemm g{A, (const bf16_t*)(ws + WS_WGU2), NLAT, 2 * DFF, D, D, D}; pg8::StaticOrder S; S.init(NLAT, 2 * DFF, G, bx); pg8::EpiSiluMul E{H, DFF}; pg8::gemm_phase(lds, g, S, E); } SEAM(12);
    if (IN(13)) REPS(13) { pg8::Gemm g{H, (const bf16_t*)(ws + WS_WD2), NLAT, D, DFF, DFF, DFF}; pg8::StaticOrder S; S.init(NLAT, D, G, bx); pg8::EpiBf16 E{Y, D}; pg8::gemm_phase(lds, g, S, E); } SEAM(13);
    if (IN(14)) REPS(14) { phase_post<2>(p); }
#undef IN
#undef SEAM
}


#ifndef MK_RUN
#define MK_RUN N_PHASES
#endif
#ifndef MK_COOP
#define MK_COOP 1
#endif
extern "C" void kernel_launch(void* const* d_in, const int* in_sizes, int n_in, void* d_out, int out_size, void* d_ws, size_t ws_size, hipStream_t stream) {
    static int grid = 0;
    if (grid == 0) {
        if (n_in != 18 || ws_size < WS_END) { fprintf(stderr, "kernel_launch: need 18 inputs and %zu bytes of workspace (got %d, %zu)\n", (size_t)WS_END, n_in, ws_size); grid = -1; return; }
        int dev = 0, cus = 0, per_cu = 0;
        hipGetDevice(&dev); hipDeviceGetAttribute(&cus, hipDeviceAttributeMultiprocessorCount, dev);
        if (hipFuncSetAttribute((const void*)mk_fwd, hipFuncAttributeMaxDynamicSharedMemorySize, LDS_BYTES) != hipSuccess) { fprintf(stderr, "kernel_launch: hipFuncSetAttribute failed\n"); grid = -1; return; }
        if (hipOccupancyMaxActiveBlocksPerMultiprocessor(&per_cu, (const void*)mk_fwd, NTHR, LDS_BYTES) != hipSuccess || per_cu < 1) { fprintf(stderr, "kernel_launch: occupancy query gave %d\n", per_cu); per_cu = 1; }
        (void)hipGetLastError();
        grid = cus * 1;
    }
    if (grid < 0) return;
    if (hipMemsetAsync((char*)d_ws + WS_CTR, 0, 16384, stream) != hipSuccess) { fprintf(stderr, "kernel_launch: memset failed\n"); return; }
    Params p{};
    const float** f = (const float**)&p;
    for (int i = 0; i < 18; ++i) f[i] = (const float*)d_in[i];
    p.out = (float*)d_out; p.ws = (uchar*)d_ws;
#if MK_COOP
    p.ph_lo = 0; p.ph_hi = MK_RUN;
    void* args[] = {&p};
    hipError_t e = hipLaunchCooperativeKernel((const void*)mk_fwd, dim3(grid), dim3(NTHR), args, LDS_BYTES, stream);
    if (e != hipSuccess) fprintf(stderr, "cooperative launch failed: %s (grid %d)\n", hipGetErrorString(e), grid);
#else
    for (int ph = 0; ph < MK_RUN; ++ph) { p.ph_lo = ph; p.ph_hi = ph + 1; hipLaunchKernelGGL(mk_fwd, dim3(grid), dim3(NTHR), LDS_BYTES, stream, p); }
#endif
}
```

```cpp
#include <hip/hip_runtime.h>
#ifndef MK_REP_MASK
#define MK_REP_MASK 0
#endif
#ifndef MK_EXTRA_SYNC
#define MK_EXTRA_SYNC 0
#endif
#include <hip/hip_cooperative_groups.h>
#include <cstdio>
namespace cg = cooperative_groups;

#define LAS __attribute__((address_space(3)))
typedef unsigned short bf16_t;
typedef unsigned char uchar;
typedef short bf16x8 __attribute__((ext_vector_type(8)));
typedef float f32x4 __attribute__((ext_vector_type(4)));
typedef float f32x16 __attribute__((ext_vector_type(16)));
typedef unsigned u32x4 __attribute__((ext_vector_type(4)));
typedef unsigned u32x2 __attribute__((ext_vector_type(2)));

constexpr int D = 2048, NB = 2, SEQ = 4096, CTXL = 256, DFF = 5632, NMODC = 9 * D;
constexpr int NLAT = NB * SEQ, NCTX = NB * CTXL, NTOK = NLAT + NCTX;
constexpr int INW = 13344;
constexpr int LDP = 13568;
constexpr int OFF_K = 0, OFF_V = 1024, OFF_NK = 3072, OFF_NV = 4096, OFF_GF = 5120, OFF_GB = 5136, OFF_Q = 5376, OFF_R = 6400, OFF_NQ = 8448, OFF_M1 = 9472, OFF_M2 = 11520;
constexpr int NCTXCOLS = 5376;
constexpr int NCH = 68;
constexpr float EPS = 1e-6f, LOG2E = 1.4426950408889634f;
constexpr int LDS_BYTES = 147456;
constexpr int NTHR = 512;

constexpr size_t SZ_WGU = (size_t)2 * DFF * D * 2, SZ_WD = (size_t)D * DFF * 2;
constexpr size_t WS_WGU2 = 0, WS_WD2 = WS_WGU2 + SZ_WGU, WS_WGLAO = WS_WD2 + SZ_WD, WS_WNAO = WS_WGLAO + (size_t)D * D * 2, WS_WOUT = WS_WNAO + (size_t)D * 1024 * 2,
                 WS_MODP = WS_WOUT + (size_t)D * D * 2, WS_CTR = WS_MODP + (size_t)2 * 3 * NMODC * 4, WS_BAR = WS_CTR + 256, WS_R1 = WS_BAR + 16384 - 256;
constexpr size_t WS_WGU1 = WS_R1, WS_WD1 = WS_WGU1 + SZ_WGU, WS_R2 = WS_WD1 + SZ_WD;
constexpr size_t WS_OF = WS_R1, WS_OB = WS_R1 + (size_t)NLAT * D * 2;
constexpr size_t WS_WIN = WS_R2, WS_R4 = WS_WIN + (size_t)LDP * D * 2;
constexpr size_t SZ_QD = (size_t)NB * 4 * 2 * NCH * 64 * 256 * 2;
constexpr size_t WS_QD = WS_R2, WS_NVTL = WS_QD + SZ_QD, WS_NVTC = WS_NVTL + (size_t)NB * 16 * 64 * 64 * 64 * 2, WS_AG = WS_R2;
constexpr size_t WS_PROJ = WS_R4, WS_R5 = WS_PROJ + (size_t)NTOK * LDP * 2;
constexpr size_t WS_Y = WS_R4, WS_YC = WS_Y + (size_t)NLAT * D * 4;
constexpr size_t WS_H = WS_R5, WS_R8 = WS_H + (size_t)NTOK * DFF * 2;
constexpr size_t WS_KET = WS_R5, WS_VT = WS_KET + SZ_QD, WS_PM = WS_VT + (size_t)NB * 4 * NCH * 512 * 64 * 2, WS_DEC = WS_PM + (size_t)NB * 4 * 2 * NCH * 4096 * 2, WS_G2 = WS_R5;
constexpr size_t WS_A = WS_R8, WS_NAO = WS_R8, WS_MG = WS_R8, WS_END = WS_A + (size_t)NTOK * D * 2;
static_assert(WS_DEC + (size_t)NB * 4 * 2 * NCH * 256 * 4 <= WS_R8, "R5 overlay");
static_assert(WS_NVTC + (size_t)NB * 16 * 64 * 256 * 2 <= WS_R4, "R2 overlay");
static_assert(WS_OB + (size_t)NLAT * D * 2 <= WS_R2, "R1 overlay");

struct Params {
    const float *x, *c, *ctx, *c_ctx, *w_ada, *b_ada, *norm_g, *ffn_wg, *ffn_wu, *ffn_wd, *w_in, *gla_wg, *gla_bg, *gla_norm_g, *w_gla_o, *na_rpb, *w_na_o, *w_out;
    float* out; uchar* ws; int ph_lo, ph_hi;
};

typedef float f32x2_t __attribute__((ext_vector_type(2)));
typedef __bf16 bf16x2_t __attribute__((ext_vector_type(2)));
__device__ __forceinline__ unsigned cvt_pk_bf16(float lo, float hi) { const f32x2_t v = {lo, hi}; union { bf16x2_t b; unsigned u; } x; x.b = __builtin_convertvector(v, bf16x2_t); return x.u; }
__device__ __forceinline__ float bf2f(bf16_t b) { return __uint_as_float(((unsigned)b) << 16); }
__device__ __forceinline__ float bflo(unsigned u) { return __uint_as_float(u << 16); }
__device__ __forceinline__ float bfhi(unsigned u) { return __uint_as_float(u & 0xffff0000u); }
__device__ __forceinline__ float fast_rcp(float x) { return __builtin_amdgcn_rcpf(x); }
__device__ __forceinline__ float sigmoidf_(float x) { return fast_rcp(1.0f + __expf(-x)); }
__device__ __forceinline__ float siluf_(float x) { return x * sigmoidf_(x); }
__device__ __forceinline__ float wave_sum(float v) {
#pragma unroll
    for (int o = 32; o >= 1; o >>= 1) v += __shfl_xor(v, o);
    return v;
}
__device__ __forceinline__ bf16x8 as_bf16x8(u32x4 v) { union { u32x4 u; bf16x8 b; } x; x.u = v; return x.b; }


#define XB_TMO      128
#define XB_XCNT(j)  (256  + 64 * (j))
#define XB_XSUB(j)  (1280 + 64 * (j))
#define XB_XGEN(j)  (2304 + 64 * (j))
#define XB_TOP      3328
#define XB_TOPGEN   3392
#define XCD_BAR_WORDS 3456
#define XB_SPIN_CAP (1u << 20)
__device__ __forceinline__ unsigned xb_ld(unsigned* p)              { return __hip_atomic_load(p, __ATOMIC_RELAXED, __HIP_MEMORY_SCOPE_AGENT); }
__device__ __forceinline__ unsigned xb_add(unsigned* p, unsigned v) { return __hip_atomic_fetch_add(p, v, __ATOMIC_RELAXED, __HIP_MEMORY_SCOPE_AGENT); }
__device__ __forceinline__ unsigned xb_xcc_id() { return (unsigned)__builtin_amdgcn_s_getreg((3 << 11) | 20) & 0xFu; }
#define XB_SPIN(cond, bar) do { unsigned _sp = 0; while (cond) { __builtin_amdgcn_s_sleep(1); \
    if ((++_sp & 255u) == 0u) { if (xb_ld(&(bar)[XB_TMO])) break; if (_sp > XB_SPIN_CAP) { atomicAdd(&(bar)[XB_TMO], 1u); break; } } } } while (0)
struct XcdBarrier { unsigned* bar; unsigned x; volatile LAS unsigned* st; };
__device__ __forceinline__ XcdBarrier xcd_barrier_post(unsigned* bar, volatile LAS unsigned* st) {
    XcdBarrier b; b.bar = bar; b.x = xb_xcc_id(); b.st = st;
    if (threadIdx.x == 0) (void)xb_add(&bar[XB_XCNT(b.x)], 1u);
    return b;
}
__device__ __forceinline__ void xcd_barrier_complete(unsigned* bar, unsigned x, unsigned& nloc, unsigned& nx) {
    const unsigned G = gridDim.x * gridDim.y * gridDim.z;
    unsigned sum, cnt, mine, sp = 0u;
    for (;;) {
        sum = 0u; cnt = 0u; mine = 0u;
#pragma unroll
        for (unsigned j = 0; j < 16; ++j) { const unsigned c = xb_ld(&bar[XB_XCNT(j)]); sum += c; cnt += (c > 0u) ? 1u : 0u; mine = (j == x) ? c : mine; }
        if (sum == G) break;
        __builtin_amdgcn_s_sleep(1);
        if ((++sp & 255u) == 0u) { if (xb_ld(&bar[XB_TMO])) break; if (sp > XB_SPIN_CAP) { atomicAdd(&bar[XB_TMO], 1u); break; } }
    }
    nloc = mine > 0u ? mine : 1u; nx = cnt > 0u ? cnt : 1u;
}
__device__ __forceinline__ void xcd_barrier(const XcdBarrier& b) {
    asm volatile("s_waitcnt vmcnt(0)" ::: "memory");
    __syncthreads();
    if (threadIdx.x == 0) {
        unsigned* bar = b.bar;
        __builtin_amdgcn_s_waitcnt(0);
        unsigned nloc = b.st[0], nx = b.st[1];
        if (nloc == 0u) { xcd_barrier_complete(bar, b.x, nloc, nx); b.st[0] = nloc; b.st[1] = nx; }
        const unsigned old = xb_add(&bar[XB_XSUB(b.x)], 1u);
        const unsigned gen = old / nloc;
        if (old + 1u == (gen + 1u) * nloc) {
            __builtin_amdgcn_fence(__ATOMIC_RELEASE, "agent");
            asm volatile("s_waitcnt vmcnt(0)" ::: "memory");
            const unsigned og = xb_add(&bar[XB_TOP], 1u);
            const unsigned tg = og / nx;
            if (og + 1u == (tg + 1u) * nx) xb_add(&bar[XB_TOPGEN], 1u);
            else XB_SPIN(xb_ld(&bar[XB_TOPGEN]) == tg, bar);
            __builtin_amdgcn_fence(__ATOMIC_ACQUIRE, "agent");
            xb_add(&bar[XB_XGEN(b.x)], 1u);
            asm volatile("s_waitcnt vmcnt(0)" ::: "memory");
        } else {
            XB_SPIN(xb_ld(&bar[XB_XGEN(b.x)]) == gen, bar);
            __builtin_amdgcn_fence(__ATOMIC_ACQUIRE, "agent");
            asm volatile("s_waitcnt vmcnt(0)" ::: "memory");
        }
    }
    __syncthreads();
}

namespace pg8 {
constexpr int BM = 256, BK = 64, HALF = 128, HTB = HALF * BK * 2, NXCD = 8, WGM = 8;
__device__ __forceinline__ int lds_byte(int r, int c) { const int st = (r >> 4) * 2 + (c >> 5), rr = r & 15, cc = c & 31, ob = rr * 64 + cc * 2; return st * 1024 + (ob ^ (((ob >> 9) & 1) << 5)); }
__device__ __forceinline__ void stage_rc(int b, int& R, int& C) { const int st = b / 1024, sb = b % 1024, swz = sb ^ (((sb >> 9) & 1) << 5); R = (st >> 1) * 16 + swz / 64; C = (st & 1) * 32 + (swz % 64) / 2; }
__device__ __forceinline__ int perm32(int rho) { const int n = rho >> 4, i = rho & 15; return 8 * (i >> 2) + 4 * n + (i & 3); }
struct Unit { int pm, pn; };
struct Gemm { const bf16_t* A; const bf16_t* Bt; int M, N, K, lda, ldb; };
struct StaticOrder {
    int nM, nN, nwg, G, c;
    __device__ void init(int M, int N, int G_, int c_) { nM = M / BM; nN = N / BM; nwg = nM * nN; G = G_; c = c_; }
    __device__ bool next(int i, Unit& u) const {
        const long L = (long)i * G + c; if (L >= nwg) return false;
        int wgid = (int)L; { const int q = nwg / NXCD, r = nwg % NXCD, xcd = wgid % NXCD, off = wgid / NXCD; wgid = (xcd < r ? xcd * (q + 1) : r * (q + 1) + (xcd - r) * q) + off; }
        const int nig = WGM * nN, gid = wgid / nig, fm = gid * WGM, gsz = (nM - fm) < WGM ? (nM - fm) : WGM;
        u.pm = fm + ((wgid % nig) % gsz); u.pn = (wgid % nig) / gsz; return true;
    }
};
struct EpiF32 {
    static constexpr bool PERM = false;
    float* C; int ldc;
    __device__ __forceinline__ void operator()(const f32x4 (&acc)[2][2][4][2], const Unit& u, int wr, int wc, int fr, int fq) const {
        const int row0 = u.pm * BM + wr * 64 + fr, col0 = u.pn * BM + wc * 32 + 4 * fq;
#pragma unroll
        for (int ai = 0; ai < 2; ++ai)
#pragma unroll
            for (int m = 0; m < 4; ++m) { float* rowp = C + (size_t)(row0 + ai * HALF + m * 16) * ldc + col0;
#pragma unroll
                for (int bj = 0; bj < 2; ++bj)
#pragma unroll
                    for (int n = 0; n < 2; ++n) *(f32x4*)(rowp + bj * HALF + n * 16) = acc[ai][bj][m][n]; }
    }
};
struct EpiBf16 {
    static constexpr bool PERM = true;
    bf16_t* O; int ldc;
    __device__ __forceinline__ void operator()(const f32x4 (&acc)[2][2][4][2], const Unit& u, int wr, int wc, int fr, int fq) const {
        const int row0 = u.pm * BM + wr * 64 + fr, col0 = u.pn * BM + wc * 32 + 8 * fq;
#pragma unroll
        for (int ai = 0; ai < 2; ++ai)
#pragma unroll
            for (int m = 0; m < 4; ++m) { bf16_t* rowp = O + (size_t)(row0 + ai * HALF + m * 16) * ldc + col0;
#pragma unroll
                for (int bj = 0; bj < 2; ++bj) { const f32x4 v0 = acc[ai][bj][m][0], v1 = acc[ai][bj][m][1];
                    u32x4 w; w.x = cvt_pk_bf16(v0[0], v0[1]); w.y = cvt_pk_bf16(v0[2], v0[3]); w.z = cvt_pk_bf16(v1[0], v1[1]); w.w = cvt_pk_bf16(v1[2], v1[3]);
                    *(u32x4*)(rowp + bj * HALF) = w; } }
    }
};
struct EpiSiluMul {
    static constexpr bool PERM = true;
    bf16_t* O; int ldc;
    __device__ __forceinline__ void operator()(const f32x4 (&acc)[2][2][4][2], const Unit& u, int wr, int wc, int fr, int fq) const {
        const int row0 = u.pm * BM + wr * 64 + fr, col0 = u.pn * HALF + wc * 32 + 8 * fq;
#pragma unroll
        for (int ai = 0; ai < 2; ++ai)
#pragma unroll
            for (int m = 0; m < 4; ++m) { bf16_t* rowp = O + (size_t)(row0 + ai * HALF + m * 16) * ldc + col0;
                float h[8];
#pragma unroll
                for (int n = 0; n < 2; ++n)
#pragma unroll
                    for (int j = 0; j < 4; ++j) h[n * 4 + j] = siluf_(acc[ai][0][m][n][j]) * acc[ai][1][m][n][j];
                u32x4 w; w.x = cvt_pk_bf16(h[0], h[1]); w.y = cvt_pk_bf16(h[2], h[3]); w.z = cvt_pk_bf16(h[4], h[5]); w.w = cvt_pk_bf16(h[6], h[7]);
                *(u32x4*)rowp = w; }
    }
};
struct EpiGate2 {
    static constexpr bool PERM = false;
    bf16_t* C; const bf16_t* gate;
    __device__ __forceinline__ void operator()(const f32x4 (&acc)[2][2][4][2], const Unit& u, int wr, int wc, int fr, int fq) const {
        const int row0 = u.pm * BM + wr * 64 + fr, col0 = u.pn * BM + wc * 32 + 4 * fq;
#pragma unroll
        for (int ai = 0; ai < 2; ++ai)
#pragma unroll
            for (int m = 0; m < 4; ++m) { const size_t row = (size_t)(row0 + ai * HALF + m * 16);
#pragma unroll
                for (int bj = 0; bj < 2; ++bj)
#pragma unroll
                    for (int n = 0; n < 2; ++n) { const int col = col0 + bj * HALF + n * 16;
                        const u32x2 gm = *(const u32x2*)(gate + row * LDP + col); const f32x4 a = acc[ai][bj][m][n];
                        f32x4 o; o[0] = sigmoidf_(bflo(gm.x)) * a[0]; o[1] = sigmoidf_(bfhi(gm.x)) * a[1]; o[2] = sigmoidf_(bflo(gm.y)) * a[2]; o[3] = sigmoidf_(bfhi(gm.y)) * a[3];
                        u32x2 ow; ow.x = cvt_pk_bf16(o[0], o[1]); ow.y = cvt_pk_bf16(o[2], o[3]); *(u32x2*)(C + row * D + col) = ow; } }
    }
};
struct EpiMerge {
    static constexpr bool PERM = true;
    bf16_t* O; const bf16_t* gate; const bf16_t* G2;
    __device__ __forceinline__ void operator()(const f32x4 (&acc)[2][2][4][2], const Unit& u, int wr, int wc, int fr, int fq) const {
        const int row0 = u.pm * BM + wr * 64 + fr, col0 = u.pn * BM + wc * 32 + 8 * fq;
#pragma unroll
        for (int ai = 0; ai < 2; ++ai)
#pragma unroll
            for (int m = 0; m < 4; ++m) { const size_t row = (size_t)(row0 + ai * HALF + m * 16);
#pragma unroll
                for (int bj = 0; bj < 2; ++bj) { const int col = col0 + bj * HALF;
                    const u32x4 gm = *(const u32x4*)(gate + row * LDP + col);
                    const u32x4 gq = *(const u32x4*)(G2 + row * D + col); const f32x4 ga = (f32x4){bflo(gq.x), bfhi(gq.x), bflo(gq.y), bfhi(gq.y)}, gb = (f32x4){bflo(gq.z), bfhi(gq.z), bflo(gq.w), bfhi(gq.w)};
                    const f32x4 v0 = acc[ai][bj][m][0], v1 = acc[ai][bj][m][1];
                    float o[8];
                    o[0] = sigmoidf_(bflo(gm.x)) * v0[0] + ga[0]; o[1] = sigmoidf_(bfhi(gm.x)) * v0[1] + ga[1]; o[2] = sigmoidf_(bflo(gm.y)) * v0[2] + ga[2]; o[3] = sigmoidf_(bfhi(gm.y)) * v0[3] + ga[3];
                    o[4] = sigmoidf_(bflo(gm.z)) * v1[0] + gb[0]; o[5] = sigmoidf_(bfhi(gm.z)) * v1[1] + gb[1]; o[6] = sigmoidf_(bflo(gm.w)) * v1[2] + gb[2]; o[7] = sigmoidf_(bfhi(gm.w)) * v1[3] + gb[3];
                    u32x4 w; w.x = cvt_pk_bf16(o[0], o[1]); w.y = cvt_pk_bf16(o[2], o[3]); w.z = cvt_pk_bf16(o[4], o[5]); w.w = cvt_pk_bf16(o[6], o[7]);
                    *(u32x4*)(O + row * D + col) = w; } }
    }
};

template <class Epi, bool ALIGN_EPI = true>
__device__ __forceinline__ void gemm_phase(LAS uchar* lds, const Gemm g, const StaticOrder& S, const Epi& E) {
    const int tid = threadIdx.x, wid = __builtin_amdgcn_readfirstlane(tid >> 6), lane = tid & 63, wr = wid >> 2, wc = wid & 3, fr = lane & 15, fq = lane >> 4;
    const int K = g.K, nt = K / BK;
    unsigned voffA[2], voffB[2];
#pragma unroll
    for (int i = 0; i < 2; ++i) { int R, C; stage_rc(tid * 16 + i * 8192, R, C); const int Rb = Epi::PERM ? ((R & ~31) + perm32(R & 31)) : R;
        voffA[i] = (unsigned)(R * g.lda + C) * 2u; voffB[i] = (unsigned)(Rb * g.ldb + C) * 2u; }
    const size_t kstep = (size_t)(BK * 2);
    const size_t hstepA = (size_t)HALF * g.lda * 2, hstepB = (size_t)HALF * g.ldb * 2;
    const size_t tstepA = 2 * hstepA, tstepB = 2 * hstepB;
    const unsigned ldsw = (unsigned)wid * 1024u;
    const int aoff = lds_byte(wr * 64 + fr, fq * 8), boff = lds_byte(wc * 32 + fr, fq * 8);
#define PG8_SA(b, h) (((b) * 2 + (h)) * HTB)
#define PG8_SB(b, h) ((4 + (b) * 2 + (h)) * HTB)
#define PG8_STAGE(bufoff, gbase, voff) do { _Pragma("unroll") for (int _i = 0; _i < 2; ++_i) \
        __builtin_amdgcn_global_load_lds((const unsigned*)((const char*)(gbase) + (voff)[_i]), (LAS unsigned*)(lds + (bufoff) + ldsw + _i * 8192), 16, 0, 0); } while (0)
#define PG8_LDA(dst, b, h) do { _Pragma("unroll") for (int m = 0; m < 4; ++m) _Pragma("unroll") for (int k = 0; k < 2; ++k) dst[m][k] = *(const LAS bf16x8*)(lds + PG8_SA(b, h) + aoff + m * 2048 + k * 1024); } while (0)
#define PG8_LDB(dst, b, h) do { _Pragma("unroll") for (int n = 0; n < 2; ++n) _Pragma("unroll") for (int k = 0; k < 2; ++k) dst[n][k] = *(const LAS bf16x8*)(lds + PG8_SB(b, h) + boff + n * 2048 + k * 1024); } while (0)
#define PG8_MMA(ai, bj, At, Bt) do { __builtin_amdgcn_s_setprio(1); _Pragma("unroll") for (int m = 0; m < 4; ++m) _Pragma("unroll") for (int n = 0; n < 2; ++n) _Pragma("unroll") for (int k = 0; k < 2; ++k) \
        acc[ai][bj][m][n] = __builtin_amdgcn_mfma_f32_16x16x32_bf16(Bt[n][k], At[m][k], acc[ai][bj][m][n], 0, 0, 0); __builtin_amdgcn_s_setprio(0); } while (0)
#define PG8_WAIT_V(n) asm volatile("s_waitcnt vmcnt(" #n ")" ::: "memory")
#define PG8_WAIT_L(n) asm volatile("s_waitcnt lgkmcnt(" #n ")" ::: "memory")
#define PG8_BAR __builtin_amdgcn_s_barrier()
#define PG8_SCHED __builtin_amdgcn_sched_barrier(0)
    Unit cur, nxt; int ui = 0;
    if (!S.next(0, cur)) return;
    f32x4 acc[2][2][4][2];
#pragma unroll
    for (int a = 0; a < 2; ++a)
#pragma unroll
        for (int b = 0; b < 2; ++b)
#pragma unroll
            for (int m = 0; m < 4; ++m)
#pragma unroll
                for (int n = 0; n < 2; ++n) acc[a][b][m][n] = (f32x4){0.f, 0.f, 0.f, 0.f};
    bf16x8 At[4][2], B0[2][2], B1[2][2];
    const char* cA = (const char*)g.A + (size_t)cur.pm * tstepA; const char* cB = (const char*)g.Bt + (size_t)cur.pn * tstepB;
    PG8_STAGE(PG8_SB(0, 0), cB, voffB); PG8_STAGE(PG8_SB(0, 1), cB + hstepB, voffB); PG8_STAGE(PG8_SA(0, 0), cA, voffA); PG8_STAGE(PG8_SA(0, 1), cA + hstepA, voffA);
    if (wr == 1) PG8_BAR;
    PG8_WAIT_V(2); PG8_BAR;
    PG8_STAGE(PG8_SB(1, 0), cB + kstep, voffB); PG8_STAGE(PG8_SA(1, 0), cA + kstep, voffA); PG8_STAGE(PG8_SB(1, 1), cB + hstepB + kstep, voffB);
    PG8_WAIT_V(6); PG8_BAR;
    for (;;) {
        const bool has_next = S.next(ui + 1, nxt);
        const char* nA = has_next ? (const char*)g.A + (size_t)nxt.pm * tstepA : cA; const char* nB = has_next ? (const char*)g.Bt + (size_t)nxt.pn * tstepB : cB;
        for (int t = 0; t < nt; t += 2) {
            const bool last = (t == nt - 2);
            const char* a1 = cA + (size_t)(t + 1) * kstep;
            const char* a2 = last ? nA : cA + (size_t)(t + 2) * kstep; const char* b2 = last ? nB : cB + (size_t)(t + 2) * kstep;
            const char* a3 = a2 + kstep; const char* b3 = b2 + kstep;
            PG8_LDB(B0, 0, 0); PG8_LDB(B1, 0, 1); PG8_SCHED; PG8_LDA(At, 0, 0); PG8_STAGE(PG8_SA(1, 1), a1 + hstepA, voffA);
            PG8_WAIT_V(8); PG8_WAIT_L(0); PG8_BAR; PG8_MMA(0, 0, At, B0); PG8_MMA(0, 1, At, B1); PG8_BAR; PG8_SCHED;
            PG8_LDA(At, 0, 1); PG8_STAGE(PG8_SB(0, 0), b2, voffB); PG8_STAGE(PG8_SB(0, 1), b2 + hstepB, voffB); PG8_STAGE(PG8_SA(0, 0), a2, voffA);
            PG8_WAIT_V(8); PG8_WAIT_L(0); PG8_BAR; PG8_MMA(1, 0, At, B0); PG8_MMA(1, 1, At, B1); PG8_BAR; PG8_SCHED;
            PG8_LDB(B0, 1, 0); PG8_LDB(B1, 1, 1); PG8_SCHED; PG8_LDA(At, 1, 0); PG8_STAGE(PG8_SA(0, 1), a2 + hstepA, voffA);
            PG8_WAIT_V(8); PG8_WAIT_L(0); PG8_BAR; PG8_MMA(0, 0, At, B0); PG8_MMA(0, 1, At, B1); PG8_BAR; PG8_SCHED;
            PG8_LDA(At, 1, 1); PG8_STAGE(PG8_SB(1, 0), b3, voffB); PG8_STAGE(PG8_SB(1, 1), b3 + hstepB, voffB); PG8_STAGE(PG8_SA(1, 0), a3, voffA);
            PG8_WAIT_V(8); PG8_WAIT_L(0); PG8_BAR; PG8_MMA(1, 0, At, B0); PG8_MMA(1, 1, At, B1); PG8_BAR; PG8_SCHED;
        }
        if constexpr (ALIGN_EPI) { if (wr == 0) PG8_BAR; }
        E(acc, cur, wr, wc, fr, fq);
        if (!has_next) break;
#pragma unroll
        for (int a = 0; a < 2; ++a)
#pragma unroll
            for (int b = 0; b < 2; ++b)
#pragma unroll
                for (int m = 0; m < 4; ++m)
#pragma unroll
                    for (int n = 0; n < 2; ++n) acc[a][b][m][n] = (f32x4){0.f, 0.f, 0.f, 0.f};
        cur = nxt; cA = nA; cB = nB; ++ui;
        if constexpr (ALIGN_EPI) { if (wr == 1) PG8_BAR; }
    }
    PG8_WAIT_V(0);
    if constexpr (!ALIGN_EPI) { if (wr == 0) PG8_BAR; }
    PG8_BAR;
#undef PG8_SA
#undef PG8_SB
#undef PG8_STAGE
#undef PG8_LDA
#undef PG8_LDB
#undef PG8_MMA
#undef PG8_WAIT_V
#undef PG8_WAIT_L
#undef PG8_BAR
#undef PG8_SCHED
}
}

struct CvtJob { const float* src; int ld, K, col0, ntn, valid; bf16_t* dst; int row0, mul; };
__device__ __forceinline__ int cvt_job(const Params& p, int j, CvtJob& o) {
    uchar* ws = p.ws;
    const size_t FW = (size_t)D * DFF;
    switch (j) {
    case 0: o = {p.ffn_wg, DFF, D, 0, 44, 5632, (bf16_t*)(ws + WS_WGU1), 0, 256}; break;
    case 1: o = {p.ffn_wu, DFF, D, 0, 44, 5632, (bf16_t*)(ws + WS_WGU1), 128, 256}; break;
    case 2: o = {p.ffn_wd, D, DFF, 0, 16, 2048, (bf16_t*)(ws + WS_WD1), 0, 128}; break;
    case 3: o = {p.w_in, INW, D, 1024, 8, 1024, (bf16_t*)(ws + WS_WIN), OFF_K, 128}; break;
    case 4: o = {p.w_in, INW, D, 2048, 16, 2048, (bf16_t*)(ws + WS_WIN), OFF_V, 128}; break;
    case 5: o = {p.w_in, INW, D, 7200, 8, 1024, (bf16_t*)(ws + WS_WIN), OFF_NK, 128}; break;
    case 6: o = {p.w_in, INW, D, 8224, 8, 1024, (bf16_t*)(ws + WS_WIN), OFF_NV, 128}; break;
    case 7: o = {p.w_in, INW, D, 6144, 2, 32, (bf16_t*)(ws + WS_WIN), OFF_GF, 128}; break;
    case 8: o = {p.w_in, INW, D, 0, 8, 1024, (bf16_t*)(ws + WS_WIN), OFF_Q, 128}; break;
    case 9: o = {p.w_in, INW, D, 4096, 16, 2048, (bf16_t*)(ws + WS_WIN), OFF_R, 128}; break;
    case 10: o = {p.w_in, INW, D, 6176, 8, 1024, (bf16_t*)(ws + WS_WIN), OFF_NQ, 128}; break;
    case 11: o = {p.w_in, INW, D, 9248, 16, 2048, (bf16_t*)(ws + WS_WIN), OFF_M1, 128}; break;
    case 12: o = {p.w_in, INW, D, 11296, 16, 2048, (bf16_t*)(ws + WS_WIN), OFF_M2, 128}; break;
    case 13: o = {p.w_gla_o, D, D, 0, 16, 2048, (bf16_t*)(ws + WS_WGLAO), 0, 128}; break;
    case 14: o = {p.w_na_o, D, 1024, 0, 16, 2048, (bf16_t*)(ws + WS_WNAO), 0, 128}; break;
    case 15: o = {p.w_out, D, D, 0, 16, 2048, (bf16_t*)(ws + WS_WOUT), 0, 128}; break;
    case 16: o = {p.ffn_wg + FW, DFF, D, 0, 44, 5632, (bf16_t*)(ws + WS_WGU2), 0, 256}; break;
    case 17: o = {p.ffn_wu + FW, DFF, D, 0, 44, 5632, (bf16_t*)(ws + WS_WGU2), 128, 256}; break;
    default: o = {p.ffn_wd + FW, D, DFF, 0, 16, 2048, (bf16_t*)(ws + WS_WD2), 0, 128}; break;
    }
    return (o.K / 128) * o.ntn;
}
constexpr int N_CVT_JOBS = 19;
constexpr int N_CVT_TILES = 6 * 704 + 16 * 106 + 256 + 128 + 256;

struct CvtRegs { f32x4 a[4], b[4]; bf16_t* dst; int K; };
__device__ __forceinline__ void cvt_load(const CvtJob& J, int tl, CvtRegs& R) {
    const int tid = threadIdx.x;
    const int ktiles = J.K / 128, nt = tl / ktiles, kt = tl % ktiles;
    const int k0 = kt * 128, c0 = nt * 128;
    const int n4 = tid & 31, kp = tid >> 5;
    const int col = c0 + 4 * n4;
    R.dst = J.dst + (size_t)(J.row0 + nt * J.mul) * J.K + k0; R.K = J.K;
#pragma unroll
    for (int it = 0; it < 4; ++it) {
        const int kpair = kp + 16 * it;
        R.a[it] = (f32x4){0.f, 0.f, 0.f, 0.f}; R.b[it] = R.a[it];
        if (col < J.valid) { const float* sp = J.src + (size_t)(k0 + 2 * kpair) * J.ld + J.col0 + col; R.a[it] = __builtin_nontemporal_load((const f32x4*)sp); R.b[it] = __builtin_nontemporal_load((const f32x4*)(sp + J.ld)); }
    }
}
__device__ __forceinline__ void cvt_store(LAS uchar* lds, const CvtRegs& R) {
    LAS unsigned* T = (LAS unsigned*)lds;
    const int tid = threadIdx.x, n4 = tid & 31, kp = tid >> 5;
#pragma unroll
    for (int it = 0; it < 4; ++it) {
        const int kpair = kp + 16 * it;
#pragma unroll
        for (int i = 0; i < 4; ++i) T[(4 * n4 + i) * 65 + kpair] = cvt_pk_bf16(R.a[it][i], R.b[it][i]);
    }
    __syncthreads();
#pragma unroll
    for (int it = 0; it < 4; ++it) {
        const int ch = tid + 512 * it, n = ch >> 4, c16 = ch & 15;
        u32x4 v; v.x = T[n * 65 + 4 * c16]; v.y = T[n * 65 + 4 * c16 + 1]; v.z = T[n * 65 + 4 * c16 + 2]; v.w = T[n * 65 + 4 * c16 + 3];
        *(u32x4*)(R.dst + (size_t)n * R.K + 8 * c16) = v;
    }
    __syncthreads();
}

__device__ __forceinline__ void ada_item(LAS uchar* lds, const Params& p, int item) {
    LAS float* sv = (LAS float*)lds;
    LAS float* red = (LAS float*)(lds + 12288);
    const int tid = threadIdx.x, w = tid >> 6, lane = tid & 63;
    const int cb = item >> 1, kh = item & 1;
    for (int i = tid; i < 3 * 1024; i += NTHR) { const int s = i >> 10, k = kh * 1024 + (i & 1023); const float v = s < 2 ? p.c[s * D + k] : p.c_ctx[k]; sv[i] = siluf_(v); }
    __syncthreads();
    f32x4 a0 = (f32x4){0.f, 0.f, 0.f, 0.f}, a1 = a0, a2 = a0;
    const float* wp = p.w_ada + (size_t)(kh * 1024 + w * 128) * NMODC + cb * 256 + lane * 4;
#pragma unroll 8
    for (int k = 0; k < 128; ++k) {
        const f32x4 wv = *(const f32x4*)(wp + (size_t)k * NMODC);
        const int kk = w * 128 + k;
        a0 += sv[kk] * wv; a1 += sv[1024 + kk] * wv; a2 += sv[2048 + kk] * wv;
    }
    *(LAS f32x4*)(red + (w * 3 + 0) * 256 + lane * 4) = a0; *(LAS f32x4*)(red + (w * 3 + 1) * 256 + lane * 4) = a1; *(LAS f32x4*)(red + (w * 3 + 2) * 256 + lane * 4) = a2;
    __syncthreads();
    float* modp = (float*)(p.ws + WS_MODP);
    for (int i = tid; i < 768; i += NTHR) { const int s = i >> 8, col = i & 255; float v = 0.f;
#pragma unroll
        for (int ww = 0; ww < 8; ++ww) v += red[(ww * 3 + s) * 256 + col];
        const int gc = cb * 256 + col; if (kh == 0) v += p.b_ada[gc];
        modp[(size_t)(kh * 3 + s) * NMODC + gc] = v; }
    __syncthreads();
}

__device__ __forceinline__ void phase_prologue(LAS uchar* lds, const Params& p) {
    const int G = gridDim.x, bx = blockIdx.x;
    int t_lo, t_hi;
    if (G == 256) {
        if (bx < 144) { ada_item(lds, p, bx); t_lo = (bx * 89) / 4; t_hi = ((bx + 1) * 89) / 4; }
        else { t_lo = 3204 + (bx - 144) * 30; t_hi = t_lo + 30; }
        if (t_hi > N_CVT_TILES) t_hi = N_CVT_TILES;
    } else {
        for (int i = bx; i < 144; i += G) ada_item(lds, p, i);
        const int per = (N_CVT_TILES + G - 1) / G; t_lo = bx * per; t_hi = t_lo + per; if (t_hi > N_CVT_TILES) t_hi = N_CVT_TILES;
    }
    int j = 0, base = 0; CvtJob J; int cnt = cvt_job(p, 0, J);
    if (t_lo < t_hi) {
        CvtRegs cur, nxt;
        while (t_lo >= base + cnt) { base += cnt; ++j; cnt = cvt_job(p, j, J); }
        cvt_load(J, t_lo - base, cur);
        for (int t = t_lo; t < t_hi; ++t) {
            if (t + 1 < t_hi) { while (t + 1 >= base + cnt) { base += cnt; ++j; cnt = cvt_job(p, j, J); } cvt_load(J, t + 1 - base, nxt); }
            cvt_store(lds, cur);
            cur = nxt;
        }
    }
}

__device__ __forceinline__ f32x4 ld_mod(const float* modp, int s, int idx, int col) {
    const float* a = modp + (size_t)s * NMODC + idx * D + col; const float* b = a + (size_t)3 * NMODC;
    return *(const f32x4*)a + *(const f32x4*)b;
}
__device__ __forceinline__ void st_bf16x4(bf16_t* dst, f32x4 v) { u32x2 w; w.x = cvt_pk_bf16(v[0], v[1]); w.y = cvt_pk_bf16(v[2], v[3]); *(u32x2*)dst = w; }

__device__ __forceinline__ void phase_prenorm1(const Params& p) {
    const int w = threadIdx.x >> 6, lane = threadIdx.x & 63;
    const float* modp = (const float*)(p.ws + WS_MODP); bf16_t* A = (bf16_t*)(p.ws + WS_A);
    for (int item = blockIdx.x; item < NTOK / 8; item += gridDim.x) {
        const int row = item * 8 + w; const int s = row < NLAT ? row / SEQ : 2;
        const float* src = row < NLAT ? p.x + (size_t)row * D : p.ctx + (size_t)(row - NLAT) * D;
        f32x4 v[8]; float ss = 0.f;
#pragma unroll
        for (int j = 0; j < 8; ++j) { v[j] = *(const f32x4*)(src + j * 256 + lane * 4); ss += v[j][0] * v[j][0] + v[j][1] * v[j][1] + v[j][2] * v[j][2] + v[j][3] * v[j][3]; }
        ss = wave_sum(ss); const float rstd = rsqrtf(ss * (1.0f / D) + EPS);
#pragma unroll
        for (int j = 0; j < 8; ++j) { const int col = j * 256 + lane * 4;
            const f32x4 g = *(const f32x4*)(p.norm_g + 0 * D + col), sh = ld_mod(modp, s, 0, col), sc = ld_mod(modp, s, 1, col);
            st_bf16x4(A + (size_t)row * D + col, (v[j] * rstd * g) * (1.0f + sc) + sh); }
    }
}
template <int MODE>
__device__ __forceinline__ void phase_post(const Params& p) {
    const int w = threadIdx.x >> 6, lane = threadIdx.x & 63;
    const float* modp = (const float*)(p.ws + WS_MODP); bf16_t* A = (bf16_t*)(p.ws + WS_A);
    const bf16_t* Y = (const bf16_t*)(p.ws + WS_Y); const bf16_t* YC = (const bf16_t*)(p.ws + WS_YC);
    constexpr int NROWS = MODE == 0 ? NTOK : NLAT;
    constexpr int GI = MODE == 0 ? 2 : (MODE == 1 ? 5 : 8), GP = MODE == 0 ? 1 : (MODE == 1 ? 3 : 5), GN = MODE == 0 ? 2 : 4, SI = MODE == 0 ? 3 : 6;
    constexpr float WRES = MODE == 1 ? 1.0f : 0.5f;
    for (int item = blockIdx.x; item < NROWS / 8; item += gridDim.x) {
        const int row = item * 8 + w; const int s = row < NLAT ? row / SEQ : 2;
        const float* xin = MODE == 0 ? (row < NLAT ? p.x + (size_t)row * D : p.ctx + (size_t)(row - NLAT) * D) : p.out + (size_t)row * D;
        f32x4 y[8], xv8[8]; float ss = 0.f;
#pragma unroll
        for (int j = 0; j < 8; ++j) xv8[j] = *(const f32x4*)(xin + j * 256 + lane * 4);
#pragma unroll
        for (int j = 0; j < 8; ++j) { const int col = j * 256 + lane * 4;
            if (MODE == 0 && row >= NLAT) { const bf16_t* yc = YC + (size_t)(row - NLAT) * D + col; f32x4 a = (f32x4){0.f, 0.f, 0.f, 0.f};
#pragma unroll
                for (int sp = 0; sp < 4; ++sp) { const u32x2 t = *(const u32x2*)(yc + (size_t)sp * NCTX * D); a += (f32x4){bflo(t.x), bfhi(t.x), bflo(t.y), bfhi(t.y)}; }
                y[j] = a; }
            else { const u32x2 t = *(const u32x2*)(Y + (size_t)row * D + col); y[j] = (f32x4){bflo(t.x), bfhi(t.x), bflo(t.y), bfhi(t.y)}; }
            ss += y[j][0] * y[j][0] + y[j][1] * y[j][1] + y[j][2] * y[j][2] + y[j][3] * y[j][3]; }
        ss = wave_sum(ss); const float rstd = rsqrtf(ss * (1.0f / D) + EPS);
        float ss2 = 0.f;
#pragma unroll
        for (int j = 0; j < 8; ++j) { const int col = j * 256 + lane * 4;
            const f32x4 g = *(const f32x4*)(p.norm_g + GP * D + col), gt = ld_mod(modp, s, GI, col), xv = xv8[j];
            const f32x4 x1 = xv + WRES * gt * (y[j] * rstd * g);
            y[j] = x1; ss2 += x1[0] * x1[0] + x1[1] * x1[1] + x1[2] * x1[2] + x1[3] * x1[3];
            if (row < NLAT) *(f32x4*)(p.out + (size_t)row * D + col) = x1; }
        if (MODE == 2) continue;
        ss2 = wave_sum(ss2); const float rstd2 = rsqrtf(ss2 * (1.0f / D) + EPS);
#pragma unroll
        for (int j = 0; j < 8; ++j) { const int col = j * 256 + lane * 4;
            const f32x4 g = *(const f32x4*)(p.norm_g + GN * D + col), sh = ld_mod(modp, s, SI, col), sc = ld_mod(modp, s, SI + 1, col);
            st_bf16x4(A + (size_t)row * D + col, (y[j] * rstd2 * g) * (1.0f + sc) + sh); }
    }
}

constexpr int PREP_PITCH = 264;
constexpr int PREP_TILE = 64 * PREP_PITCH * 2;
__device__ __forceinline__ size_t gla_idx(int b, int h, int dir, int cid) { return (size_t)(((b * 4 + h) * 2 + dir) * NCH + cid); }

__device__ __forceinline__ void gla_prep_item(LAS uchar* lds, const Params& p, int item) {
    const int tid = threadIdx.x, wv = tid >> 6, lane = tid & 63;
    int h, cid, b;
    if (item < NB * 64 * 4) { h = item & 3; const int bc = item >> 2; cid = 4 + (bc & 63); b = bc >> 6; }
    else { const int it2 = item - NB * 64 * 4; h = it2 & 3; const int bc = it2 >> 2; cid = bc & 3; b = bc >> 2; }
    const bool lat = cid >= 4;
    const int rowbase = lat ? b * SEQ + (cid - 4) * 64 : NLAT + b * CTXL + cid * 64;
    const bf16_t* PROJ = (const bf16_t*)(p.ws + WS_PROJ);
    LAS float* Gs = (LAS float*)lds;
    {
        const int i = tid >> 3, c4 = (tid & 7) * 4;
        const u32x2 g = *(const u32x2*)(PROJ + (size_t)(rowbase + i) * LDP + OFF_GF + c4);
        *(LAS f32x4*)(Gs + i * 32 + c4) = (f32x4){bflo(g.x), bfhi(g.x), bflo(g.y), bfhi(g.y)};
    }
    __syncthreads();
    const int wvu = __builtin_amdgcn_readfirstlane(tid >> 6);
    const int d = tid & 255, dir = wvu >> 2;
    float wg[16];
#pragma unroll
    for (int r = 0; r < 16; ++r) wg[r] = p.gla_wg[(size_t)(dir * 16 + r) * 1024 + h * 256 + d] * LOG2E;
    const float bg = p.gla_bg[dir * 1024 + h * 256 + d] * LOG2E;
    const int axis = (wvu >> 1) & 1, fi = d & 63; const bool first = (wvu & 1) == 0;
    const int dpart = first ? d + 64 : d - 64;
    const float freq = __expf(-(float)fi * (9.210340371976184f / 64.0f));
    const float ang_row = (float)(cid - 4) * freq;
    float cs_row, sn_row; __sincosf(ang_row, &sn_row, &cs_row);
    if (!first) sn_row = -sn_row; sn_row = -sn_row;
    const float freq_rev = (first ? -freq : freq) * 0.15915494309189535f;
    bf16_t* QD = (bf16_t*)(p.ws + WS_QD) + gla_idx(b, h, dir, cid) * (64 * 256);
    bf16_t* KET = (bf16_t*)(p.ws + WS_KET) + gla_idx(b, h, dir, cid) * (256 * 64);
    LAS bf16_t* QDs = (LAS bf16_t*)(lds + 8192 + dir * 2 * PREP_TILE);
    LAS bf16_t* KIs = (LAS bf16_t*)(lds + 8192 + dir * 2 * PREP_TILE + PREP_TILE);
    float cum = 0.f;
    unsigned short rk[8], rkp[8], rq[8], rqp[8], nk_[8], nkp[8], nq_[8], nqp[8];
    const bf16_t* pbase = PROJ + (size_t)rowbase * LDP + h * 256;
    const unsigned ok_ = OFF_K + d, okp_ = OFF_K + dpart, oq_ = OFF_Q + d, oqp_ = OFF_Q + dpart;
#define PREP_LOAD(dk_, dkp_, dq_, dqp_, n8_) do { _Pragma("unroll") for (int jj = 0; jj < 8; ++jj) { const int n_ = (n8_) * 8 + jj, i_ = dir ? 63 - n_ : n_; \
        const unsigned to_ = (unsigned)i_ * (unsigned)LDP; dk_[jj] = pbase[to_ + ok_]; \
        if (lat) { dkp_[jj] = pbase[to_ + okp_]; dq_[jj] = pbase[to_ + oq_]; dqp_[jj] = pbase[to_ + oqp_]; } else { dkp_[jj] = 0; dq_[jj] = 0; dqp_[jj] = 0; } } } while (0)
    PREP_LOAD(rk, rkp, rq, rqp, 0);
    for (int n8 = 0; n8 < 8; ++n8) {
        if (n8 < 7) PREP_LOAD(nk_, nkp, nq_, nqp, n8 + 1);
        float ke[8];
#pragma unroll
        for (int jj = 0; jj < 8; ++jj) {
            const int n = n8 * 8 + jj, i = dir ? 63 - n : n;
            const LAS f32x4* gp = (const LAS f32x4*)(Gs + i * 32 + dir * 16);
            float z = bg;
#pragma unroll
            for (int q4 = 0; q4 < 4; ++q4) { const f32x4 gv = gp[q4]; z += gv[0] * wg[q4 * 4] + gv[1] * wg[q4 * 4 + 1] + gv[2] * wg[q4 * 4 + 2] + gv[3] * wg[q4 * 4 + 3]; }
            cum += (fminf(z, 0.f) - __builtin_amdgcn_logf(1.0f + __builtin_amdgcn_exp2f(-fabsf(z)))) * (1.0f / 16.0f);
            float kv = bf2f(rk[jj]);
            if (lat) {
                float cs, sn;
                if (axis == 0) { cs = cs_row; sn = sn_row; } else { const float a = (float)i * freq_rev; cs = __builtin_amdgcn_cosf(a); sn = __builtin_amdgcn_sinf(a); }
                const float kp2 = bf2f(rkp[jj]);
                kv = kv * cs + kp2 * sn;
                float qv = bf2f(rq[jj]); const float qp2 = bf2f(rqp[jj]);
                qv = (qv * cs + qp2 * sn) * 0.0625f;
                const float qd = qv * __builtin_amdgcn_exp2f(cum);
                const bf16_t qb = (bf16_t)(cvt_pk_bf16(qd, 0.f) & 0xffffu);
                QD[(size_t)i * 256 + d] = qb; QDs[i * PREP_PITCH + d] = qb;
            }
            const float ki = kv * __builtin_amdgcn_exp2f(-cum);
            if (lat) KIs[i * PREP_PITCH + d] = (bf16_t)(cvt_pk_bf16(ki, 0.f) & 0xffffu);
            ke[jj] = ki;
        }
        u32x4 o;
        if (dir == 0) { o.x = cvt_pk_bf16(ke[0], ke[1]); o.y = cvt_pk_bf16(ke[2], ke[3]); o.z = cvt_pk_bf16(ke[4], ke[5]); o.w = cvt_pk_bf16(ke[6], ke[7]); *(u32x4*)(KET + (size_t)d * 64 + n8 * 8) = o; }
        else { o.x = cvt_pk_bf16(ke[7], ke[6]); o.y = cvt_pk_bf16(ke[5], ke[4]); o.z = cvt_pk_bf16(ke[3], ke[2]); o.w = cvt_pk_bf16(ke[1], ke[0]); *(u32x4*)(KET + (size_t)d * 64 + (7 - n8) * 8) = o; }
#pragma unroll
        for (int jj = 0; jj < 8; ++jj) { rk[jj] = nk_[jj]; rkp[jj] = nkp[jj]; rq[jj] = nq_[jj]; rqp[jj] = nqp[jj]; }
    }
#undef PREP_LOAD
    ((float*)(p.ws + WS_DEC))[gla_idx(b, h, dir, cid) * 256 + d] = __builtin_amdgcn_exp2f(cum);
    {
        bf16_t* VT = (bf16_t*)(p.ws + WS_VT) + (size_t)((b * 4 + h) * NCH + cid) * (512 * 64);
        const bf16_t* vsrc = PROJ + (size_t)rowbase * LDP + OFF_V + h * 512 + tid;
        unsigned short e[64];
#pragma unroll
        for (int t = 0; t < 64; ++t) e[t] = vsrc[(size_t)t * LDP];
#pragma unroll
        for (int n8 = 0; n8 < 8; ++n8) {
            u32x4 o; o.x = e[n8 * 8] | ((unsigned)e[n8 * 8 + 1] << 16); o.y = e[n8 * 8 + 2] | ((unsigned)e[n8 * 8 + 3] << 16); o.z = e[n8 * 8 + 4] | ((unsigned)e[n8 * 8 + 5] << 16); o.w = e[n8 * 8 + 6] | ((unsigned)e[n8 * 8 + 7] << 16);
            *(u32x4*)(VT + (size_t)tid * 64 + n8 * 8) = o;
        }
    }
    __syncthreads();
    if (lat) {
        const int wdir = wv >> 2, ib = wv & 3, fr = lane & 15, g = lane >> 4;
        const LAS bf16_t* Qs = (const LAS bf16_t*)(lds + 8192 + wdir * 2 * PREP_TILE);
        const LAS bf16_t* Ks = (const LAS bf16_t*)(lds + 8192 + wdir * 2 * PREP_TILE + PREP_TILE);
        f32x4 acc[4];
#pragma unroll
        for (int nb = 0; nb < 4; ++nb) acc[nb] = (f32x4){0.f, 0.f, 0.f, 0.f};
        bf16x8 qf[8];
#pragma unroll
        for (int kk = 0; kk < 8; ++kk) qf[kk] = *(const LAS bf16x8*)(Qs + (16 * ib + fr) * PREP_PITCH + 32 * kk + 8 * g);
#pragma unroll
        for (int nb = 0; nb < 4; ++nb) {
            bf16x8 kf[8];
#pragma unroll
            for (int kk = 0; kk < 8; ++kk) kf[kk] = *(const LAS bf16x8*)(Ks + (16 * nb + fr) * PREP_PITCH + 32 * kk + 8 * g);
            __builtin_amdgcn_sched_barrier(0);
#pragma unroll
            for (int kk = 0; kk < 8; ++kk) acc[nb] = __builtin_amdgcn_mfma_f32_16x16x32_bf16(kf[kk], qf[kk], acc[nb], 0, 0, 0);
        }
        bf16_t* PM = (bf16_t*)(p.ws + WS_PM) + gla_idx(b, h, wdir, cid) * 4096;
        const int i = 16 * ib + fr;
#pragma unroll
        for (int nb = 0; nb < 4; ++nb) {
            float v[4];
#pragma unroll
            for (int r = 0; r < 4; ++r) { const int j = 16 * nb + 4 * g + r; const bool keep = wdir ? (j >= i) : (j <= i); v[r] = keep ? acc[nb][r] : 0.f; }
            u32x2 o; o.x = cvt_pk_bf16(v[0], v[1]); o.y = cvt_pk_bf16(v[2], v[3]);
            *(u32x2*)(PM + (size_t)i * 64 + 16 * nb + 4 * g) = o;
        }
    }
    __syncthreads();
}
__device__ __forceinline__ void na_vt_item(const Params& p, int item) {
    const int tid = threadIdx.x; const int blk = item % NCH, b = item / NCH; const bool lat = blk >= 4;
    const int rowbase = lat ? b * SEQ + (blk - 4) * 64 : NLAT + b * CTXL + blk * 64;
    const bf16_t* PROJ = (const bf16_t*)(p.ws + WS_PROJ);
    const int c = 2 * tid, h = c >> 6, dv = c & 63;
    const bf16_t* src = PROJ + (size_t)rowbase * LDP + OFF_NV + c;
    bf16_t* dst; int pitch;
    if (lat) { dst = (bf16_t*)(p.ws + WS_NVTL) + ((size_t)((b * 16 + h) * 64 + (blk - 4)) * 64 + dv) * 64; pitch = 64; }
    else { dst = (bf16_t*)(p.ws + WS_NVTC) + ((size_t)(b * 16 + h) * 64 + dv) * 256 + blk * 64; pitch = 256; }
    unsigned e[64];
#pragma unroll
    for (int t = 0; t < 64; ++t) e[t] = *(const unsigned*)(src + (size_t)t * LDP);
#pragma unroll
    for (int n8 = 0; n8 < 8; ++n8) {
        const unsigned* q = e + n8 * 8;
        u32x4 lo, hi;
        lo.x = (q[0] & 0xffffu) | (q[1] << 16); lo.y = (q[2] & 0xffffu) | (q[3] << 16); lo.z = (q[4] & 0xffffu) | (q[5] << 16); lo.w = (q[6] & 0xffffu) | (q[7] << 16);
        hi.x = (q[0] >> 16) | (q[1] & 0xffff0000u); hi.y = (q[2] >> 16) | (q[3] & 0xffff0000u); hi.z = (q[4] >> 16) | (q[5] & 0xffff0000u); hi.w = (q[6] >> 16) | (q[7] & 0xffff0000u);
        *(u32x4*)(dst + n8 * 8) = lo; *(u32x4*)(dst + pitch + n8 * 8) = hi;
    }
}

constexpr int ST_PITCH = 264, VT_PITCH = 72;
constexpr int SC_ST = 0, SC_QD = 64 * ST_PITCH * 2, SC_VT = 2 * 64 * ST_PITCH * 2, SC_PM = SC_VT + 64 * VT_PITCH * 2, SC_KT = SC_PM + 64 * VT_PITCH * 2, SC_DC = SC_KT + 256 * VT_PITCH * 2;
__device__ __forceinline__ int scan_cid(int n, int dir) { return n < 4 ? (dir ? 3 - n : n) : (dir ? 67 - (n - 4) : n); }

__device__ __forceinline__ void gla_scan_task(LAS uchar* lds, const Params& p, int task) {
    const int tid = threadIdx.x, w = __builtin_amdgcn_readfirstlane(tid >> 6), lane = tid & 63;
    const int xcd = task & 7, jj = task >> 3, combo = xcd * 2 + (jj >> 3), sl = jj & 7;
    const int b = combo >> 3, h = (combo >> 1) & 3, dir = combo & 1, dv0 = sl * 64;
    const int l32 = lane & 31, hf = lane >> 5;
    const bool isU = w >= 4; const int u = w & 3;
    const int dvb = u >> 1, ibk = u & 1;
    LAS bf16_t* ST = (LAS bf16_t*)(lds + SC_ST); LAS bf16_t* QDs = (LAS bf16_t*)(lds + SC_QD); LAS bf16_t* VTs = (LAS bf16_t*)(lds + SC_VT); LAS bf16_t* PMs = (LAS bf16_t*)(lds + SC_PM);
    LAS bf16_t* KTs = (LAS bf16_t*)(lds + SC_KT); LAS float* DCs = (LAS float*)(lds + SC_DC);
    for (int i = tid; i < 64 * ST_PITCH / 2; i += NTHR) ((LAS unsigned*)lds)[i] = 0u;
    const bf16_t* QDb = (const bf16_t*)(p.ws + WS_QD); const bf16_t* KITb = (const bf16_t*)(p.ws + WS_KET); const bf16_t* PMb = (const bf16_t*)(p.ws + WS_PM);
    const float* DECb = (const float*)(p.ws + WS_DEC); const bf16_t* VTb = (const bf16_t*)(p.ws + WS_VT);
    bf16_t* Ob = (bf16_t*)(p.ws + (dir ? WS_OB : WS_OF));
    f32x16 S00, S01, S10, S11;
#pragma unroll
    for (int i = 0; i < 16; ++i) { S00[i] = 0.f; S01[i] = 0.f; S10[i] = 0.f; S11[i] = 0.f; }
    const int vrow = tid >> 3, vc = (tid & 7) * 8;
    u32x4 qd_r[4], vt_r, pm_r, kt_r[4]; f32x4 dc_r;
#define SC_FETCH(n_) do { const int cid_ = scan_cid((n_), dir); const size_t gi_ = gla_idx(b, h, dir, cid_); \
        vt_r = *(const u32x4*)(VTb + (size_t)((b * 4 + h) * NCH + cid_) * (512 * 64) + (size_t)(dv0 + vrow) * 64 + vc); \
        _Pragma("unroll") for (int k4 = 0; k4 < 4; ++k4) kt_r[k4] = *(const u32x4*)(KITb + gi_ * (256 * 64) + (size_t)(tid + 512 * k4) * 8); \
        if (tid < 64) dc_r = *(const f32x4*)(DECb + gi_ * 256 + 4 * tid); \
        if ((n_) >= 4) { pm_r = *(const u32x4*)(PMb + gi_ * 4096 + vrow * 64 + vc); \
            _Pragma("unroll") for (int k4 = 0; k4 < 4; ++k4) { const int ch_ = tid + 512 * k4; qd_r[k4] = *(const u32x4*)(QDb + gi_ * (64 * 256) + (size_t)(ch_ >> 5) * 256 + (ch_ & 31) * 8); } } } while (0)
#define SC_COMMIT(n_) do { *(LAS u32x4*)(VTs + vrow * VT_PITCH + vc) = vt_r; \
        _Pragma("unroll") for (int k4 = 0; k4 < 4; ++k4) { const int ch_ = tid + 512 * k4; *(LAS u32x4*)(KTs + (ch_ >> 3) * VT_PITCH + (ch_ & 7) * 8) = kt_r[k4]; } \
        if (tid < 64) *(LAS f32x4*)(DCs + 4 * tid) = dc_r; \
        if ((n_) >= 4) { *(LAS u32x4*)(PMs + vrow * VT_PITCH + vc) = pm_r; \
            _Pragma("unroll") for (int k4 = 0; k4 < 4; ++k4) { const int ch_ = tid + 512 * k4; *(LAS u32x4*)(QDs + (ch_ >> 5) * ST_PITCH + (ch_ & 31) * 8) = qd_r[k4]; } } } while (0)
    SC_FETCH(0);
    SC_COMMIT(0);
    __syncthreads();
    for (int n = 0; n < NCH; ++n) {
        if (n + 1 < NCH) SC_FETCH(n + 1);
        if (isU) {
            f32x4 dec[2][4]; bf16x8 kit[8];
#pragma unroll
            for (int rb = 0; rb < 2; ++rb)
#pragma unroll
                for (int j4 = 0; j4 < 4; ++j4) dec[rb][j4] = *(const LAS f32x4*)(DCs + 64 * u + 32 * rb + 8 * j4 + 4 * hf);
#pragma unroll
            for (int rb = 0; rb < 2; ++rb)
#pragma unroll
                for (int kk = 0; kk < 4; ++kk) kit[rb * 4 + kk] = *(const LAS bf16x8*)(KTs + (64 * u + 32 * rb + l32) * VT_PITCH + 16 * kk + 8 * hf);
            const LAS bf16_t* vb0 = VTs + l32 * VT_PITCH + 8 * hf; const LAS bf16_t* vb1 = vb0 + 32 * VT_PITCH;
            bf16x8 ua[4], ub[4];
#pragma unroll
            for (int kk = 0; kk < 4; ++kk) { ua[kk] = *(const LAS bf16x8*)(vb0 + 16 * kk); ub[kk] = *(const LAS bf16x8*)(vb1 + 16 * kk); }
#pragma unroll
            for (int kk = 0; kk < 4; ++kk) {
                S00 = __builtin_amdgcn_mfma_f32_32x32x16_bf16(kit[kk], ua[kk], S00, 0, 0, 0);
                S01 = __builtin_amdgcn_mfma_f32_32x32x16_bf16(kit[kk], ub[kk], S01, 0, 0, 0);
                S10 = __builtin_amdgcn_mfma_f32_32x32x16_bf16(kit[4 + kk], ua[kk], S10, 0, 0, 0);
                S11 = __builtin_amdgcn_mfma_f32_32x32x16_bf16(kit[4 + kk], ub[kk], S11, 0, 0, 0); }
#pragma unroll
            for (int j4 = 0; j4 < 4; ++j4)
#pragma unroll
                for (int r = 0; r < 4; ++r) { S00[j4 * 4 + r] *= dec[0][j4][r]; S01[j4 * 4 + r] *= dec[0][j4][r]; S10[j4 * 4 + r] *= dec[1][j4][r]; S11[j4 * 4 + r] *= dec[1][j4][r]; }
        } else if (n >= 4) {
            const int cid = scan_cid(n, dir);
            f32x16 o;
#pragma unroll
            for (int i = 0; i < 16; ++i) o[i] = 0.f;
            const LAS bf16_t* sa = ST + (32 * dvb + l32) * ST_PITCH + 8 * hf; const LAS bf16_t* qb_ = QDs + (32 * ibk + l32) * ST_PITCH + 8 * hf;
            const LAS bf16_t* va = VTs + (32 * dvb + l32) * VT_PITCH + 8 * hf; const LAS bf16_t* pb = PMs + (32 * ibk + l32) * VT_PITCH + 8 * hf;
#pragma unroll
            for (int half = 0; half < 2; ++half) {
                bf16x8 fa[8], fb[8];
#pragma unroll
                for (int kk = 0; kk < 8; ++kk) { fa[kk] = *(const LAS bf16x8*)(sa + 16 * (half * 8 + kk)); fb[kk] = *(const LAS bf16x8*)(qb_ + 16 * (half * 8 + kk)); }
#pragma unroll
                for (int kk = 0; kk < 8; ++kk) o = __builtin_amdgcn_mfma_f32_32x32x16_bf16(fa[kk], fb[kk], o, 0, 0, 0);
            }
            {
                bf16x8 fa[4], fb[4];
#pragma unroll
                for (int q = 0; q < 4; ++q) { fa[q] = *(const LAS bf16x8*)(va + 16 * q); fb[q] = *(const LAS bf16x8*)(pb + 16 * q); }
#pragma unroll
                for (int q = 0; q < 4; ++q) o = __builtin_amdgcn_mfma_f32_32x32x16_bf16(fa[q], fb[q], o, 0, 0, 0);
            }
            bf16_t* op = Ob + (size_t)(b * SEQ + (cid - 4) * 64 + 32 * ibk + l32) * D + h * 512 + dv0 + 32 * dvb + 4 * hf;
#pragma unroll
            for (int j4 = 0; j4 < 4; ++j4) { u32x2 ov; ov.x = cvt_pk_bf16(o[j4 * 4], o[j4 * 4 + 1]); ov.y = cvt_pk_bf16(o[j4 * 4 + 2], o[j4 * 4 + 3]); *(u32x2*)(op + 8 * j4) = ov; }
        }
        __syncthreads();
        if (isU) {
            LAS bf16_t* stw = ST + l32 * ST_PITCH + 64 * u + 4 * hf;
#pragma unroll
            for (int j4 = 0; j4 < 4; ++j4) { u32x2 sv;
                sv.x = cvt_pk_bf16(S00[j4 * 4], S00[j4 * 4 + 1]); sv.y = cvt_pk_bf16(S00[j4 * 4 + 2], S00[j4 * 4 + 3]); *(LAS u32x2*)(stw + 8 * j4) = sv;
                sv.x = cvt_pk_bf16(S01[j4 * 4], S01[j4 * 4 + 1]); sv.y = cvt_pk_bf16(S01[j4 * 4 + 2], S01[j4 * 4 + 3]); *(LAS u32x2*)(stw + 32 * ST_PITCH + 8 * j4) = sv;
                sv.x = cvt_pk_bf16(S10[j4 * 4], S10[j4 * 4 + 1]); sv.y = cvt_pk_bf16(S10[j4 * 4 + 2], S10[j4 * 4 + 3]); *(LAS u32x2*)(stw + 32 + 8 * j4) = sv;
                sv.x = cvt_pk_bf16(S11[j4 * 4], S11[j4 * 4 + 1]); sv.y = cvt_pk_bf16(S11[j4 * 4 + 2], S11[j4 * 4 + 3]); *(LAS u32x2*)(stw + 32 * ST_PITCH + 32 + 8 * j4) = sv; }
        }
        if (n + 1 < NCH) SC_COMMIT(n + 1);
        __syncthreads();
    }
#undef SC_FETCH
#undef SC_COMMIT
}

constexpr int NA_KV = 24576, NA_KP = 72, NA_CP = 264;
constexpr int NA_QW = 20480;
__device__ __forceinline__ void na_item(LAS uchar* lds, const Params& p, int it) {
    const int tid = threadIdx.x, w = tid >> 6, lane = tid & 63, fr = lane & 15, g = lane >> 4;
    const int r = it & 63, h = (it >> 6) & 15, b = it >> 10;
    const int qb = w & 3, kind = w >> 2;
    LAS float* rpbS = (LAS float*)lds;
    LAS float* CBm = (LAS float*)(lds + 2048);
    LAS float* CBl = (LAS float*)(lds + 2048 + 256);
    LAS float* CBo = (LAS float*)(lds + 4096);
    LAS bf16_t* KL = (LAS bf16_t*)(lds + NA_KV);
    LAS bf16_t* KC = (LAS bf16_t*)(lds + NA_KV + 512 * NA_KP * 2);
    const bf16_t* PROJ = (const bf16_t*)(p.ws + WS_PROJ);
    const int rs = min(max(r - 4, 0), 56);
    u32x4 st[12];
    {
        const int c8 = (tid & 7) * 8;
#pragma unroll
        for (int k = 0; k < 8; ++k) { const int key = (tid >> 3) + 64 * k; st[k] = *(const u32x4*)(PROJ + (size_t)(b * SEQ + (rs + k) * 64 + (tid >> 3)) * LDP + OFF_NK + h * 64 + c8); (void)key; }
#pragma unroll
        for (int k = 0; k < 4; ++k) st[8 + k] = *(const u32x4*)(PROJ + (size_t)(NLAT + b * CTXL + (tid >> 3) + 64 * k) * LDP + OFF_NK + h * 64 + c8);
    }
    const int c0 = qb == 0 ? 0 : (qb == 1 ? 8 : (qb == 2 ? 24 : 32));
    const int j = 16 * qb + fr;
    const int cs = min(max(j - 8, 0), 48);
    const bf16_t* qrow = PROJ + (size_t)(b * SEQ + r * 64 + j) * LDP + OFF_NQ + h * 64 + 8 * g;
    const bf16x8 q0 = *(const bf16x8*)qrow, q1 = *(const bf16x8*)(qrow + 32);
    if (tid < 480) { const int rw = tid >> 5, cc = tid & 31; rpbS[tid] = cc < 31 ? p.na_rpb[h * 465 + rw * 31 + cc] * LOG2E : -1e30f; }
    {
        const int c8 = (tid & 7) * 8, kr = tid >> 3;
#pragma unroll
        for (int k = 0; k < 8; ++k) *(LAS u32x4*)(KL + (kr + 64 * k) * NA_KP + c8) = st[k];
#pragma unroll
        for (int k = 0; k < 4; ++k) *(LAS u32x4*)(KC + (kr + 64 * k) * NA_KP + c8) = st[8 + k];
    }
    __syncthreads();
    {
        const bf16_t* vl = (const bf16_t*)(p.ws + WS_NVTL) + (size_t)((b * 16 + h) * 64 + rs) * (64 * 64);
#pragma unroll
        for (int k = 0; k < 8; ++k) st[k] = *(const u32x4*)(vl + (size_t)(tid + 512 * k) * 8);
        const bf16_t* vc = (const bf16_t*)(p.ws + WS_NVTC) + (size_t)(b * 16 + h) * (64 * 256);
#pragma unroll
        for (int k = 0; k < 4; ++k) st[8 + k] = *(const u32x4*)(vc + (size_t)(tid + 512 * k) * 8);
    }
    const int mk = 8 * (fr >> 2) + (fr & 3);
    f32x4 s[16];
#pragma unroll
    for (int kb = 0; kb < 16; ++kb) {
        const int pp = kb >> 1, e = kb & 1;
        const LAS bf16_t* krow = kind == 0 ? KL + (pp * 64 + c0 + mk + 4 * e) * NA_KP + 8 * g : KC + (32 * pp + mk + 4 * e) * NA_KP + 8 * g;
        const bf16x8 k0 = *(const LAS bf16x8*)krow, k1 = *(const LAS bf16x8*)(krow + 32);
        f32x4 a = (f32x4){0.f, 0.f, 0.f, 0.f};
        a = __builtin_amdgcn_mfma_f32_16x16x32_bf16(k0, q0, a, 0, 0, 0);
        a = __builtin_amdgcn_mfma_f32_16x16x32_bf16(k1, q1, a, 0, 0, 0);
        s[kb] = a;
    }
    const float sc = 0.125f * LOG2E;
    float mx = -1e30f;
    if (kind == 0) {
        int colb[8];
        const int rowbase = (rs - r + 7) * 32;
#pragma unroll
        for (int x = 0; x < 8; ++x) { const int kc = c0 + 8 * g + x; const bool ok = (kc >= cs) && (kc < cs + 16); colb[x] = rowbase + (ok ? kc - j + 15 : 31); }
#pragma unroll
        for (int kb = 0; kb < 16; ++kb) {
            const int pp = kb >> 1, e = kb & 1;
#pragma unroll
            for (int i = 0; i < 4; ++i) { const float t = s[kb][i] * sc + rpbS[colb[4 * e + i] + pp * 32]; s[kb][i] = t; mx = fmaxf(mx, t); }
        }
    } else {
#pragma unroll
        for (int kb = 0; kb < 16; ++kb)
#pragma unroll
            for (int i = 0; i < 4; ++i) { const float t = s[kb][i] * sc; s[kb][i] = t; mx = fmaxf(mx, t); }
    }
    mx = fmaxf(mx, __shfl_xor(mx, 16)); mx = fmaxf(mx, __shfl_xor(mx, 32));
    float l = 0.f;
#pragma unroll
    for (int kb = 0; kb < 16; ++kb)
#pragma unroll
        for (int i = 0; i < 4; ++i) { const float e2 = __builtin_amdgcn_exp2f(s[kb][i] - mx); s[kb][i] = e2; l += e2; }
    l += __shfl_xor(l, 16); l += __shfl_xor(l, 32);
    __syncthreads();
    {
#pragma unroll
        for (int k = 0; k < 8; ++k) { const int ch = tid + 512 * k; *(LAS u32x4*)(KL + (ch >> 3) * NA_KP + (ch & 7) * 8) = st[k]; }
#pragma unroll
        for (int k = 0; k < 4; ++k) { const int ch = tid + 512 * k; *(LAS u32x4*)(KC + (ch >> 5) * NA_CP + (ch & 31) * 8) = st[8 + k]; }
    }
    __syncthreads();
    f32x4 o[4];
#pragma unroll
    for (int dvb = 0; dvb < 4; ++dvb) o[dvb] = (f32x4){0.f, 0.f, 0.f, 0.f};
#pragma unroll
    for (int pp = 0; pp < 8; ++pp) {
        u32x4 pk; pk.x = cvt_pk_bf16(s[2 * pp][0], s[2 * pp][1]); pk.y = cvt_pk_bf16(s[2 * pp][2], s[2 * pp][3]); pk.z = cvt_pk_bf16(s[2 * pp + 1][0], s[2 * pp + 1][1]); pk.w = cvt_pk_bf16(s[2 * pp + 1][2], s[2 * pp + 1][3]);
        const bf16x8 pf = as_bf16x8(pk);
#pragma unroll
        for (int dvb = 0; dvb < 4; ++dvb) {
            const LAS bf16_t* vp = kind == 0 ? KL + (pp * 64 + 16 * dvb + fr) * NA_KP + c0 + 8 * g : KC + (16 * dvb + fr) * NA_CP + 32 * pp + 8 * g;
            o[dvb] = __builtin_amdgcn_mfma_f32_16x16x32_bf16(*(const LAS bf16x8*)vp, pf, o[dvb], 0, 0, 0);
        }
    }
    if (kind == 1) {
        if (g == 0) { CBm[qb * 16 + fr] = mx; CBl[qb * 16 + fr] = l; }
#pragma unroll
        for (int dvb = 0; dvb < 4; ++dvb) *(LAS f32x4*)(CBo + (qb * 64 + lane) * 16 + dvb * 4) = o[dvb];
    }
    __syncthreads();
    if (kind == 0) {
        const float m2 = CBm[qb * 16 + fr], l2 = CBl[qb * 16 + fr];
        const float M = fmaxf(mx, m2), a1 = __builtin_amdgcn_exp2f(mx - M), a2 = __builtin_amdgcn_exp2f(m2 - M);
        const float inv = fast_rcp(l * a1 + l2 * a2);
        bf16_t* op = (bf16_t*)(p.ws + WS_NAO) + (size_t)(b * SEQ + r * 64 + j) * 1024 + h * 64 + 4 * g;
#pragma unroll
        for (int dvb = 0; dvb < 4; ++dvb) {
            const f32x4 o2 = *(const LAS f32x4*)(CBo + (qb * 64 + lane) * 16 + dvb * 4);
            const f32x4 v = (o[dvb] * a1 + o2 * a2) * inv;
            u32x2 ov; ov.x = cvt_pk_bf16(v[0], v[1]); ov.y = cvt_pk_bf16(v[2], v[3]); *(u32x2*)(op + 16 * dvb) = ov;
        }
    }
    __syncthreads();
}

__device__ __forceinline__ void phase_readout(const Params& p) {
    const int w = threadIdx.x >> 6, lane = threadIdx.x & 63;
    const bf16_t* OF = (const bf16_t*)(p.ws + WS_OF); const bf16_t* OB = (const bf16_t*)(p.ws + WS_OB); const bf16_t* PROJ = (const bf16_t*)(p.ws + WS_PROJ);
    bf16_t* AG = (bf16_t*)(p.ws + WS_AG);
    for (int item = blockIdx.x; item < NLAT / 8; item += gridDim.x) {
        const int row = item * 8 + w;
        u32x4 av[4], bv[4], rv4[4];
#pragma unroll
        for (int h = 0; h < 4; ++h) { const int col = h * 512 + lane * 8;
            av[h] = *(const u32x4*)(OF + (size_t)row * D + col); bv[h] = *(const u32x4*)(OB + (size_t)row * D + col); rv4[h] = *(const u32x4*)(PROJ + (size_t)row * LDP + OFF_R + col); }
        const f32x4 g0 = *(const f32x4*)(p.gla_norm_g + lane * 8), g1 = *(const f32x4*)(p.gla_norm_g + lane * 8 + 4);
#pragma unroll
        for (int h = 0; h < 4; ++h) {
            const int col = h * 512 + lane * 8;
            const u32x4 a = av[h], bq = bv[h], rr = rv4[h];
            float o[8];
            o[0] = bflo(a.x) + bflo(bq.x); o[1] = bfhi(a.x) + bfhi(bq.x); o[2] = bflo(a.y) + bflo(bq.y); o[3] = bfhi(a.y) + bfhi(bq.y);
            o[4] = bflo(a.z) + bflo(bq.z); o[5] = bfhi(a.z) + bfhi(bq.z); o[6] = bflo(a.w) + bflo(bq.w); o[7] = bfhi(a.w) + bfhi(bq.w);
            float ss = 0.f;
#pragma unroll
            for (int i = 0; i < 8; ++i) ss += o[i] * o[i];
            ss = wave_sum(ss); const float rstd = rsqrtf(ss * (1.0f / 512.0f) + EPS);
            const float rv[8] = {bflo(rr.x), bfhi(rr.x), bflo(rr.y), bfhi(rr.y), bflo(rr.z), bfhi(rr.z), bflo(rr.w), bfhi(rr.w)};
            float v[8];
#pragma unroll
            for (int i = 0; i < 8; ++i) v[i] = o[i] * rstd * (i < 4 ? g0[i] : g1[i - 4]) * siluf_(rv[i]);
            u32x4 ov; ov.x = cvt_pk_bf16(v[0], v[1]); ov.y = cvt_pk_bf16(v[2], v[3]); ov.z = cvt_pk_bf16(v[4], v[5]); ov.w = cvt_pk_bf16(v[6], v[7]);
            *(u32x4*)(AG + (size_t)row * D + col) = ov;
        }
    }
}

constexpr int N_PHASES = 15;
__global__ void __launch_bounds__(NTHR, 2) mk_fwd(Params p) {
    extern __shared__ __attribute__((aligned(16))) uchar lds_raw[];
    LAS uchar* lds = (LAS uchar*)lds_raw;
    const int G = gridDim.x, bx = blockIdx.x;
    uchar* ws = p.ws;
#define IN(k) (p.ph_lo <= (k) && (k) < p.ph_hi)
    LAS unsigned* xbst = (LAS unsigned*)(lds + LDS_BYTES - 16);
    if (threadIdx.x == 0) { xbst[0] = 0u; xbst[1] = 0u; xbst[2] = 0u; xbst[3] = 0u; }
    __syncthreads();
    const XcdBarrier xbar = xcd_barrier_post((unsigned*)(ws + WS_BAR), (volatile LAS unsigned*)xbst);
    if (p.ph_lo < 0) cg::this_grid().sync();
#define SEAM(k) do { if (IN(k) && IN((k) + 1)) { xcd_barrier(xbar); for (int xs_ = 0; xs_ < MK_EXTRA_SYNC; ++xs_) xcd_barrier(xbar); } } while (0)
#define REPS(k) for (int rep_ = 0; rep_ < 1 + ((MK_REP_MASK >> (k)) & 1); ++rep_)
    bf16_t* A = (bf16_t*)(ws + WS_A); bf16_t* H = (bf16_t*)(ws + WS_H); bf16_t* Y = (bf16_t*)(ws + WS_Y); bf16_t* YC = (bf16_t*)(ws + WS_YC);
    bf16_t* PROJ = (bf16_t*)(ws + WS_PROJ);

    if (IN(0)) REPS(0) { phase_prologue(lds, p); } SEAM(0);
    if (IN(1)) REPS(1) { phase_prenorm1(p); } SEAM(1);
    if (IN(2)) REPS(2) {
        { pg8::Gemm g{A, (const bf16_t*)(ws + WS_WGU1), NLAT, 2 * DFF, D, D, D}; pg8::StaticOrder S; S.init(NLAT, 2 * DFF, G, bx); pg8::EpiSiluMul E{H, DFF}; pg8::gemm_phase(lds, g, S, E); }
        { pg8::Gemm g{A + (size_t)NLAT * D, (const bf16_t*)(ws + WS_WGU1), NCTX, 2 * DFF, D, D, D}; pg8::StaticOrder S; S.init(NCTX, 2 * DFF, G, G - 1 - bx); pg8::EpiSiluMul E{H + (size_t)NLAT * DFF, DFF}; pg8::gemm_phase(lds, g, S, E); }
    } SEAM(2);
    if (IN(3)) REPS(3) {
        { pg8::Gemm g{H, (const bf16_t*)(ws + WS_WD1), NLAT, D, DFF, DFF, DFF}; pg8::StaticOrder S; S.init(NLAT, D, G, bx); pg8::EpiBf16 E{Y, D}; pg8::gemm_phase(lds, g, S, E); }
        for (int sp = 0; sp < 4; ++sp) { pg8::Gemm g{H + (size_t)NLAT * DFF + sp * 1408, (const bf16_t*)(ws + WS_WD1) + sp * 1408, NCTX, D, 1408, DFF, DFF}; pg8::StaticOrder S; S.init(NCTX, D, G, (bx + G - 16 * sp) % G);
            pg8::EpiBf16 E{YC + (size_t)sp * NCTX * D, D}; pg8::gemm_phase(lds, g, S, E); }
    } SEAM(3);
    if (IN(4)) REPS(4) { phase_post<0>(p); } SEAM(4);
    if (IN(5)) REPS(5) {
        { pg8::Gemm g{A, (const bf16_t*)(ws + WS_WIN), NLAT, LDP, D, D, D}; pg8::StaticOrder S; S.init(NLAT, LDP, G, bx); pg8::EpiBf16 E{PROJ, LDP}; pg8::gemm_phase(lds, g, S, E); }
        { pg8::Gemm g{A + (size_t)NLAT * D, (const bf16_t*)(ws + WS_WIN), NCTX, NCTXCOLS, D, D, D}; pg8::StaticOrder S; S.init(NCTX, NCTXCOLS, G, G - 1 - bx); pg8::EpiBf16 E{PROJ + (size_t)NLAT * LDP, LDP}; pg8::gemm_phase(lds, g, S, E); }
    } SEAM(5);
    if (IN(6)) REPS(6) {
        const int n_items = NB * NCH * 4 + NB * NCH;
        for (int it = bx; it < n_items; it += G) { if (it < NB * NCH * 4) gla_prep_item(lds, p, it); else na_vt_item(p, it - NB * NCH * 4); }
    } SEAM(6);
    if (IN(7)) REPS(7) {
        for (int t = bx; t < 128; t += G) gla_scan_task(lds, p, t);
        __syncthreads();
        {
            unsigned* qhead = (unsigned*)(ws + WS_CTR);
            if (threadIdx.x == 0) *(LAS unsigned*)(lds + NA_QW) = atomicAdd(qhead, 1u);
            __syncthreads();
            unsigned it = *(LAS unsigned*)(lds + NA_QW);
            __syncthreads();
            while (it < (unsigned)(NB * 16 * 64)) {
                unsigned nxt = 0u;
                if (threadIdx.x == 0) nxt = atomicAdd(qhead, 1u);
                na_item(lds, p, (int)it);
                if (threadIdx.x == 0) *(LAS unsigned*)(lds + NA_QW) = nxt;
                __syncthreads();
                it = *(LAS unsigned*)(lds + NA_QW);
                __syncthreads();
            }
        }
    } SEAM(7);
    if (IN(8)) REPS(8) {
        phase_readout(p);
        { pg8::Gemm g{(const bf16_t*)(ws + WS_NAO), (const bf16_t*)(ws + WS_WNAO), NLAT, D, 1024, 1024, 1024}; pg8::StaticOrder S; S.init(NLAT, D, G, bx); pg8::EpiGate2 E{(bf16_t*)(ws + WS_G2), PROJ + OFF_M2}; pg8::gemm_phase(lds, g, S, E); }
    } SEAM(8);
    if (IN(9)) REPS(9) { pg8::Gemm g{(const bf16_t*)(ws + WS_AG), (const bf16_t*)(ws + WS_WGLAO), NLAT, D, D, D, D}; pg8::StaticOrder S; S.init(NLAT, D, G, bx); pg8::EpiMerge E{(bf16_t*)(ws + WS_MG), PROJ + OFF_M1, (const bf16_t*)(ws + WS_G2)}; pg8::gemm_phase(lds, g, S, E); } SEAM(9);
    if (IN(10)) REPS(10) { pg8::Gemm g{(const bf16_t*)(ws + WS_MG), (const bf16_t*)(ws + WS_WOUT), NLAT, D, D, D, D}; pg8::StaticOrder S; S.init(NLAT, D, G, bx); pg8::EpiBf16 E{Y, D}; pg8::gemm_phase(lds, g, S, E); } SEAM(10);
    if (IN(11)) REPS(11) { phase_post<1>(p); } SEAM(11);
    if (IN(12)) REPS(12) { pg8::Gemm g{A, (const bf16_t*)(ws + WS_WGU2), NLAT, 2 * DFF, D, D, D}; pg8::StaticOrder S; S.init(NLAT, 2 * DFF, G, bx); pg8::EpiSiluMul E{H, DFF}; pg8::gemm_phase(lds, g, S, E); } SEAM(12);
    if (IN(13)) REPS(13) { pg8::Gemm g{H, (const bf16_t*)(ws + WS_WD2), NLAT, D, DFF, DFF, DFF}; pg8::StaticOrder S; S.init(NLAT, D, G, bx); pg8::EpiBf16 E{Y, D}; pg8::gemm_phase(lds, g, S, E); } SEAM(13);
    if (IN(14)) REPS(14) { phase_post<2>(p); }
#undef IN
#undef SEAM
}


#ifndef MK_RUN
#define MK_RUN N_PHASES
#endif
#ifndef MK_COOP
#define MK_COOP 1
#endif
extern "C" void kernel_launch(void* const* d_in, const int* in_sizes, int n_in, void* d_out, int out_size, void* d_ws, size_t ws_size, hipStream_t stream) {
    static int grid = 0;
    if (grid == 0) {
        if (n_in != 18 || ws_size < WS_END) { fprintf(stderr, "kernel_launch: need 18 inputs and %zu bytes of workspace (got %d, %zu)\n", (size_t)WS_END, n_in, ws_size); grid = -1; return; }
        int dev = 0, cus = 0, per_cu = 0;
        hipGetDevice(&dev); hipDeviceGetAttribute(&cus, hipDeviceAttributeMultiprocessorCount, dev);
        if (hipFuncSetAttribute((const void*)mk_fwd, hipFuncAttributeMaxDynamicSharedMemorySize, LDS_BYTES) != hipSuccess) { fprintf(stderr, "kernel_launch: hipFuncSetAttribute failed\n"); grid = -1; return; }
        if (hipOccupancyMaxActiveBlocksPerMultiprocessor(&per_cu, (const void*)mk_fwd, NTHR, LDS_BYTES) != hipSuccess || per_cu < 1) { fprintf(stderr, "kernel_launch: occupancy query gave %d\n", per_cu); per_cu = 1; }
        (void)hipGetLastError();
        grid = cus * 1;
    }
    if (grid < 0) return;
    if (hipMemsetAsync((char*)d_ws + WS_CTR, 0, 16384, stream) != hipSuccess) { fprintf(stderr, "kernel_launch: memset failed\n"); return; }
    Params p{};
    const float** f = (const float**)&p;
    for (int i = 0; i < 18; ++i) f[i] = (const float*)d_in[i];
    p.out = (float*)d_out; p.ws = (uchar*)d_ws;
#if MK_COOP
    p.ph_lo = 0; p.ph_hi = MK_RUN;
    void* args[] = {&p};
    hipError_t e = hipLaunchCooperativeKernel((const void*)mk_fwd, dim3(grid), dim3(NTHR), args, LDS_BYTES, stream);
    if (e != hipSuccess) fprintf(stderr, "cooperative launch failed: %s (grid %d)\n", hipGetErrorString(e), grid);
#else
    for (int ph = 0; ph < MK_RUN; ++ph) { p.ph_lo = ph; p.ph_hi = ph + 1; hipLaunchKernelGGL(mk_fwd, dim3(grid), dim3(NTHR), LDS_BYTES, stream, p); }
#endif
}
```

```cpp
#include <hip/hip_runtime.h>
#ifndef MK_REP_MASK
#define MK_REP_MASK 0
#endif
#ifndef MK_EXTRA_SYNC
#define MK_EXTRA_SYNC 0
#endif
#include <hip/hip_cooperative_groups.h>
#include <cstdio>
namespace cg = cooperative_groups;

#define LAS __attribute__((address_space(3)))
typedef unsigned short bf16_t;
typedef unsigned char uchar;
typedef short bf16x8 __attribute__((ext_vector_type(8)));
typedef float f32x4 __attribute__((ext_vector_type(4)));
typedef float f32x16 __attribute__((ext_vector_type(16)));
typedef unsigned u32x4 __attribute__((ext_vector_type(4)));
typedef unsigned u32x2 __attribute__((ext_vector_type(2)));

constexpr int D = 2048, NB = 2, SEQ = 4096, CTXL = 256, DFF = 5632, NMODC = 9 * D;
constexpr int NLAT = NB * SEQ, NCTX = NB * CTXL, NTOK = NLAT + NCTX;
constexpr int INW = 13344;
constexpr int LDP = 13568;
constexpr int OFF_K = 0, OFF_V = 1024, OFF_NK = 3072, OFF_NV = 4096, OFF_GF = 5120, OFF_GB = 5136, OFF_Q = 5376, OFF_R = 6400, OFF_NQ = 8448, OFF_M1 = 9472, OFF_M2 = 11520;
constexpr int NCTXCOLS = 5376;
constexpr int NCH = 68;
constexpr float EPS = 1e-6f, LOG2E = 1.4426950408889634f;
constexpr int LDS_BYTES = 147456;
constexpr int NTHR = 512;

constexpr size_t SZ_WGU = (size_t)2 * DFF * D * 2, SZ_WD = (size_t)D * DFF * 2;
constexpr size_t WS_WGU2 = 0, WS_WD2 = WS_WGU2 + SZ_WGU, WS_WGLAO = WS_WD2 + SZ_WD, WS_WNAO = WS_WGLAO + (size_t)D * D * 2, WS_WOUT = WS_WNAO + (size_t)D * 1024 * 2,
                 WS_MODP = WS_WOUT + (size_t)D * D * 2, WS_CTR = WS_MODP + (size_t)2 * 3 * NMODC * 4, WS_BAR = WS_CTR + 256, WS_R1 = WS_BAR + 16384 - 256;
constexpr size_t WS_WGU1 = WS_R1, WS_WD1 = WS_WGU1 + SZ_WGU, WS_R2 = WS_WD1 + SZ_WD;
constexpr size_t WS_OF = WS_R1, WS_OB = WS_R1 + (size_t)NLAT * D * 2;
constexpr size_t WS_WIN = WS_R2, WS_R4 = WS_WIN + (size_t)LDP * D * 2;
constexpr size_t SZ_QD = (size_t)NB * 4 * 2 * NCH * 64 * 256 * 2;
constexpr size_t WS_QD = WS_R2, WS_NVTL = WS_QD + SZ_QD, WS_NVTC = WS_NVTL + (size_t)NB * 16 * 64 * 64 * 64 * 2, WS_AG = WS_R2;
constexpr size_t WS_PROJ = WS_R4, WS_R5 = WS_PROJ + (size_t)NTOK * LDP * 2;
constexpr size_t WS_Y = WS_R4, WS_YC = WS_Y + (size_t)NLAT * D * 4;
constexpr size_t WS_H = WS_R5, WS_R8 = WS_H + (size_t)NTOK * DFF * 2;
constexpr size_t WS_KET = WS_R5, WS_VT = WS_KET + SZ_QD, WS_PM = WS_VT + (size_t)NB * 4 * NCH * 512 * 64 * 2, WS_DEC = WS_PM + (size_t)NB * 4 * 2 * NCH * 4096 * 2, WS_G2 = WS_R5;
constexpr size_t WS_A = WS_R8, WS_NAO = WS_R8, WS_MG = WS_R8, WS_END = WS_A + (size_t)NTOK * D * 2;
static_assert(WS_DEC + (size_t)NB * 4 * 2 * NCH * 256 * 4 <= WS_R8, "R5 overlay");
static_assert(WS_NVTC + (size_t)NB * 16 * 64 * 256 * 2 <= WS_R4, "R2 overlay");
static_assert(WS_OB + (size_t)NLAT * D * 2 <= WS_R2, "R1 overlay");

struct Params {
    const float *x, *c, *ctx, *c_ctx, *w_ada, *b_ada, *norm_g, *ffn_wg, *ffn_wu, *ffn_wd, *w_in, *gla_wg, *gla_bg, *gla_norm_g, *w_gla_o, *na_rpb, *w_na_o, *w_out;
    float* out; uchar* ws; int ph_lo, ph_hi;
};

typedef float f32x2_t __attribute__((ext_vector_type(2)));
typedef __bf16 bf16x2_t __attribute__((ext_vector_type(2)));
__device__ __forceinline__ unsigned cvt_pk_bf16(float lo, float hi) { const f32x2_t v = {lo, hi}; union { bf16x2_t b; unsigned u; } x; x.b = __builtin_convertvector(v, bf16x2_t); return x.u; }
__device__ __forceinline__ float bf2f(bf16_t b) { return __uint_as_float(((unsigned)b) << 16); }
__device__ __forceinline__ float bflo(unsigned u) { return __uint_as_float(u << 16); }
__device__ __forceinline__ float bfhi(unsigned u) { return __uint_as_float(u & 0xffff0000u); }
__device__ __forceinline__ float fast_rcp(float x) { return __builtin_amdgcn_rcpf(x); }
__device__ __forceinline__ float sigmoidf_(float x) { return fast_rcp(1.0f + __builtin_amdgcn_exp2f(x * -LOG2E)); }
__device__ __forceinline__ float siluf_(float x) { return x * sigmoidf_(x); }
__device__ __forceinline__ float wave_sum(float v) {
#pragma unroll
    for (int o = 32; o >= 1; o >>= 1) v += __shfl_xor(v, o);
    return v;
}
__device__ __forceinline__ bf16x8 as_bf16x8(u32x4 v) { union { u32x4 u; bf16x8 b; } x; x.u = v; return x.b; }


#define XB_TMO      128
#define XB_XCNT(j)  (256  + 64 * (j))
#define XB_XSUB(j)  (1280 + 64 * (j))
#define XB_XGEN(j)  (2304 + 64 * (j))
#define XB_TOP      3328
#define XB_TOPGEN   3392
#define XCD_BAR_WORDS 3456
#define XB_SPIN_CAP (1u << 20)
__device__ __forceinline__ unsigned xb_ld(unsigned* p)              { return __hip_atomic_load(p, __ATOMIC_RELAXED, __HIP_MEMORY_SCOPE_AGENT); }
__device__ __forceinline__ unsigned xb_add(unsigned* p, unsigned v) { return __hip_atomic_fetch_add(p, v, __ATOMIC_RELAXED, __HIP_MEMORY_SCOPE_AGENT); }
__device__ __forceinline__ unsigned xb_xcc_id() { return (unsigned)__builtin_amdgcn_s_getreg((3 << 11) | 20) & 0xFu; }
#define XB_SPIN(cond, bar) do { unsigned _sp = 0; while (cond) { __builtin_amdgcn_s_sleep(1); \
    if ((++_sp & 255u) == 0u) { if (xb_ld(&(bar)[XB_TMO])) break; if (_sp > XB_SPIN_CAP) { atomicAdd(&(bar)[XB_TMO], 1u); break; } } } } while (0)
struct XcdBarrier { unsigned* bar; unsigned x; volatile LAS unsigned* st; };
__device__ __forceinline__ XcdBarrier xcd_barrier_post(unsigned* bar, volatile LAS unsigned* st) {
    XcdBarrier b; b.bar = bar; b.x = xb_xcc_id(); b.st = st;
    if (threadIdx.x == 0) (void)xb_add(&bar[XB_XCNT(b.x)], 1u);
    return b;
}
__device__ __forceinline__ void xcd_barrier_complete(unsigned* bar, unsigned x, unsigned& nloc, unsigned& nx) {
    const unsigned G = gridDim.x * gridDim.y * gridDim.z;
    unsigned sum, cnt, mine, sp = 0u;
    for (;;) {
        sum = 0u; cnt = 0u; mine = 0u;
#pragma unroll
        for (unsigned j = 0; j < 16; ++j) { const unsigned c = xb_ld(&bar[XB_XCNT(j)]); sum += c; cnt += (c > 0u) ? 1u : 0u; mine = (j == x) ? c : mine; }
        if (sum == G) break;
        __builtin_amdgcn_s_sleep(1);
        if ((++sp & 255u) == 0u) { if (xb_ld(&bar[XB_TMO])) break; if (sp > XB_SPIN_CAP) { atomicAdd(&bar[XB_TMO], 1u); break; } }
    }
    nloc = mine > 0u ? mine : 1u; nx = cnt > 0u ? cnt : 1u;
}
__device__ __forceinline__ void xcd_barrier(const XcdBarrier& b) {
    asm volatile("s_waitcnt vmcnt(0)" ::: "memory");
    __syncthreads();
    if (threadIdx.x == 0) {
        unsigned* bar = b.bar;
        __builtin_amdgcn_s_waitcnt(0);
        unsigned nloc = b.st[0], nx = b.st[1];
        if (nloc == 0u) { xcd_barrier_complete(bar, b.x, nloc, nx); b.st[0] = nloc; b.st[1] = nx; }
        const unsigned old = xb_add(&bar[XB_XSUB(b.x)], 1u);
        const unsigned gen = old / nloc;
        if (old + 1u == (gen + 1u) * nloc) {
            __builtin_amdgcn_fence(__ATOMIC_RELEASE, "agent");
            asm volatile("s_waitcnt vmcnt(0)" ::: "memory");
            const unsigned og = xb_add(&bar[XB_TOP], 1u);
            const unsigned tg = og / nx;
            if (og + 1u == (tg + 1u) * nx) xb_add(&bar[XB_TOPGEN], 1u);
            else XB_SPIN(xb_ld(&bar[XB_TOPGEN]) == tg, bar);
            __builtin_amdgcn_fence(__ATOMIC_ACQUIRE, "agent");
            xb_add(&bar[XB_XGEN(b.x)], 1u);
            asm volatile("s_waitcnt vmcnt(0)" ::: "memory");
        } else {
            XB_SPIN(xb_ld(&bar[XB_XGEN(b.x)]) == gen, bar);
            __builtin_amdgcn_fence(__ATOMIC_ACQUIRE, "agent");
            asm volatile("s_waitcnt vmcnt(0)" ::: "memory");
        }
    }
    __syncthreads();
}

namespace pg8 {
constexpr int BM = 256, BK = 64, HALF = 128, HTB = HALF * BK * 2, NXCD = 8, WGM = 8;
__device__ __forceinline__ int lds_byte(int r, int c) { const int st = (r >> 4) * 2 + (c >> 5), rr = r & 15, cc = c & 31, ob = rr * 64 + cc * 2; return st * 1024 + (ob ^ (((ob >> 9) & 1) << 5)); }
__device__ __forceinline__ void stage_rc(int b, int& R, int& C) { const int st = b / 1024, sb = b % 1024, swz = sb ^ (((sb >> 9) & 1) << 5); R = (st >> 1) * 16 + swz / 64; C = (st & 1) * 32 + (swz % 64) / 2; }
__device__ __forceinline__ int perm32(int rho) { const int n = rho >> 4, i = rho & 15; return 8 * (i >> 2) + 4 * n + (i & 3); }
struct Unit { int pm, pn; };
struct Gemm { const bf16_t* A; const bf16_t* Bt; int M, N, K, lda, ldb; };
struct StaticOrder {
    int nM, nN, nwg, G, c;
    __device__ void init(int M, int N, int G_, int c_) { nM = M / BM; nN = N / BM; nwg = nM * nN; G = G_; c = c_; }
    __device__ bool next(int i, Unit& u) const {
        const long L = (long)i * G + c; if (L >= nwg) return false;
        int wgid = (int)L; { const int q = nwg / NXCD, r = nwg % NXCD, xcd = wgid % NXCD, off = wgid / NXCD; wgid = (xcd < r ? xcd * (q + 1) : r * (q + 1) + (xcd - r) * q) + off; }
        const int nig = WGM * nN, gid = wgid / nig, fm = gid * WGM, gsz = (nM - fm) < WGM ? (nM - fm) : WGM;
        u.pm = fm + ((wgid % nig) % gsz); u.pn = (wgid % nig) / gsz; return true;
    }
};
struct EpiF32 {
    static constexpr bool PERM = false;
    float* C; int ldc;
    __device__ __forceinline__ void operator()(const f32x4 (&acc)[2][2][4][2], const Unit& u, int wr, int wc, int fr, int fq) const {
        const int row0 = u.pm * BM + wr * 64 + fr, col0 = u.pn * BM + wc * 32 + 4 * fq;
#pragma unroll
        for (int ai = 0; ai < 2; ++ai)
#pragma unroll
            for (int m = 0; m < 4; ++m) { float* rowp = C + (size_t)(row0 + ai * HALF + m * 16) * ldc + col0;
#pragma unroll
                for (int bj = 0; bj < 2; ++bj)
#pragma unroll
                    for (int n = 0; n < 2; ++n) *(f32x4*)(rowp + bj * HALF + n * 16) = acc[ai][bj][m][n]; }
    }
};
struct EpiBf16 {
    static constexpr bool PERM = true;
    bf16_t* O; int ldc;
    __device__ __forceinline__ void operator()(const f32x4 (&acc)[2][2][4][2], const Unit& u, int wr, int wc, int fr, int fq) const {
        const int row0 = u.pm * BM + wr * 64 + fr, col0 = u.pn * BM + wc * 32 + 8 * fq;
#pragma unroll
        for (int ai = 0; ai < 2; ++ai)
#pragma unroll
            for (int m = 0; m < 4; ++m) { bf16_t* rowp = O + (size_t)(row0 + ai * HALF + m * 16) * ldc + col0;
#pragma unroll
                for (int bj = 0; bj < 2; ++bj) { const f32x4 v0 = acc[ai][bj][m][0], v1 = acc[ai][bj][m][1];
                    u32x4 w; w.x = cvt_pk_bf16(v0[0], v0[1]); w.y = cvt_pk_bf16(v0[2], v0[3]); w.z = cvt_pk_bf16(v1[0], v1[1]); w.w = cvt_pk_bf16(v1[2], v1[3]);
                    *(u32x4*)(rowp + bj * HALF) = w; } }
    }
};
struct EpiSiluMul {
    static constexpr bool PERM = true;
    bf16_t* O; int ldc;
    __device__ __forceinline__ void operator()(const f32x4 (&acc)[2][2][4][2], const Unit& u, int wr, int wc, int fr, int fq) const {
        const int row0 = u.pm * BM + wr * 64 + fr, col0 = u.pn * HALF + wc * 32 + 8 * fq;
#pragma unroll
        for (int ai = 0; ai < 2; ++ai)
#pragma unroll
            for (int m = 0; m < 4; ++m) { bf16_t* rowp = O + (size_t)(row0 + ai * HALF + m * 16) * ldc + col0;
                float h[8];
#pragma unroll
                for (int n = 0; n < 2; ++n)
#pragma unroll
                    for (int j = 0; j < 4; ++j) h[n * 4 + j] = siluf_(acc[ai][0][m][n][j]) * acc[ai][1][m][n][j];
                u32x4 w; w.x = cvt_pk_bf16(h[0], h[1]); w.y = cvt_pk_bf16(h[2], h[3]); w.z = cvt_pk_bf16(h[4], h[5]); w.w = cvt_pk_bf16(h[6], h[7]);
                *(u32x4*)rowp = w; }
    }
};
struct EpiGate2 {
    static constexpr bool PERM = false;
    bf16_t* C; const bf16_t* gate;
    __device__ __forceinline__ void operator()(const f32x4 (&acc)[2][2][4][2], const Unit& u, int wr, int wc, int fr, int fq) const {
        const int row0 = u.pm * BM + wr * 64 + fr, col0 = u.pn * BM + wc * 32 + 4 * fq;
#pragma unroll
        for (int ai = 0; ai < 2; ++ai)
#pragma unroll
            for (int m = 0; m < 4; ++m) { const size_t row = (size_t)(row0 + ai * HALF + m * 16);
#pragma unroll
                for (int bj = 0; bj < 2; ++bj)
#pragma unroll
                    for (int n = 0; n < 2; ++n) { const int col = col0 + bj * HALF + n * 16;
                        const u32x2 gm = *(const u32x2*)(gate + row * LDP + col); const f32x4 a = acc[ai][bj][m][n];
                        f32x4 o; o[0] = sigmoidf_(bflo(gm.x)) * a[0]; o[1] = sigmoidf_(bfhi(gm.x)) * a[1]; o[2] = sigmoidf_(bflo(gm.y)) * a[2]; o[3] = sigmoidf_(bfhi(gm.y)) * a[3];
                        u32x2 ow; ow.x = cvt_pk_bf16(o[0], o[1]); ow.y = cvt_pk_bf16(o[2], o[3]); *(u32x2*)(C + row * D + col) = ow; } }
    }
};
struct EpiMerge {
    static constexpr bool PERM = true;
    bf16_t* O; const bf16_t* gate; const bf16_t* G2;
    __device__ __forceinline__ void operator()(const f32x4 (&acc)[2][2][4][2], const Unit& u, int wr, int wc, int fr, int fq) const {
        const int row0 = u.pm * BM + wr * 64 + fr, col0 = u.pn * BM + wc * 32 + 8 * fq;
#pragma unroll
        for (int ai = 0; ai < 2; ++ai)
#pragma unroll
            for (int m = 0; m < 4; ++m) { const size_t row = (size_t)(row0 + ai * HALF + m * 16);
#pragma unroll
                for (int bj = 0; bj < 2; ++bj) { const int col = col0 + bj * HALF;
                    const u32x4 gm = *(const u32x4*)(gate + row * LDP + col);
                    const u32x4 gq = *(const u32x4*)(G2 + row * D + col); const f32x4 ga = (f32x4){bflo(gq.x), bfhi(gq.x), bflo(gq.y), bfhi(gq.y)}, gb = (f32x4){bflo(gq.z), bfhi(gq.z), bflo(gq.w), bfhi(gq.w)};
                    const f32x4 v0 = acc[ai][bj][m][0], v1 = acc[ai][bj][m][1];
                    float o[8];
                    o[0] = sigmoidf_(bflo(gm.x)) * v0[0] + ga[0]; o[1] = sigmoidf_(bfhi(gm.x)) * v0[1] + ga[1]; o[2] = sigmoidf_(bflo(gm.y)) * v0[2] + ga[2]; o[3] = sigmoidf_(bfhi(gm.y)) * v0[3] + ga[3];
                    o[4] = sigmoidf_(bflo(gm.z)) * v1[0] + gb[0]; o[5] = sigmoidf_(bfhi(gm.z)) * v1[1] + gb[1]; o[6] = sigmoidf_(bflo(gm.w)) * v1[2] + gb[2]; o[7] = sigmoidf_(bfhi(gm.w)) * v1[3] + gb[3];
                    u32x4 w; w.x = cvt_pk_bf16(o[0], o[1]); w.y = cvt_pk_bf16(o[2], o[3]); w.z = cvt_pk_bf16(o[4], o[5]); w.w = cvt_pk_bf16(o[6], o[7]);
                    *(u32x4*)(O + row * D + col) = w; } }
    }
};

template <class Epi, bool ALIGN_EPI = true>
__device__ __forceinline__ void gemm_phase(LAS uchar* lds, const Gemm g, const StaticOrder& S, const Epi& E) {
    const int tid = threadIdx.x, wid = __builtin_amdgcn_readfirstlane(tid >> 6), lane = tid & 63, wr = wid >> 2, wc = wid & 3, fr = lane & 15, fq = lane >> 4;
    const int K = g.K, nt = K / BK;
    unsigned voffA[2], voffB[2];
#pragma unroll
    for (int i = 0; i < 2; ++i) { int R, C; stage_rc(tid * 16 + i * 8192, R, C); const int Rb = Epi::PERM ? ((R & ~31) + perm32(R & 31)) : R;
        voffA[i] = (unsigned)(R * g.lda + C) * 2u; voffB[i] = (unsigned)(Rb * g.ldb + C) * 2u; }
    const size_t kstep = (size_t)(BK * 2);
    const size_t hstepA = (size_t)HALF * g.lda * 2, hstepB = (size_t)HALF * g.ldb * 2;
    const size_t tstepA = 2 * hstepA, tstepB = 2 * hstepB;
    const unsigned ldsw = (unsigned)wid * 1024u;
    const int aoff = lds_byte(wr * 64 + fr, fq * 8), boff = lds_byte(wc * 32 + fr, fq * 8);
#define PG8_SA(b, h) (((b) * 2 + (h)) * HTB)
#define PG8_SB(b, h) ((4 + (b) * 2 + (h)) * HTB)
#define PG8_STAGE(bufoff, gbase, voff) do { _Pragma("unroll") for (int _i = 0; _i < 2; ++_i) \
        __builtin_amdgcn_global_load_lds((const unsigned*)((const char*)(gbase) + (voff)[_i]), (LAS unsigned*)(lds + (bufoff) + ldsw + _i * 8192), 16, 0, 0); } while (0)
#define PG8_LDA(dst, b, h) do { _Pragma("unroll") for (int m = 0; m < 4; ++m) _Pragma("unroll") for (int k = 0; k < 2; ++k) dst[m][k] = *(const LAS bf16x8*)(lds + PG8_SA(b, h) + aoff + m * 2048 + k * 1024); } while (0)
#define PG8_LDB(dst, b, h) do { _Pragma("unroll") for (int n = 0; n < 2; ++n) _Pragma("unroll") for (int k = 0; k < 2; ++k) dst[n][k] = *(const LAS bf16x8*)(lds + PG8_SB(b, h) + boff + n * 2048 + k * 1024); } while (0)
#define PG8_MMA(ai, bj, At, Bt) do { __builtin_amdgcn_s_setprio(1); _Pragma("unroll") for (int m = 0; m < 4; ++m) _Pragma("unroll") for (int n = 0; n < 2; ++n) _Pragma("unroll") for (int k = 0; k < 2; ++k) \
        acc[ai][bj][m][n] = __builtin_amdgcn_mfma_f32_16x16x32_bf16(Bt[n][k], At[m][k], acc[ai][bj][m][n], 0, 0, 0); __builtin_amdgcn_s_setprio(0); } while (0)
#define PG8_WAIT_V(n) asm volatile("s_waitcnt vmcnt(" #n ")" ::: "memory")
#define PG8_WAIT_L(n) asm volatile("s_waitcnt lgkmcnt(" #n ")" ::: "memory")
#define PG8_BAR __builtin_amdgcn_s_barrier()
#define PG8_SCHED __builtin_amdgcn_sched_barrier(0)
    Unit cur, nxt; int ui = 0;
    if (!S.next(0, cur)) return;
    f32x4 acc[2][2][4][2];
#pragma unroll
    for (int a = 0; a < 2; ++a)
#pragma unroll
        for (int b = 0; b < 2; ++b)
#pragma unroll
            for (int m = 0; m < 4; ++m)
#pragma unroll
                for (int n = 0; n < 2; ++n) acc[a][b][m][n] = (f32x4){0.f, 0.f, 0.f, 0.f};
    bf16x8 At[4][2], B0[2][2], B1[2][2];
    const char* cA = (const char*)g.A + (size_t)cur.pm * tstepA; const char* cB = (const char*)g.Bt + (size_t)cur.pn * tstepB;
    PG8_STAGE(PG8_SB(0, 0), cB, voffB); PG8_STAGE(PG8_SB(0, 1), cB + hstepB, voffB); PG8_STAGE(PG8_SA(0, 0), cA, voffA); PG8_STAGE(PG8_SA(0, 1), cA + hstepA, voffA);
    if (wr == 1) PG8_BAR;
    PG8_WAIT_V(2); PG8_BAR;
    PG8_STAGE(PG8_SB(1, 0), cB + kstep, voffB); PG8_STAGE(PG8_SA(1, 0), cA + kstep, voffA); PG8_STAGE(PG8_SB(1, 1), cB + hstepB + kstep, voffB);
    PG8_WAIT_V(6); PG8_BAR;
    for (;;) {
        const bool has_next = S.next(ui + 1, nxt);
        const char* nA = has_next ? (const char*)g.A + (size_t)nxt.pm * tstepA : cA; const char* nB = has_next ? (const char*)g.Bt + (size_t)nxt.pn * tstepB : cB;
        for (int t = 0; t < nt; t += 2) {
            const bool last = (t == nt - 2);
            const char* a1 = cA + (size_t)(t + 1) * kstep;
            const char* a2 = last ? nA : cA + (size_t)(t + 2) * kstep; const char* b2 = last ? nB : cB + (size_t)(t + 2) * kstep;
            const char* a3 = a2 + kstep; const char* b3 = b2 + kstep;
            PG8_LDB(B0, 0, 0); PG8_LDB(B1, 0, 1); PG8_SCHED; PG8_LDA(At, 0, 0); PG8_STAGE(PG8_SA(1, 1), a1 + hstepA, voffA);
            PG8_WAIT_V(8); PG8_WAIT_L(0); PG8_BAR; PG8_MMA(0, 0, At, B0); PG8_MMA(0, 1, At, B1); PG8_BAR; PG8_SCHED;
            PG8_LDA(At, 0, 1); PG8_STAGE(PG8_SB(0, 0), b2, voffB); PG8_STAGE(PG8_SB(0, 1), b2 + hstepB, voffB); PG8_STAGE(PG8_SA(0, 0), a2, voffA);
            PG8_WAIT_V(8); PG8_WAIT_L(0); PG8_BAR; PG8_MMA(1, 0, At, B0); PG8_MMA(1, 1, At, B1); PG8_BAR; PG8_SCHED;
            PG8_LDB(B0, 1, 0); PG8_LDB(B1, 1, 1); PG8_SCHED; PG8_LDA(At, 1, 0); PG8_STAGE(PG8_SA(0, 1), a2 + hstepA, voffA);
            PG8_WAIT_V(8); PG8_WAIT_L(0); PG8_BAR; PG8_MMA(0, 0, At, B0); PG8_MMA(0, 1, At, B1); PG8_BAR; PG8_SCHED;
            PG8_LDA(At, 1, 1); PG8_STAGE(PG8_SB(1, 0), b3, voffB); PG8_STAGE(PG8_SB(1, 1), b3 + hstepB, voffB); PG8_STAGE(PG8_SA(1, 0), a3, voffA);
            PG8_WAIT_V(8); PG8_WAIT_L(0); PG8_BAR; PG8_MMA(1, 0, At, B0); PG8_MMA(1, 1, At, B1); PG8_BAR; PG8_SCHED;
        }
        if constexpr (ALIGN_EPI) { if (wr == 0) PG8_BAR; }
        E(acc, cur, wr, wc, fr, fq);
        if (!has_next) break;
#pragma unroll
        for (int a = 0; a < 2; ++a)
#pragma unroll
            for (int b = 0; b < 2; ++b)
#pragma unroll
                for (int m = 0; m < 4; ++m)
#pragma unroll
                    for (int n = 0; n < 2; ++n) acc[a][b][m][n] = (f32x4){0.f, 0.f, 0.f, 0.f};
        cur = nxt; cA = nA; cB = nB; ++ui;
        if constexpr (ALIGN_EPI) { if (wr == 1) PG8_BAR; }
    }
    PG8_WAIT_V(0);
    if constexpr (!ALIGN_EPI) { if (wr == 0) PG8_BAR; }
    PG8_BAR;
#undef PG8_SA
#undef PG8_SB
#undef PG8_STAGE
#undef PG8_LDA
#undef PG8_LDB
#undef PG8_MMA
#undef PG8_WAIT_V
#undef PG8_WAIT_L
#undef PG8_BAR
#undef PG8_SCHED
}
}

struct CvtJob { const float* src; int ld, K, col0, ntn, valid; bf16_t* dst; int row0, mul; };
__device__ __forceinline__ int cvt_job(const Params& p, int j, CvtJob& o) {
    uchar* ws = p.ws;
    const size_t FW = (size_t)D * DFF;
    switch (j) {
    case 0: o = {p.ffn_wg, DFF, D, 0, 44, 5632, (bf16_t*)(ws + WS_WGU1), 0, 256}; break;
    case 1: o = {p.ffn_wu, DFF, D, 0, 44, 5632, (bf16_t*)(ws + WS_WGU1), 128, 256}; break;
    case 2: o = {p.ffn_wd, D, DFF, 0, 16, 2048, (bf16_t*)(ws + WS_WD1), 0, 128}; break;
    case 3: o = {p.w_in, INW, D, 1024, 8, 1024, (bf16_t*)(ws + WS_WIN), OFF_K, 128}; break;
    case 4: o = {p.w_in, INW, D, 2048, 16, 2048, (bf16_t*)(ws + WS_WIN), OFF_V, 128}; break;
    case 5: o = {p.w_in, INW, D, 7200, 8, 1024, (bf16_t*)(ws + WS_WIN), OFF_NK, 128}; break;
    case 6: o = {p.w_in, INW, D, 8224, 8, 1024, (bf16_t*)(ws + WS_WIN), OFF_NV, 128}; break;
    case 7: o = {p.w_in, INW, D, 6144, 2, 32, (bf16_t*)(ws + WS_WIN), OFF_GF, 128}; break;
    case 8: o = {p.w_in, INW, D, 0, 8, 1024, (bf16_t*)(ws + WS_WIN), OFF_Q, 128}; break;
    case 9: o = {p.w_in, INW, D, 4096, 16, 2048, (bf16_t*)(ws + WS_WIN), OFF_R, 128}; break;
    case 10: o = {p.w_in, INW, D, 6176, 8, 1024, (bf16_t*)(ws + WS_WIN), OFF_NQ, 128}; break;
    case 11: o = {p.w_in, INW, D, 9248, 16, 2048, (bf16_t*)(ws + WS_WIN), OFF_M1, 128}; break;
    case 12: o = {p.w_in, INW, D, 11296, 16, 2048, (bf16_t*)(ws + WS_WIN), OFF_M2, 128}; break;
    case 13: o = {p.w_gla_o, D, D, 0, 16, 2048, (bf16_t*)(ws + WS_WGLAO), 0, 128}; break;
    case 14: o = {p.w_na_o, D, 1024, 0, 16, 2048, (bf16_t*)(ws + WS_WNAO), 0, 128}; break;
    case 15: o = {p.w_out, D, D, 0, 16, 2048, (bf16_t*)(ws + WS_WOUT), 0, 128}; break;
    case 16: o = {p.ffn_wg + FW, DFF, D, 0, 44, 5632, (bf16_t*)(ws + WS_WGU2), 0, 256}; break;
    case 17: o = {p.ffn_wu + FW, DFF, D, 0, 44, 5632, (bf16_t*)(ws + WS_WGU2), 128, 256}; break;
    default: o = {p.ffn_wd + FW, D, DFF, 0, 16, 2048, (bf16_t*)(ws + WS_WD2), 0, 128}; break;
    }
    return (o.K / 128) * o.ntn;
}
constexpr int N_CVT_JOBS = 19;
constexpr int N_CVT_TILES = 6 * 704 + 16 * 106 + 256 + 128 + 256;

struct CvtRegs { f32x4 a[4], b[4]; bf16_t* dst; int K; };
__device__ __forceinline__ void cvt_load(const CvtJob& J, int tl, CvtRegs& R) {
    const int tid = threadIdx.x;
    const int ktiles = J.K / 128, nt = tl / ktiles, kt = tl % ktiles;
    const int k0 = kt * 128, c0 = nt * 128;
    const int n4 = tid & 31, kp = tid >> 5;
    const int col = c0 + 4 * n4;
    R.dst = J.dst + (size_t)(J.row0 + nt * J.mul) * J.K + k0; R.K = J.K;
#pragma unroll
    for (int it = 0; it < 4; ++it) {
        const int kpair = kp + 16 * it;
        R.a[it] = (f32x4){0.f, 0.f, 0.f, 0.f}; R.b[it] = R.a[it];
        if (col < J.valid) { const float* sp = J.src + (size_t)(k0 + 2 * kpair) * J.ld + J.col0 + col; R.a[it] = __builtin_nontemporal_load((const f32x4*)sp); R.b[it] = __builtin_nontemporal_load((const f32x4*)(sp + J.ld)); }
    }
}
__device__ __forceinline__ void cvt_store(LAS uchar* lds, const CvtRegs& R) {
    LAS unsigned* T = (LAS unsigned*)lds;
    const int tid = threadIdx.x, n4 = tid & 31, kp = tid >> 5;
#pragma unroll
    for (int it = 0; it < 4; ++it) {
        const int kpair = kp + 16 * it;
#pragma unroll
        for (int i = 0; i < 4; ++i) T[(4 * n4 + i) * 65 + kpair] = cvt_pk_bf16(R.a[it][i], R.b[it][i]);
    }
    __syncthreads();
#pragma unroll
    for (int it = 0; it < 4; ++it) {
        const int ch = tid + 512 * it, n = ch >> 4, c16 = ch & 15;
        u32x4 v; v.x = T[n * 65 + 4 * c16]; v.y = T[n * 65 + 4 * c16 + 1]; v.z = T[n * 65 + 4 * c16 + 2]; v.w = T[n * 65 + 4 * c16 + 3];
        *(u32x4*)(R.dst + (size_t)n * R.K + 8 * c16) = v;
    }
    __syncthreads();
}

__device__ __forceinline__ void ada_item(LAS uchar* lds, const Params& p, int item) {
    LAS float* sv = (LAS float*)lds;
    LAS float* red = (LAS float*)(lds + 12288);
    const int tid = threadIdx.x, w = tid >> 6, lane = tid & 63;
    const int cb = item >> 1, kh = item & 1;
    for (int i = tid; i < 3 * 1024; i += NTHR) { const int s = i >> 10, k = kh * 1024 + (i & 1023); const float v = s < 2 ? p.c[s * D + k] : p.c_ctx[k]; sv[i] = siluf_(v); }
    __syncthreads();
    f32x4 a0 = (f32x4){0.f, 0.f, 0.f, 0.f}, a1 = a0, a2 = a0;
    const float* wp = p.w_ada + (size_t)(kh * 1024 + w * 128) * NMODC + cb * 256 + lane * 4;
#pragma unroll 8
    for (int k = 0; k < 128; ++k) {
        const f32x4 wv = *(const f32x4*)(wp + (size_t)k * NMODC);
        const int kk = w * 128 + k;
        a0 += sv[kk] * wv; a1 += sv[1024 + kk] * wv; a2 += sv[2048 + kk] * wv;
    }
    *(LAS f32x4*)(red + (w * 3 + 0) * 256 + lane * 4) = a0; *(LAS f32x4*)(red + (w * 3 + 1) * 256 + lane * 4) = a1; *(LAS f32x4*)(red + (w * 3 + 2) * 256 + lane * 4) = a2;
    __syncthreads();
    float* modp = (float*)(p.ws + WS_MODP);
    for (int i = tid; i < 768; i += NTHR) { const int s = i >> 8, col = i & 255; float v = 0.f;
#pragma unroll
        for (int ww = 0; ww < 8; ++ww) v += red[(ww * 3 + s) * 256 + col];
        const int gc = cb * 256 + col; if (kh == 0) v += p.b_ada[gc];
        modp[(size_t)(kh * 3 + s) * NMODC + gc] = v; }
    __syncthreads();
}

__device__ __forceinline__ void phase_prologue(LAS uchar* lds, const Params& p) {
    const int G = gridDim.x, bx = blockIdx.x;
    int t_lo, t_hi;
    if (G == 256) {
        if (bx < 144) { ada_item(lds, p, bx); t_lo = (bx * 89) / 4; t_hi = ((bx + 1) * 89) / 4; }
        else { t_lo = 3204 + (bx - 144) * 30; t_hi = t_lo + 30; }
        if (t_hi > N_CVT_TILES) t_hi = N_CVT_TILES;
    } else {
        for (int i = bx; i < 144; i += G) ada_item(lds, p, i);
        const int per = (N_CVT_TILES + G - 1) / G; t_lo = bx * per; t_hi = t_lo + per; if (t_hi > N_CVT_TILES) t_hi = N_CVT_TILES;
    }
    int j = 0, base = 0; CvtJob J; int cnt = cvt_job(p, 0, J);
    if (t_lo < t_hi) {
        CvtRegs cur, nxt;
        while (t_lo >= base + cnt) { base += cnt; ++j; cnt = cvt_job(p, j, J); }
        cvt_load(J, t_lo - base, cur);
        for (int t = t_lo; t < t_hi; ++t) {
            if (t + 1 < t_hi) { while (t + 1 >= base + cnt) { base += cnt; ++j; cnt = cvt_job(p, j, J); } cvt_load(J, t + 1 - base, nxt); }
            cvt_store(lds, cur);
            cur = nxt;
        }
    }
}

__device__ __forceinline__ f32x4 ld_mod(const float* modp, int s, int idx, int col) {
    const float* a = modp + (size_t)s * NMODC + idx * D + col; const float* b = a + (size_t)3 * NMODC;
    return *(const f32x4*)a + *(const f32x4*)b;
}
__device__ __forceinline__ void st_bf16x4(bf16_t* dst, f32x4 v) { u32x2 w; w.x = cvt_pk_bf16(v[0], v[1]); w.y = cvt_pk_bf16(v[2], v[3]); *(u32x2*)dst = w; }

__device__ __forceinline__ void phase_prenorm1(const Params& p) {
    const int w = threadIdx.x >> 6, lane = threadIdx.x & 63;
    const float* modp = (const float*)(p.ws + WS_MODP); bf16_t* A = (bf16_t*)(p.ws + WS_A);
    for (int item = blockIdx.x; item < NTOK / 8; item += gridDim.x) {
        const int row = item * 8 + w; const int s = row < NLAT ? row / SEQ : 2;
        const float* src = row < NLAT ? p.x + (size_t)row * D : p.ctx + (size_t)(row - NLAT) * D;
        f32x4 v[8]; float ss = 0.f;
#pragma unroll
        for (int j = 0; j < 8; ++j) { v[j] = *(const f32x4*)(src + j * 256 + lane * 4); ss += v[j][0] * v[j][0] + v[j][1] * v[j][1] + v[j][2] * v[j][2] + v[j][3] * v[j][3]; }
        ss = wave_sum(ss); const float rstd = rsqrtf(ss * (1.0f / D) + EPS);
#pragma unroll
        for (int j = 0; j < 8; ++j) { const int col = j * 256 + lane * 4;
            const f32x4 g = *(const f32x4*)(p.norm_g + 0 * D + col), sh = ld_mod(modp, s, 0, col), sc = ld_mod(modp, s, 1, col);
            st_bf16x4(A + (size_t)row * D + col, (v[j] * rstd * g) * (1.0f + sc) + sh); }
    }
}
template <int MODE>
__device__ __forceinline__ void phase_post(const Params& p) {
    const int w = threadIdx.x >> 6, lane = threadIdx.x & 63;
    const float* modp = (const float*)(p.ws + WS_MODP); bf16_t* A = (bf16_t*)(p.ws + WS_A);
    const bf16_t* Y = (const bf16_t*)(p.ws + WS_Y); const bf16_t* YC = (const bf16_t*)(p.ws + WS_YC);
    constexpr int NROWS = MODE == 0 ? NTOK : NLAT;
    constexpr int GI = MODE == 0 ? 2 : (MODE == 1 ? 5 : 8), GP = MODE == 0 ? 1 : (MODE == 1 ? 3 : 5), GN = MODE == 0 ? 2 : 4, SI = MODE == 0 ? 3 : 6;
    constexpr float WRES = MODE == 1 ? 1.0f : 0.5f;
    for (int item = blockIdx.x; item < NROWS / 8; item += gridDim.x) {
        const int row = item * 8 + w; const int s = row < NLAT ? row / SEQ : 2;
        const float* xin = MODE == 0 ? (row < NLAT ? p.x + (size_t)row * D : p.ctx + (size_t)(row - NLAT) * D) : p.out + (size_t)row * D;
        f32x4 y[8], xv8[8]; float ss = 0.f;
#pragma unroll
        for (int j = 0; j < 8; ++j) xv8[j] = *(const f32x4*)(xin + j * 256 + lane * 4);
#pragma unroll
        for (int j = 0; j < 8; ++j) { const int col = j * 256 + lane * 4;
            if (MODE == 0 && row >= NLAT) { const bf16_t* yc = YC + (size_t)(row - NLAT) * D + col; f32x4 a = (f32x4){0.f, 0.f, 0.f, 0.f};
#pragma unroll
                for (int sp = 0; sp < 4; ++sp) { const u32x2 t = *(const u32x2*)(yc + (size_t)sp * NCTX * D); a += (f32x4){bflo(t.x), bfhi(t.x), bflo(t.y), bfhi(t.y)}; }
                y[j] = a; }
            else { const u32x2 t = *(const u32x2*)(Y + (size_t)row * D + col); y[j] = (f32x4){bflo(t.x), bfhi(t.x), bflo(t.y), bfhi(t.y)}; }
            ss += y[j][0] * y[j][0] + y[j][1] * y[j][1] + y[j][2] * y[j][2] + y[j][3] * y[j][3]; }
        ss = wave_sum(ss); const float rstd = rsqrtf(ss * (1.0f / D) + EPS);
        float ss2 = 0.f;
#pragma unroll
        for (int j = 0; j < 8; ++j) { const int col = j * 256 + lane * 4;
            const f32x4 g = *(const f32x4*)(p.norm_g + GP * D + col), gt = ld_mod(modp, s, GI, col), xv = xv8[j];
            const f32x4 x1 = xv + WRES * gt * (y[j] * rstd * g);
            y[j] = x1; ss2 += x1[0] * x1[0] + x1[1] * x1[1] + x1[2] * x1[2] + x1[3] * x1[3];
            if (row < NLAT) *(f32x4*)(p.out + (size_t)row * D + col) = x1; }
        if (MODE == 2) continue;
        ss2 = wave_sum(ss2); const float rstd2 = rsqrtf(ss2 * (1.0f / D) + EPS);
#pragma unroll
        for (int j = 0; j < 8; ++j) { const int col = j * 256 + lane * 4;
            const f32x4 g = *(const f32x4*)(p.norm_g + GN * D + col), sh = ld_mod(modp, s, SI, col), sc = ld_mod(modp, s, SI + 1, col);
            st_bf16x4(A + (size_t)row * D + col, (y[j] * rstd2 * g) * (1.0f + sc) + sh); }
    }
}

constexpr int PREP_PITCH = 264;
constexpr int PREP_TILE = 64 * PREP_PITCH * 2;
__device__ __forceinline__ size_t gla_idx(int b, int h, int dir, int cid) { return (size_t)(((b * 4 + h) * 2 + dir) * NCH + cid); }

__device__ __forceinline__ void gla_prep_item(LAS uchar* lds, const Params& p, int item) {
    const int tid = threadIdx.x, wv = tid >> 6, lane = tid & 63;
    int h, cid, b;
    if (item < NB * 64 * 4) { h = item & 3; const int bc = item >> 2; cid = 4 + (bc & 63); b = bc >> 6; }
    else { const int it2 = item - NB * 64 * 4; h = it2 & 3; const int bc = it2 >> 2; cid = bc & 3; b = bc >> 2; }
    const bool lat = cid >= 4;
    const int rowbase = lat ? b * SEQ + (cid - 4) * 64 : NLAT + b * CTXL + cid * 64;
    const bf16_t* PROJ = (const bf16_t*)(p.ws + WS_PROJ);
    LAS float* Gs = (LAS float*)lds;
    {
        const int i = tid >> 3, c4 = (tid & 7) * 4;
        const u32x2 g = *(const u32x2*)(PROJ + (size_t)(rowbase + i) * LDP + OFF_GF + c4);
        *(LAS f32x4*)(Gs + i * 32 + c4) = (f32x4){bflo(g.x), bfhi(g.x), bflo(g.y), bfhi(g.y)};
    }
    __syncthreads();
    const int wvu = __builtin_amdgcn_readfirstlane(tid >> 6);
    const int d = tid & 255, dir = wvu >> 2;
    float wg[16];
#pragma unroll
    for (int r = 0; r < 16; ++r) wg[r] = p.gla_wg[(size_t)(dir * 16 + r) * 1024 + h * 256 + d] * LOG2E;
    const float bg = p.gla_bg[dir * 1024 + h * 256 + d] * LOG2E;
    const int axis = (wvu >> 1) & 1, fi = d & 63; const bool first = (wvu & 1) == 0;
    const int dpart = first ? d + 64 : d - 64;
    const float freq = __expf(-(float)fi * (9.210340371976184f / 64.0f));
    const float ang_row = (float)(cid - 4) * freq;
    float cs_row, sn_row; __sincosf(ang_row, &sn_row, &cs_row);
    if (!first) sn_row = -sn_row; sn_row = -sn_row;
    const float freq_rev = (first ? -freq : freq) * 0.15915494309189535f;
    bf16_t* QD = (bf16_t*)(p.ws + WS_QD) + gla_idx(b, h, dir, cid) * (64 * 256);
    bf16_t* KET = (bf16_t*)(p.ws + WS_KET) + gla_idx(b, h, dir, cid) * (256 * 64);
    LAS bf16_t* QDs = (LAS bf16_t*)(lds + 8192 + dir * 2 * PREP_TILE);
    LAS bf16_t* KIs = (LAS bf16_t*)(lds + 8192 + dir * 2 * PREP_TILE + PREP_TILE);
    float cum = 0.f;
    unsigned short rk[8], rkp[8], rq[8], rqp[8], nk_[8], nkp[8], nq_[8], nqp[8];
    const bf16_t* pbase = PROJ + (size_t)rowbase * LDP + h * 256;
    const unsigned ok_ = OFF_K + d, okp_ = OFF_K + dpart, oq_ = OFF_Q + d, oqp_ = OFF_Q + dpart;
#define PREP_LOAD(dk_, dkp_, dq_, dqp_, n8_) do { _Pragma("unroll") for (int jj = 0; jj < 8; ++jj) { const int n_ = (n8_) * 8 + jj, i_ = dir ? 63 - n_ : n_; \
        const unsigned to_ = (unsigned)i_ * (unsigned)LDP; dk_[jj] = pbase[to_ + ok_]; \
        if (lat) { dkp_[jj] = pbase[to_ + okp_]; dq_[jj] = pbase[to_ + oq_]; dqp_[jj] = pbase[to_ + oqp_]; } else { dkp_[jj] = 0; dq_[jj] = 0; dqp_[jj] = 0; } } } while (0)
    PREP_LOAD(rk, rkp, rq, rqp, 0);
    for (int n8 = 0; n8 < 8; ++n8) {
        if (n8 < 7) PREP_LOAD(nk_, nkp, nq_, nqp, n8 + 1);
        float ke[8];
#pragma unroll
        for (int jj = 0; jj < 8; ++jj) {
            const int n = n8 * 8 + jj, i = dir ? 63 - n : n;
            const LAS f32x4* gp = (const LAS f32x4*)(Gs + i * 32 + dir * 16);
            float z = bg;
#pragma unroll
            for (int q4 = 0; q4 < 4; ++q4) { const f32x4 gv = gp[q4]; z += gv[0] * wg[q4 * 4] + gv[1] * wg[q4 * 4 + 1] + gv[2] * wg[q4 * 4 + 2] + gv[3] * wg[q4 * 4 + 3]; }
            cum += (fminf(z, 0.f) - __builtin_amdgcn_logf(1.0f + __builtin_amdgcn_exp2f(-fabsf(z)))) * (1.0f / 16.0f);
            float kv = bf2f(rk[jj]);
            if (lat) {
                float cs, sn;
                if (axis == 0) { cs = cs_row; sn = sn_row; } else { const float a = (float)i * freq_rev; cs = __builtin_amdgcn_cosf(a); sn = __builtin_amdgcn_sinf(a); }
                const float kp2 = bf2f(rkp[jj]);
                kv = kv * cs + kp2 * sn;
                float qv = bf2f(rq[jj]); const float qp2 = bf2f(rqp[jj]);
                qv = (qv * cs + qp2 * sn) * 0.0625f;
                const float qd = qv * __builtin_amdgcn_exp2f(cum);
                const bf16_t qb = (bf16_t)(cvt_pk_bf16(qd, 0.f) & 0xffffu);
                QD[(size_t)i * 256 + d] = qb; QDs[i * PREP_PITCH + d] = qb;
            }
            const float ki = kv * __builtin_amdgcn_exp2f(-cum);
            if (lat) KIs[i * PREP_PITCH + d] = (bf16_t)(cvt_pk_bf16(ki, 0.f) & 0xffffu);
            ke[jj] = ki;
        }
        u32x4 o;
        if (dir == 0) { o.x = cvt_pk_bf16(ke[0], ke[1]); o.y = cvt_pk_bf16(ke[2], ke[3]); o.z = cvt_pk_bf16(ke[4], ke[5]); o.w = cvt_pk_bf16(ke[6], ke[7]); *(u32x4*)(KET + (size_t)d * 64 + n8 * 8) = o; }
        else { o.x = cvt_pk_bf16(ke[7], ke[6]); o.y = cvt_pk_bf16(ke[5], ke[4]); o.z = cvt_pk_bf16(ke[3], ke[2]); o.w = cvt_pk_bf16(ke[1], ke[0]); *(u32x4*)(KET + (size_t)d * 64 + (7 - n8) * 8) = o; }
#pragma unroll
        for (int jj = 0; jj < 8; ++jj) { rk[jj] = nk_[jj]; rkp[jj] = nkp[jj]; rq[jj] = nq_[jj]; rqp[jj] = nqp[jj]; }
    }
#undef PREP_LOAD
    ((float*)(p.ws + WS_DEC))[gla_idx(b, h, dir, cid) * 256 + d] = __builtin_amdgcn_exp2f(cum);
    {
        bf16_t* VT = (bf16_t*)(p.ws + WS_VT) + (size_t)((b * 4 + h) * NCH + cid) * (512 * 64);
        const bf16_t* vsrc = PROJ + (size_t)rowbase * LDP + OFF_V + h * 512 + tid;
        unsigned short e[64];
#pragma unroll
        for (int t = 0; t < 64; ++t) e[t] = vsrc[(size_t)t * LDP];
#pragma unroll
        for (int n8 = 0; n8 < 8; ++n8) {
            u32x4 o; o.x = e[n8 * 8] | ((unsigned)e[n8 * 8 + 1] << 16); o.y = e[n8 * 8 + 2] | ((unsigned)e[n8 * 8 + 3] << 16); o.z = e[n8 * 8 + 4] | ((unsigned)e[n8 * 8 + 5] << 16); o.w = e[n8 * 8 + 6] | ((unsigned)e[n8 * 8 + 7] << 16);
            *(u32x4*)(VT + (size_t)tid * 64 + n8 * 8) = o;
        }
    }
    __syncthreads();
    if (lat) {
        const int wdir = wv >> 2, ib = wv & 3, fr = lane & 15, g = lane >> 4;
        const LAS bf16_t* Qs = (const LAS bf16_t*)(lds + 8192 + wdir * 2 * PREP_TILE);
        const LAS bf16_t* Ks = (const LAS bf16_t*)(lds + 8192 + wdir * 2 * PREP_TILE + PREP_TILE);
        f32x4 acc[4];
#pragma unroll
        for (int nb = 0; nb < 4; ++nb) acc[nb] = (f32x4){0.f, 0.f, 0.f, 0.f};
        bf16x8 qf[8];
#pragma unroll
        for (int kk = 0; kk < 8; ++kk) qf[kk] = *(const LAS bf16x8*)(Qs + (16 * ib + fr) * PREP_PITCH + 32 * kk + 8 * g);
#pragma unroll
        for (int nb = 0; nb < 4; ++nb) {
            bf16x8 kf[8];
#pragma unroll
            for (int kk = 0; kk < 8; ++kk) kf[kk] = *(const LAS bf16x8*)(Ks + (16 * nb + fr) * PREP_PITCH + 32 * kk + 8 * g);
            __builtin_amdgcn_sched_barrier(0);
#pragma unroll
            for (int kk = 0; kk < 8; ++kk) acc[nb] = __builtin_amdgcn_mfma_f32_16x16x32_bf16(kf[kk], qf[kk], acc[nb], 0, 0, 0);
        }
        bf16_t* PM = (bf16_t*)(p.ws + WS_PM) + gla_idx(b, h, wdir, cid) * 4096;
        const int i = 16 * ib + fr;
#pragma unroll
        for (int nb = 0; nb < 4; ++nb) {
            float v[4];
#pragma unroll
            for (int r = 0; r < 4; ++r) { const int j = 16 * nb + 4 * g + r; const bool keep = wdir ? (j >= i) : (j <= i); v[r] = keep ? acc[nb][r] : 0.f; }
            u32x2 o; o.x = cvt_pk_bf16(v[0], v[1]); o.y = cvt_pk_bf16(v[2], v[3]);
            *(u32x2*)(PM + (size_t)i * 64 + 16 * nb + 4 * g) = o;
        }
    }
    __syncthreads();
}
__device__ __forceinline__ void na_vt_item(const Params& p, int item) {
    const int tid = threadIdx.x; const int blk = item % NCH, b = item / NCH; const bool lat = blk >= 4;
    const int rowbase = lat ? b * SEQ + (blk - 4) * 64 : NLAT + b * CTXL + blk * 64;
    const bf16_t* PROJ = (const bf16_t*)(p.ws + WS_PROJ);
    const int c = 2 * tid, h = c >> 6, dv = c & 63;
    const bf16_t* src = PROJ + (size_t)rowbase * LDP + OFF_NV + c;
    bf16_t* dst; int pitch;
    if (lat) { dst = (bf16_t*)(p.ws + WS_NVTL) + ((size_t)((b * 16 + h) * 64 + (blk - 4)) * 64 + dv) * 64; pitch = 64; }
    else { dst = (bf16_t*)(p.ws + WS_NVTC) + ((size_t)(b * 16 + h) * 64 + dv) * 256 + blk * 64; pitch = 256; }
    unsigned e[64];
#pragma unroll
    for (int t = 0; t < 64; ++t) e[t] = *(const unsigned*)(src + (size_t)t * LDP);
#pragma unroll
    for (int n8 = 0; n8 < 8; ++n8) {
        const unsigned* q = e + n8 * 8;
        u32x4 lo, hi;
        lo.x = (q[0] & 0xffffu) | (q[1] << 16); lo.y = (q[2] & 0xffffu) | (q[3] << 16); lo.z = (q[4] & 0xffffu) | (q[5] << 16); lo.w = (q[6] & 0xffffu) | (q[7] << 16);
        hi.x = (q[0] >> 16) | (q[1] & 0xffff0000u); hi.y = (q[2] >> 16) | (q[3] & 0xffff0000u); hi.z = (q[4] >> 16) | (q[5] & 0xffff0000u); hi.w = (q[6] >> 16) | (q[7] & 0xffff0000u);
        *(u32x4*)(dst + n8 * 8) = lo; *(u32x4*)(dst + pitch + n8 * 8) = hi;
    }
}

constexpr int ST_PITCH = 264, VT_PITCH = 72;
constexpr int SC_ST = 0, SC_QD = 64 * ST_PITCH * 2, SC_VT = 2 * 64 * ST_PITCH * 2, SC_PM = SC_VT + 64 * VT_PITCH * 2, SC_KT = SC_PM + 64 * VT_PITCH * 2, SC_DC = SC_KT + 256 * VT_PITCH * 2;
__device__ __forceinline__ int scan_cid(int n, int dir) { return n < 4 ? (dir ? 3 - n : n) : (dir ? 67 - (n - 4) : n); }

__device__ __forceinline__ void gla_scan_task(LAS uchar* lds, const Params& p, int task) {
    const int tid = threadIdx.x, w = __builtin_amdgcn_readfirstlane(tid >> 6), lane = tid & 63;
    const int xcd = task & 7, jj = task >> 3, combo = xcd * 2 + (jj >> 3), sl = jj & 7;
    const int b = combo >> 3, h = (combo >> 1) & 3, dir = combo & 1, dv0 = sl * 64;
    const int l32 = lane & 31, hf = lane >> 5;
    const bool isU = w >= 4; const int u = w & 3;
    const int dvb = u >> 1, ibk = u & 1;
    LAS bf16_t* ST = (LAS bf16_t*)(lds + SC_ST); LAS bf16_t* QDs = (LAS bf16_t*)(lds + SC_QD); LAS bf16_t* VTs = (LAS bf16_t*)(lds + SC_VT); LAS bf16_t* PMs = (LAS bf16_t*)(lds + SC_PM);
    LAS bf16_t* KTs = (LAS bf16_t*)(lds + SC_KT); LAS float* DCs = (LAS float*)(lds + SC_DC);
    for (int i = tid; i < 64 * ST_PITCH / 2; i += NTHR) ((LAS unsigned*)lds)[i] = 0u;
    const bf16_t* QDb = (const bf16_t*)(p.ws + WS_QD); const bf16_t* KITb = (const bf16_t*)(p.ws + WS_KET); const bf16_t* PMb = (const bf16_t*)(p.ws + WS_PM);
    const float* DECb = (const float*)(p.ws + WS_DEC); const bf16_t* VTb = (const bf16_t*)(p.ws + WS_VT);
    bf16_t* Ob = (bf16_t*)(p.ws + (dir ? WS_OB : WS_OF));
    f32x16 S00, S01, S10, S11;
#pragma unroll
    for (int i = 0; i < 16; ++i) { S00[i] = 0.f; S01[i] = 0.f; S10[i] = 0.f; S11[i] = 0.f; }
    const int vrow = tid >> 3, vc = (tid & 7) * 8;
    u32x4 qd_r[4], vt_r, pm_r, kt_r[4]; f32x4 dc_r;
#define SC_FETCH(n_) do { const int cid_ = scan_cid((n_), dir); const size_t gi_ = gla_idx(b, h, dir, cid_); \
        vt_r = *(const u32x4*)(VTb + (size_t)((b * 4 + h) * NCH + cid_) * (512 * 64) + (size_t)(dv0 + vrow) * 64 + vc); \
        _Pragma("unroll") for (int k4 = 0; k4 < 4; ++k4) kt_r[k4] = *(const u32x4*)(KITb + gi_ * (256 * 64) + (size_t)(tid + 512 * k4) * 8); \
        if (tid < 64) dc_r = *(const f32x4*)(DECb + gi_ * 256 + 4 * tid); \
        if ((n_) >= 4) { pm_r = *(const u32x4*)(PMb + gi_ * 4096 + vrow * 64 + vc); \
            _Pragma("unroll") for (int k4 = 0; k4 < 4; ++k4) { const int ch_ = tid + 512 * k4; qd_r[k4] = *(const u32x4*)(QDb + gi_ * (64 * 256) + (size_t)(ch_ >> 5) * 256 + (ch_ & 31) * 8); } } } while (0)
#define SC_COMMIT(n_) do { *(LAS u32x4*)(VTs + vrow * VT_PITCH + vc) = vt_r; \
        _Pragma("unroll") for (int k4 = 0; k4 < 4; ++k4) { const int ch_ = tid + 512 * k4; *(LAS u32x4*)(KTs + (ch_ >> 3) * VT_PITCH + (ch_ & 7) * 8) = kt_r[k4]; } \
        if (tid < 64) *(LAS f32x4*)(DCs + 4 * tid) = dc_r; \
        if ((n_) >= 4) { *(LAS u32x4*)(PMs + vrow * VT_PITCH + vc) = pm_r; \
            _Pragma("unroll") for (int k4 = 0; k4 < 4; ++k4) { const int ch_ = tid + 512 * k4; *(LAS u32x4*)(QDs + (ch_ >> 5) * ST_PITCH + (ch_ & 31) * 8) = qd_r[k4]; } } } while (0)
    SC_FETCH(0);
    SC_COMMIT(0);
    __syncthreads();
    for (int n = 0; n < NCH; ++n) {
        if (n + 1 < NCH) SC_FETCH(n + 1);
        if (isU) {
            f32x4 dec[2][4]; bf16x8 kit[8];
#pragma unroll
            for (int rb = 0; rb < 2; ++rb)
#pragma unroll
                for (int j4 = 0; j4 < 4; ++j4) dec[rb][j4] = *(const LAS f32x4*)(DCs + 64 * u + 32 * rb + 8 * j4 + 4 * hf);
#pragma unroll
            for (int rb = 0; rb < 2; ++rb)
#pragma unroll
                for (int kk = 0; kk < 4; ++kk) kit[rb * 4 + kk] = *(const LAS bf16x8*)(KTs + (64 * u + 32 * rb + l32) * VT_PITCH + 16 * kk + 8 * hf);
            const LAS bf16_t* vb0 = VTs + l32 * VT_PITCH + 8 * hf; const LAS bf16_t* vb1 = vb0 + 32 * VT_PITCH;
            bf16x8 ua[4], ub[4];
#pragma unroll
            for (int kk = 0; kk < 4; ++kk) { ua[kk] = *(const LAS bf16x8*)(vb0 + 16 * kk); ub[kk] = *(const LAS bf16x8*)(vb1 + 16 * kk); }
#pragma unroll
            for (int kk = 0; kk < 4; ++kk) {
                S00 = __builtin_amdgcn_mfma_f32_32x32x16_bf16(kit[kk], ua[kk], S00, 0, 0, 0);
                S01 = __builtin_amdgcn_mfma_f32_32x32x16_bf16(kit[kk], ub[kk], S01, 0, 0, 0);
                S10 = __builtin_amdgcn_mfma_f32_32x32x16_bf16(kit[4 + kk], ua[kk], S10, 0, 0, 0);
                S11 = __builtin_amdgcn_mfma_f32_32x32x16_bf16(kit[4 + kk], ub[kk], S11, 0, 0, 0); }
#pragma unroll
            for (int j4 = 0; j4 < 4; ++j4)
#pragma unroll
                for (int r = 0; r < 4; ++r) { S00[j4 * 4 + r] *= dec[0][j4][r]; S01[j4 * 4 + r] *= dec[0][j4][r]; S10[j4 * 4 + r] *= dec[1][j4][r]; S11[j4 * 4 + r] *= dec[1][j4][r]; }
        } else if (n >= 4) {
            const int cid = scan_cid(n, dir);
            f32x16 o;
#pragma unroll
            for (int i = 0; i < 16; ++i) o[i] = 0.f;
            const LAS bf16_t* sa = ST + (32 * dvb + l32) * ST_PITCH + 8 * hf; const LAS bf16_t* qb_ = QDs + (32 * ibk + l32) * ST_PITCH + 8 * hf;
            const LAS bf16_t* va = VTs + (32 * dvb + l32) * VT_PITCH + 8 * hf; const LAS bf16_t* pb = PMs + (32 * ibk + l32) * VT_PITCH + 8 * hf;
#pragma unroll
            for (int half = 0; half < 2; ++half) {
                bf16x8 fa[8], fb[8];
#pragma unroll
                for (int kk = 0; kk < 8; ++kk) { fa[kk] = *(const LAS bf16x8*)(sa + 16 * (half * 8 + kk)); fb[kk] = *(const LAS bf16x8*)(qb_ + 16 * (half * 8 + kk)); }
#pragma unroll
                for (int kk = 0; kk < 8; ++kk) o = __builtin_amdgcn_mfma_f32_32x32x16_bf16(fa[kk], fb[kk], o, 0, 0, 0);
            }
            {
                bf16x8 fa[4], fb[4];
#pragma unroll
                for (int q = 0; q < 4; ++q) { fa[q] = *(const LAS bf16x8*)(va + 16 * q); fb[q] = *(const LAS bf16x8*)(pb + 16 * q); }
#pragma unroll
                for (int q = 0; q < 4; ++q) o = __builtin_amdgcn_mfma_f32_32x32x16_bf16(fa[q], fb[q], o, 0, 0, 0);
            }
            bf16_t* op = Ob + (size_t)(b * SEQ + (cid - 4) * 64 + 32 * ibk + l32) * D + h * 512 + dv0 + 32 * dvb + 4 * hf;
#pragma unroll
            for (int j4 = 0; j4 < 4; ++j4) { u32x2 ov; ov.x = cvt_pk_bf16(o[j4 * 4], o[j4 * 4 + 1]); ov.y = cvt_pk_bf16(o[j4 * 4 + 2], o[j4 * 4 + 3]); *(u32x2*)(op + 8 * j4) = ov; }
        }
        __syncthreads();
        if (isU) {
            LAS bf16_t* stw = ST + l32 * ST_PITCH + 64 * u + 4 * hf;
#pragma unroll
            for (int j4 = 0; j4 < 4; ++j4) { u32x2 sv;
                sv.x = cvt_pk_bf16(S00[j4 * 4], S00[j4 * 4 + 1]); sv.y = cvt_pk_bf16(S00[j4 * 4 + 2], S00[j4 * 4 + 3]); *(LAS u32x2*)(stw + 8 * j4) = sv;
                sv.x = cvt_pk_bf16(S01[j4 * 4], S01[j4 * 4 + 1]); sv.y = cvt_pk_bf16(S01[j4 * 4 + 2], S01[j4 * 4 + 3]); *(LAS u32x2*)(stw + 32 * ST_PITCH + 8 * j4) = sv;
                sv.x = cvt_pk_bf16(S10[j4 * 4], S10[j4 * 4 + 1]); sv.y = cvt_pk_bf16(S10[j4 * 4 + 2], S10[j4 * 4 + 3]); *(LAS u32x2*)(stw + 32 + 8 * j4) = sv;
                sv.x = cvt_pk_bf16(S11[j4 * 4], S11[j4 * 4 + 1]); sv.y = cvt_pk_bf16(S11[j4 * 4 + 2], S11[j4 * 4 + 3]); *(LAS u32x2*)(stw + 32 * ST_PITCH + 32 + 8 * j4) = sv; }
        }
        if (n + 1 < NCH) SC_COMMIT(n + 1);
        __syncthreads();
    }
#undef SC_FETCH
#undef SC_COMMIT
}

constexpr int NA_KV = 24576, NA_KP = 72, NA_CP = 264;
constexpr int NA_QW = 20480;
__device__ __forceinline__ void na_item(LAS uchar* lds, const Params& p, int it) {
    const int tid = threadIdx.x, w = tid >> 6, lane = tid & 63, fr = lane & 15, g = lane >> 4;
    const int r = it & 63, h = (it >> 6) & 15, b = it >> 10;
    const int qb = w & 3, kind = w >> 2;
    LAS float* rpbS = (LAS float*)lds;
    LAS float* CBm = (LAS float*)(lds + 2048);
    LAS float* CBl = (LAS float*)(lds + 2048 + 256);
    LAS float* CBo = (LAS float*)(lds + 4096);
    LAS bf16_t* KL = (LAS bf16_t*)(lds + NA_KV);
    LAS bf16_t* KC = (LAS bf16_t*)(lds + NA_KV + 512 * NA_KP * 2);
    const bf16_t* PROJ = (const bf16_t*)(p.ws + WS_PROJ);
    const int rs = min(max(r - 4, 0), 56);
    u32x4 st[12];
    {
        const int c8 = (tid & 7) * 8;
#pragma unroll
        for (int k = 0; k < 8; ++k) { const int key = (tid >> 3) + 64 * k; st[k] = *(const u32x4*)(PROJ + (size_t)(b * SEQ + (rs + k) * 64 + (tid >> 3)) * LDP + OFF_NK + h * 64 + c8); (void)key; }
#pragma unroll
        for (int k = 0; k < 4; ++k) st[8 + k] = *(const u32x4*)(PROJ + (size_t)(NLAT + b * CTXL + (tid >> 3) + 64 * k) * LDP + OFF_NK + h * 64 + c8);
    }
    const int c0 = qb == 0 ? 0 : (qb == 1 ? 8 : (qb == 2 ? 24 : 32));
    const int j = 16 * qb + fr;
    const int cs = min(max(j - 8, 0), 48);
    const bf16_t* qrow = PROJ + (size_t)(b * SEQ + r * 64 + j) * LDP + OFF_NQ + h * 64 + 8 * g;
    const bf16x8 q0 = *(const bf16x8*)qrow, q1 = *(const bf16x8*)(qrow + 32);
    if (tid < 480) { const int rw = tid >> 5, cc = tid & 31; rpbS[tid] = cc < 31 ? p.na_rpb[h * 465 + rw * 31 + cc] * LOG2E : -1e30f; }
    {
        const int c8 = (tid & 7) * 8, kr = tid >> 3;
#pragma unroll
        for (int k = 0; k < 8; ++k) *(LAS u32x4*)(KL + (kr + 64 * k) * NA_KP + c8) = st[k];
#pragma unroll
        for (int k = 0; k < 4; ++k) *(LAS u32x4*)(KC + (kr + 64 * k) * NA_KP + c8) = st[8 + k];
    }
    __syncthreads();
    {
        const bf16_t* vl = (const bf16_t*)(p.ws + WS_NVTL) + (size_t)((b * 16 + h) * 64 + rs) * (64 * 64);
#pragma unroll
        for (int k = 0; k < 8; ++k) st[k] = *(const u32x4*)(vl + (size_t)(tid + 512 * k) * 8);
        const bf16_t* vc = (const bf16_t*)(p.ws + WS_NVTC) + (size_t)(b * 16 + h) * (64 * 256);
#pragma unroll
        for (int k = 0; k < 4; ++k) st[8 + k] = *(const u32x4*)(vc + (size_t)(tid + 512 * k) * 8);
    }
    const int mk = 8 * (fr >> 2) + (fr & 3);
    f32x4 s[16];
#pragma unroll
    for (int kb = 0; kb < 16; ++kb) {
        const int pp = kb >> 1, e = kb & 1;
        const LAS bf16_t* krow = kind == 0 ? KL + (pp * 64 + c0 + mk + 4 * e) * NA_KP + 8 * g : KC + (32 * pp + mk + 4 * e) * NA_KP + 8 * g;
        const bf16x8 k0 = *(const LAS bf16x8*)krow, k1 = *(const LAS bf16x8*)(krow + 32);
        f32x4 a = (f32x4){0.f, 0.f, 0.f, 0.f};
        a = __builtin_amdgcn_mfma_f32_16x16x32_bf16(k0, q0, a, 0, 0, 0);
        a = __builtin_amdgcn_mfma_f32_16x16x32_bf16(k1, q1, a, 0, 0, 0);
        s[kb] = a;
    }
    const float sc = 0.125f * LOG2E;
    float mx = -1e30f;
    if (kind == 0) {
        int colb[8];
        const int rowbase = (rs - r + 7) * 32;
#pragma unroll
        for (int x = 0; x < 8; ++x) { const int kc = c0 + 8 * g + x; const bool ok = (kc >= cs) && (kc < cs + 16); colb[x] = rowbase + (ok ? kc - j + 15 : 31); }
#pragma unroll
        for (int kb = 0; kb < 16; ++kb) {
            const int pp = kb >> 1, e = kb & 1;
#pragma unroll
            for (int i = 0; i < 4; ++i) { const float t = s[kb][i] * sc + rpbS[colb[4 * e + i] + pp * 32]; s[kb][i] = t; mx = fmaxf(mx, t); }
        }
    } else {
#pragma unroll
        for (int kb = 0; kb < 16; ++kb)
#pragma unroll
            for (int i = 0; i < 4; ++i) { const float t = s[kb][i] * sc; s[kb][i] = t; mx = fmaxf(mx, t); }
    }
    mx = fmaxf(mx, __shfl_xor(mx, 16)); mx = fmaxf(mx, __shfl_xor(mx, 32));
    float l = 0.f;
#pragma unroll
    for (int kb = 0; kb < 16; ++kb)
#pragma unroll
        for (int i = 0; i < 4; ++i) { const float e2 = __builtin_amdgcn_exp2f(s[kb][i] - mx); s[kb][i] = e2; l += e2; }
    l += __shfl_xor(l, 16); l += __shfl_xor(l, 32);
    __syncthreads();
    {
#pragma unroll
        for (int k = 0; k < 8; ++k) { const int ch = tid + 512 * k; *(LAS u32x4*)(KL + (ch >> 3) * NA_KP + (ch & 7) * 8) = st[k]; }
#pragma unroll
        for (int k = 0; k < 4; ++k) { const int ch = tid + 512 * k; *(LAS u32x4*)(KC + (ch >> 5) * NA_CP + (ch & 31) * 8) = st[8 + k]; }
    }
    __syncthreads();
    f32x4 o[4];
#pragma unroll
    for (int dvb = 0; dvb < 4; ++dvb) o[dvb] = (f32x4){0.f, 0.f, 0.f, 0.f};
#pragma unroll
    for (int pp = 0; pp < 8; ++pp) {
        u32x4 pk; pk.x = cvt_pk_bf16(s[2 * pp][0], s[2 * pp][1]); pk.y = cvt_pk_bf16(s[2 * pp][2], s[2 * pp][3]); pk.z = cvt_pk_bf16(s[2 * pp + 1][0], s[2 * pp + 1][1]); pk.w = cvt_pk_bf16(s[2 * pp + 1][2], s[2 * pp + 1][3]);
        const bf16x8 pf = as_bf16x8(pk);
#pragma unroll
        for (int dvb = 0; dvb < 4; ++dvb) {
            const LAS bf16_t* vp = kind == 0 ? KL + (pp * 64 + 16 * dvb + fr) * NA_KP + c0 + 8 * g : KC + (16 * dvb + fr) * NA_CP + 32 * pp + 8 * g;
            o[dvb] = __builtin_amdgcn_mfma_f32_16x16x32_bf16(*(const LAS bf16x8*)vp, pf, o[dvb], 0, 0, 0);
        }
    }
    if (kind == 1) {
        if (g == 0) { CBm[qb * 16 + fr] = mx; CBl[qb * 16 + fr] = l; }
#pragma unroll
        for (int dvb = 0; dvb < 4; ++dvb) *(LAS f32x4*)(CBo + (qb * 64 + lane) * 16 + dvb * 4) = o[dvb];
    }
    __syncthreads();
    if (kind == 0) {
        const float m2 = CBm[qb * 16 + fr], l2 = CBl[qb * 16 + fr];
        const float M = fmaxf(mx, m2), a1 = __builtin_amdgcn_exp2f(mx - M), a2 = __builtin_amdgcn_exp2f(m2 - M);
        const float inv = fast_rcp(l * a1 + l2 * a2);
        bf16_t* op = (bf16_t*)(p.ws + WS_NAO) + (size_t)(b * SEQ + r * 64 + j) * 1024 + h * 64 + 4 * g;
#pragma unroll
        for (int dvb = 0; dvb < 4; ++dvb) {
            const f32x4 o2 = *(const LAS f32x4*)(CBo + (qb * 64 + lane) * 16 + dvb * 4);
            const f32x4 v = (o[dvb] * a1 + o2 * a2) * inv;
            u32x2 ov; ov.x = cvt_pk_bf16(v[0], v[1]); ov.y = cvt_pk_bf16(v[2], v[3]); *(u32x2*)(op + 16 * dvb) = ov;
        }
    }
    __syncthreads();
}

__device__ __forceinline__ void phase_readout(const Params& p) {
    const int w = threadIdx.x >> 6, lane = threadIdx.x & 63;
    const bf16_t* OF = (const bf16_t*)(p.ws + WS_OF); const bf16_t* OB = (const bf16_t*)(p.ws + WS_OB); const bf16_t* PROJ = (const bf16_t*)(p.ws + WS_PROJ);
    bf16_t* AG = (bf16_t*)(p.ws + WS_AG);
    for (int item = blockIdx.x; item < NLAT / 8; item += gridDim.x) {
        const int row = item * 8 + w;
        u32x4 av[4], bv[4], rv4[4];
#pragma unroll
        for (int h = 0; h < 4; ++h) { const int col = h * 512 + lane * 8;
            av[h] = *(const u32x4*)(OF + (size_t)row * D + col); bv[h] = *(const u32x4*)(OB + (size_t)row * D + col); rv4[h] = *(const u32x4*)(PROJ + (size_t)row * LDP + OFF_R + col); }
        const f32x4 g0 = *(const f32x4*)(p.gla_norm_g + lane * 8), g1 = *(const f32x4*)(p.gla_norm_g + lane * 8 + 4);
#pragma unroll
        for (int h = 0; h < 4; ++h) {
            const int col = h * 512 + lane * 8;
            const u32x4 a = av[h], bq = bv[h], rr = rv4[h];
            float o[8];
            o[0] = bflo(a.x) + bflo(bq.x); o[1] = bfhi(a.x) + bfhi(bq.x); o[2] = bflo(a.y) + bflo(bq.y); o[3] = bfhi(a.y) + bfhi(bq.y);
            o[4] = bflo(a.z) + bflo(bq.z); o[5] = bfhi(a.z) + bfhi(bq.z); o[6] = bflo(a.w) + bflo(bq.w); o[7] = bfhi(a.w) + bfhi(bq.w);
            float ss = 0.f;
#pragma unroll
            for (int i = 0; i < 8; ++i) ss += o[i] * o[i];
            ss = wave_sum(ss); const float rstd = rsqrtf(ss * (1.0f / 512.0f) + EPS);
            const float rv[8] = {bflo(rr.x), bfhi(rr.x), bflo(rr.y), bfhi(rr.y), bflo(rr.z), bfhi(rr.z), bflo(rr.w), bfhi(rr.w)};
            float v[8];
#pragma unroll
            for (int i = 0; i < 8; ++i) v[i] = o[i] * rstd * (i < 4 ? g0[i] : g1[i - 4]) * siluf_(rv[i]);
            u32x4 ov; ov.x = cvt_pk_bf16(v[0], v[1]); ov.y = cvt_pk_bf16(v[2], v[3]); ov.z = cvt_pk_bf16(v[4], v[5]); ov.w = cvt_pk_bf16(v[6], v[7]);
            *(u32x4*)(AG + (size_t)row * D + col) = ov;
        }
    }
}

constexpr int N_PHASES = 15;
__global__ void __launch_bounds__(NTHR, 2) mk_fwd(Params p) {
    extern __shared__ __attribute__((aligned(16))) uchar lds_raw[];
    LAS uchar* lds = (LAS uchar*)lds_raw;
    const int G = gridDim.x, bx = blockIdx.x;
    uchar* ws = p.ws;
#define IN(k) (p.ph_lo <= (k) && (k) < p.ph_hi)
    LAS unsigned* xbst = (LAS unsigned*)(lds + LDS_BYTES - 16);
    if (threadIdx.x == 0) { xbst[0] = 0u; xbst[1] = 0u; xbst[2] = 0u; xbst[3] = 0u; }
    __syncthreads();
    const XcdBarrier xbar = xcd_barrier_post((unsigned*)(ws + WS_BAR), (volatile LAS unsigned*)xbst);
    if (p.ph_lo < 0) cg::this_grid().sync();
#define SEAM(k) do { if (IN(k) && IN((k) + 1)) { xcd_barrier(xbar); for (int xs_ = 0; xs_ < MK_EXTRA_SYNC; ++xs_) xcd_barrier(xbar); } } while (0)
#define REPS(k) for (int rep_ = 0; rep_ < 1 + ((MK_REP_MASK >> (k)) & 1); ++rep_)
    bf16_t* A = (bf16_t*)(ws + WS_A); bf16_t* H = (bf16_t*)(ws + WS_H); bf16_t* Y = (bf16_t*)(ws + WS_Y); bf16_t* YC = (bf16_t*)(ws + WS_YC);
    bf16_t* PROJ = (bf16_t*)(ws + WS_PROJ);

    if (IN(0)) REPS(0) { phase_prologue(lds, p); } SEAM(0);
    if (IN(1)) REPS(1) { phase_prenorm1(p); } SEAM(1);
    if (IN(2)) REPS(2) {
        { pg8::Gemm g{A, (const bf16_t*)(ws + WS_WGU1), NLAT, 2 * DFF, D, D, D}; pg8::StaticOrder S; S.init(NLAT, 2 * DFF, G, bx); pg8::EpiSiluMul E{H, DFF}; pg8::gemm_phase(lds, g, S, E); }
        { pg8::Gemm g{A + (size_t)NLAT * D, (const bf16_t*)(ws + WS_WGU1), NCTX, 2 * DFF, D, D, D}; pg8::StaticOrder S; S.init(NCTX, 2 * DFF, G, G - 1 - bx); pg8::EpiSiluMul E{H + (size_t)NLAT * DFF, DFF}; pg8::gemm_phase(lds, g, S, E); }
    } SEAM(2);
    if (IN(3)) REPS(3) {
        { pg8::Gemm g{H, (const bf16_t*)(ws + WS_WD1), NLAT, D, DFF, DFF, DFF}; pg8::StaticOrder S; S.init(NLAT, D, G, bx); pg8::EpiBf16 E{Y, D}; pg8::gemm_phase(lds, g, S, E); }
        for (int sp = 0; sp < 4; ++sp) { pg8::Gemm g{H + (size_t)NLAT * DFF + sp * 1408, (const bf16_t*)(ws + WS_WD1) + sp * 1408, NCTX, D, 1408, DFF, DFF}; pg8::StaticOrder S; S.init(NCTX, D, G, (bx + G - 16 * sp) % G);
            pg8::EpiBf16 E{YC + (size_t)sp * NCTX * D, D}; pg8::gemm_phase(lds, g, S, E); }
    } SEAM(3);
    if (IN(4)) REPS(4) { phase_post<0>(p); } SEAM(4);
    if (IN(5)) REPS(5) {
        { pg8::Gemm g{A, (const bf16_t*)(ws + WS_WIN), NLAT, LDP, D, D, D}; pg8::StaticOrder S; S.init(NLAT, LDP, G, bx); pg8::EpiBf16 E{PROJ, LDP}; pg8::gemm_phase(lds, g, S, E); }
        { pg8::Gemm g{A + (size_t)NLAT * D, (const bf16_t*)(ws + WS_WIN), NCTX, NCTXCOLS, D, D, D}; pg8::StaticOrder S; S.init(NCTX, NCTXCOLS, G, G - 1 - bx); pg8::EpiBf16 E{PROJ + (size_t)NLAT * LDP, LDP}; pg8::gemm_phase(lds, g, S, E); }
    } SEAM(5);
    if (IN(6)) REPS(6) {
        const int n_items = NB * NCH * 4 + NB * NCH;
        for (int it = bx; it < n_items; it += G) { if (it < NB * NCH * 4) gla_prep_item(lds, p, it); else na_vt_item(p, it - NB * NCH * 4); }
    } SEAM(6);
    if (IN(7)) REPS(7) {
        for (int t = bx; t < 128; t += G) gla_scan_task(lds, p, t);
        __syncthreads();
        {
            unsigned* qhead = (unsigned*)(ws + WS_CTR);
            if (threadIdx.x == 0) *(LAS unsigned*)(lds + NA_QW) = atomicAdd(qhead, 1u);
            __syncthreads();
            unsigned it = *(LAS unsigned*)(lds + NA_QW);
            __syncthreads();
            while (it < (unsigned)(NB * 16 * 64)) {
                unsigned nxt = 0u;
                if (threadIdx.x == 0) nxt = atomicAdd(qhead, 1u);
                na_item(lds, p, (int)it);
                if (threadIdx.x == 0) *(LAS unsigned*)(lds + NA_QW) = nxt;
                __syncthreads();
                it = *(LAS unsigned*)(lds + NA_QW);
                __syncthreads();
            }
        }
    } SEAM(7);
    if (IN(8)) REPS(8) {
        phase_readout(p);
        { pg8::Gemm g{(const bf16_t*)(ws + WS_NAO), (const bf16_t*)(ws + WS_WNAO), NLAT, D, 1024, 1024, 1024}; pg8::StaticOrder S; S.init(NLAT, D, G, bx); pg8::EpiGate2 E{(bf16_t*)(ws + WS_G2), PROJ + OFF_M2}; pg8::gemm_phase(lds, g, S, E); }
    } SEAM(8);
    if (IN(9)) REPS(9) { pg8::Gemm g{(const bf16_t*)(ws + WS_AG), (const bf16_t*)(ws + WS_WGLAO), NLAT, D, D, D, D}; pg8::StaticOrder S; S.init(NLAT, D, G, bx); pg8::EpiMerge E{(bf16_t*)(ws + WS_MG), PROJ + OFF_M1, (const bf16_t*)(ws + WS_G2)}; pg8::gemm_phase(lds, g, S, E); } SEAM(9);
    if (IN(10)) REPS(10) { pg8::Gemm g{(const bf16_t*)(ws + WS_MG), (const bf16_t*)(ws + WS_WOUT), NLAT, D, D, D, D}; pg8::StaticOrder S; S.init(NLAT, D, G, bx); pg8::EpiBf16 E{Y, D}; pg8::gemm_phase(lds, g, S, E); } SEAM(10);
    if (IN(11)) REPS(11) { phase_post<1>(p); } SEAM(11);
    if (IN(12)) REPS(12) { pg8::Gemm g{A, (const bf16_t*)(ws + WS_WGU2), NLAT, 2 * DFF, D, D, D}; pg8::StaticOrder S; S.init(NLAT, 2 * DFF, G, bx); pg8::EpiSiluMul E{H, DFF}; pg8::gemm_phase(lds, g, S, E); } SEAM(12);
    if (IN(13)) REPS(13) { pg8::Gemm g{H, (const bf16_t*)(ws + WS_WD2), NLAT, D, DFF, DFF, DFF}; pg8::StaticOrder S; S.init(NLAT, D, G, bx); pg8::EpiBf16 E{Y, D}; pg8::gemm_phase(lds, g, S, E); } SEAM(13);
    if (IN(14)) REPS(14) { phase_post<2>(p); }
#undef IN
#undef SEAM
}


#ifndef MK_RUN
#define MK_RUN N_PHASES
#endif
#ifndef MK_COOP
#define MK_COOP 1
#endif
extern "C" void kernel_launch(void* const* d_in, const int* in_sizes, int n_in, void* d_out, int out_size, void* d_ws, size_t ws_size, hipStream_t stream) {
    static int grid = 0;
    if (grid == 0) {
        if (n_in != 18 || ws_size < WS_END) { fprintf(stderr, "kernel_launch: need 18 inputs and %zu bytes of workspace (got %d, %zu)\n", (size_t)WS_END, n_in, ws_size); grid = -1; return; }
        int dev = 0, cus = 0, per_cu = 0;
        hipGetDevice(&dev); hipDeviceGetAttribute(&cus, hipDeviceAttributeMultiprocessorCount, dev);
        if (hipFuncSetAttribute((const void*)mk_fwd, hipFuncAttributeMaxDynamicSharedMemorySize, LDS_BYTES) != hipSuccess) { fprintf(stderr, "kernel_launch: hipFuncSetAttribute failed\n"); grid = -1; return; }
        if (hipOccupancyMaxActiveBlocksPerMultiprocessor(&per_cu, (const void*)mk_fwd, NTHR, LDS_BYTES) != hipSuccess || per_cu < 1) { fprintf(stderr, "kernel_launch: occupancy query gave %d\n", per_cu); per_cu = 1; }
        (void)hipGetLastError();
        grid = cus * 1;
    }
    if (grid < 0) return;
    if (hipMemsetAsync((char*)d_ws + WS_CTR, 0, 16384, stream) != hipSuccess) { fprintf(stderr, "kernel_launch: memset failed\n"); return; }
    Params p{};
    const float** f = (const float**)&p;
    for (int i = 0; i < 18; ++i) f[i] = (const float*)d_in[i];
    p.out = (float*)d_out; p.ws = (uchar*)d_ws;
#if MK_COOP
    p.ph_lo = 0; p.ph_hi = MK_RUN;
    void* args[] = {&p};
    hipError_t e = hipLaunchCooperativeKernel((const void*)mk_fwd, dim3(grid), dim3(NTHR), args, LDS_BYTES, stream);
    if (e != hipSuccess) fprintf(stderr, "cooperative launch failed: %s (grid %d)\n", hipGetErrorString(e), grid);
#else
    for (int ph = 0; ph < MK_RUN; ++ph) { p.ph_lo = ph; p.ph_hi = ph + 1; hipLaunchKernelGGL(mk_fwd, dim3(grid), dim3(NTHR), LDS_BYTES, stream, p); }
#endif
}
```

```cpp
#include <hip/hip_runtime.h>
#ifndef MK_REP_MASK
#define MK_REP_MASK 0
#endif
#ifndef MK_EXTRA_SYNC
#define MK_EXTRA_SYNC 0
#endif
#include <hip/hip_cooperative_groups.h>
#include <cstdio>
namespace cg = cooperative_groups;

#define LAS __attribute__((address_space(3)))
typedef unsigned short bf16_t;
typedef unsigned char uchar;
typedef short bf16x8 __attribute__((ext_vector_type(8)));
typedef float f32x4 __attribute__((ext_vector_type(4)));
typedef float f32x16 __attribute__((ext_vector_type(16)));
typedef unsigned u32x4 __attribute__((ext_vector_type(4)));
typedef unsigned u32x2 __attribute__((ext_vector_type(2)));

constexpr int D = 2048, NB = 2, SEQ = 4096, CTXL = 256, DFF = 5632, NMODC = 9 * D;
constexpr int NLAT = NB * SEQ, NCTX = NB * CTXL, NTOK = NLAT + NCTX;
constexpr int INW = 13344;
constexpr int LDP = 13568;
constexpr int OFF_K = 0, OFF_V = 1024, OFF_NK = 3072, OFF_NV = 4096, OFF_GF = 5120, OFF_GB = 5136, OFF_Q = 5376, OFF_R = 6400, OFF_NQ = 8448, OFF_M1 = 9472, OFF_M2 = 11520;
constexpr int NCTXCOLS = 5376;
constexpr int NCH = 68;
constexpr float EPS = 1e-6f, LOG2E = 1.4426950408889634f;
constexpr int LDS_BYTES = 147456;
constexpr int NTHR = 512;

constexpr size_t SZ_WGU = (size_t)2 * DFF * D * 2, SZ_WD = (size_t)D * DFF * 2;
constexpr size_t WS_WGU2 = 0, WS_WD2 = WS_WGU2 + SZ_WGU, WS_WGLAO = WS_WD2 + SZ_WD, WS_WNAO = WS_WGLAO + (size_t)D * D * 2, WS_WOUT = WS_WNAO + (size_t)D * 1024 * 2,
                 WS_MODP = WS_WOUT + (size_t)D * D * 2, WS_CTR = WS_MODP + (size_t)2 * 3 * NMODC * 4, WS_BAR = WS_CTR + 256, WS_R1 = WS_BAR + 16384 - 256;
constexpr size_t WS_WGU1 = WS_R1, WS_WD1 = WS_WGU1 + SZ_WGU, WS_R2 = WS_WD1 + SZ_WD;
constexpr size_t WS_OF = WS_R1, WS_OB = WS_R1 + (size_t)NLAT * D * 2;
constexpr size_t WS_WIN = WS_R2, WS_R4 = WS_WIN + (size_t)LDP * D * 2;
constexpr size_t SZ_QD = (size_t)NB * 4 * 2 * NCH * 64 * 256 * 2;
constexpr size_t WS_QD = WS_R2, WS_NVTL = WS_QD + SZ_QD, WS_NVTC = WS_NVTL + (size_t)NB * 16 * 64 * 64 * 64 * 2, WS_AG = WS_R2;
constexpr size_t WS_PROJ = WS_R4, WS_R5 = WS_PROJ + (size_t)NTOK * LDP * 2;
constexpr size_t WS_Y = WS_R4, WS_YC = WS_Y + (size_t)NLAT * D * 4;
constexpr size_t WS_H = WS_R5, WS_R8 = WS_H + (size_t)NTOK * DFF * 2;
constexpr size_t WS_KET = WS_R5, WS_VT = WS_KET + SZ_QD, WS_PM = WS_VT + (size_t)NB * 4 * NCH * 512 * 64 * 2, WS_DEC = WS_PM + (size_t)NB * 4 * 2 * NCH * 4096 * 2, WS_G2 = WS_R5;
constexpr size_t WS_A = WS_R8, WS_NAO = WS_R8, WS_MG = WS_R8, WS_END = WS_A + (size_t)NTOK * D * 2;
static_assert(WS_DEC + (size_t)NB * 4 * 2 * NCH * 256 * 4 <= WS_R8, "R5 overlay");
static_assert(WS_NVTC + (size_t)NB * 16 * 64 * 256 * 2 <= WS_R4, "R2 overlay");
static_assert(WS_OB + (size_t)NLAT * D * 2 <= WS_R2, "R1 overlay");

struct Params {
    const float *x, *c, *ctx, *c_ctx, *w_ada, *b_ada, *norm_g, *ffn_wg, *ffn_wu, *ffn_wd, *w_in, *gla_wg, *gla_bg, *gla_norm_g, *w_gla_o, *na_rpb, *w_na_o, *w_out;
    float* out; uchar* ws; int ph_lo, ph_hi;
};

typedef float f32x2_t __attribute__((ext_vector_type(2)));
typedef __bf16 bf16x2_t __attribute__((ext_vector_type(2)));
__device__ __forceinline__ unsigned cvt_pk_bf16(float lo, float hi) { const f32x2_t v = {lo, hi}; union { bf16x2_t b; unsigned u; } x; x.b = __builtin_convertvector(v, bf16x2_t); return x.u; }
__device__ __forceinline__ float bf2f(bf16_t b) { return __uint_as_float(((unsigned)b) << 16); }
__device__ __forceinline__ float bflo(unsigned u) { return __uint_as_float(u << 16); }
__device__ __forceinline__ float bfhi(unsigned u) { return __uint_as_float(u & 0xffff0000u); }
__device__ __forceinline__ float fast_rcp(float x) { return __builtin_amdgcn_rcpf(x); }
__device__ __forceinline__ float sigmoidf_(float x) { return fast_rcp(1.0f + __builtin_amdgcn_exp2f(x * -LOG2E)); }
__device__ __forceinline__ float siluf_(float x) { return x * sigmoidf_(x); }
__device__ __forceinline__ float wave_sum(float v) {
#pragma unroll
    for (int o = 32; o >= 1; o >>= 1) v += __shfl_xor(v, o);
    return v;
}
__device__ __forceinline__ bf16x8 as_bf16x8(u32x4 v) { union { u32x4 u; bf16x8 b; } x; x.u = v; return x.b; }


#define XB_TMO      128
#define XB_XCNT(j)  (256  + 64 * (j))
#define XB_XSUB(j)  (1280 + 64 * (j))
#define XB_XGEN(j)  (2304 + 64 * (j))
#define XB_TOP      3328
#define XB_TOPGEN   3392
#define XCD_BAR_WORDS 3456
#define XB_SPIN_CAP (1u << 20)
__device__ __forceinline__ unsigned xb_ld(unsigned* p)              { return __hip_atomic_load(p, __ATOMIC_RELAXED, __HIP_MEMORY_SCOPE_AGENT); }
__device__ __forceinline__ unsigned xb_add(unsigned* p, unsigned v) { return __hip_atomic_fetch_add(p, v, __ATOMIC_RELAXED, __HIP_MEMORY_SCOPE_AGENT); }
__device__ __forceinline__ unsigned xb_xcc_id() { return (unsigned)__builtin_amdgcn_s_getreg((3 << 11) | 20) & 0xFu; }
#define XB_SPIN(cond, bar) do { unsigned _sp = 0; while (cond) { __builtin_amdgcn_s_sleep(1); \
    if ((++_sp & 255u) == 0u) { if (xb_ld(&(bar)[XB_TMO])) break; if (_sp > XB_SPIN_CAP) { atomicAdd(&(bar)[XB_TMO], 1u); break; } } } } while (0)
struct XcdBarrier { unsigned* bar; unsigned x; volatile LAS unsigned* st; };
__device__ __forceinline__ XcdBarrier xcd_barrier_post(unsigned* bar, volatile LAS unsigned* st) {
    XcdBarrier b; b.bar = bar; b.x = xb_xcc_id(); b.st = st;
    if (threadIdx.x == 0) (void)xb_add(&bar[XB_XCNT(b.x)], 1u);
    return b;
}
__device__ __forceinline__ void xcd_barrier_complete(unsigned* bar, unsigned x, unsigned& nloc, unsigned& nx) {
    const unsigned G = gridDim.x * gridDim.y * gridDim.z;
    unsigned sum, cnt, mine, sp = 0u;
    for (;;) {
        sum = 0u; cnt = 0u; mine = 0u;
#pragma unroll
        for (unsigned j = 0; j < 16; ++j) { const unsigned c = xb_ld(&bar[XB_XCNT(j)]); sum += c; cnt += (c > 0u) ? 1u : 0u; mine = (j == x) ? c : mine; }
        if (sum == G) break;
        __builtin_amdgcn_s_sleep(1);
        if ((++sp & 255u) == 0u) { if (xb_ld(&bar[XB_TMO])) break; if (sp > XB_SPIN_CAP) { atomicAdd(&bar[XB_TMO], 1u); break; } }
    }
    nloc = mine > 0u ? mine : 1u; nx = cnt > 0u ? cnt : 1u;
}
__device__ __forceinline__ void xcd_barrier(const XcdBarrier& b) {
    asm volatile("s_waitcnt vmcnt(0)" ::: "memory");
    __syncthreads();
    if (threadIdx.x == 0) {
        unsigned* bar = b.bar;
        __builtin_amdgcn_s_waitcnt(0);
        unsigned nloc = b.st[0], nx = b.st[1];
        if (nloc == 0u) { xcd_barrier_complete(bar, b.x, nloc, nx); b.st[0] = nloc; b.st[1] = nx; }
        const unsigned old = xb_add(&bar[XB_XSUB(b.x)], 1u);
        const unsigned gen = old / nloc;
        if (old + 1u == (gen + 1u) * nloc) {
            __builtin_amdgcn_fence(__ATOMIC_RELEASE, "agent");
            asm volatile("s_waitcnt vmcnt(0)" ::: "memory");
            const unsigned og = xb_add(&bar[XB_TOP], 1u);
            const unsigned tg = og / nx;
            if (og + 1u == (tg + 1u) * nx) xb_add(&bar[XB_TOPGEN], 1u);
            else XB_SPIN(xb_ld(&bar[XB_TOPGEN]) == tg, bar);
            __builtin_amdgcn_fence(__ATOMIC_ACQUIRE, "agent");
            xb_add(&bar[XB_XGEN(b.x)], 1u);
            asm volatile("s_waitcnt vmcnt(0)" ::: "memory");
        } else {
            XB_SPIN(xb_ld(&bar[XB_XGEN(b.x)]) == gen, bar);
            __builtin_amdgcn_fence(__ATOMIC_ACQUIRE, "agent");
            asm volatile("s_waitcnt vmcnt(0)" ::: "memory");
        }
    }
    __syncthreads();
}

namespace pg8 {
constexpr int BM = 256, BK = 64, HALF = 128, HTB = HALF * BK * 2, NXCD = 8, WGM = 8;
__device__ __forceinline__ int lds_byte(int r, int c) { const int st = (r >> 4) * 2 + (c >> 5), rr = r & 15, cc = c & 31, ob = rr * 64 + cc * 2; return st * 1024 + (ob ^ (((ob >> 9) & 1) << 5)); }
__device__ __forceinline__ void stage_rc(int b, int& R, int& C) { const int st = b / 1024, sb = b % 1024, swz = sb ^ (((sb >> 9) & 1) << 5); R = (st >> 1) * 16 + swz / 64; C = (st & 1) * 32 + (swz % 64) / 2; }
__device__ __forceinline__ int perm32(int rho) { const int n = rho >> 4, i = rho & 15; return 8 * (i >> 2) + 4 * n + (i & 3); }
struct Unit { int pm, pn; };
struct Gemm { const bf16_t* A; const bf16_t* Bt; int M, N, K, lda, ldb; };
struct StaticOrder {
    int nM, nN, nwg, G, c;
    __device__ void init(int M, int N, int G_, int c_) { nM = M / BM; nN = N / BM; nwg = nM * nN; G = G_; c = c_; }
    __device__ bool next(int i, Unit& u) const {
        const long L = (long)i * G + c; if (L >= nwg) return false;
        int wgid = (int)L; { const int q = nwg / NXCD, r = nwg % NXCD, xcd = wgid % NXCD, off = wgid / NXCD; wgid = (xcd < r ? xcd * (q + 1) : r * (q + 1) + (xcd - r) * q) + off; }
        const int nig = WGM * nN, gid = wgid / nig, fm = gid * WGM, gsz = (nM - fm) < WGM ? (nM - fm) : WGM;
        u.pm = fm + ((wgid % nig) % gsz); u.pn = (wgid % nig) / gsz; return true;
    }
};
struct EpiF32 {
    static constexpr bool PERM = false;
    float* C; int ldc;
    __device__ __forceinline__ void operator()(const f32x4 (&acc)[2][2][4][2], const Unit& u, int wr, int wc, int fr, int fq) const {
        const int row0 = u.pm * BM + wr * 64 + fr, col0 = u.pn * BM + wc * 32 + 4 * fq;
#pragma unroll
        for (int ai = 0; ai < 2; ++ai)
#pragma unroll
            for (int m = 0; m < 4; ++m) { float* rowp = C + (size_t)(row0 + ai * HALF + m * 16) * ldc + col0;
#pragma unroll
                for (int bj = 0; bj < 2; ++bj)
#pragma unroll
                    for (int n = 0; n < 2; ++n) *(f32x4*)(rowp + bj * HALF + n * 16) = acc[ai][bj][m][n]; }
    }
};
struct EpiBf16 {
    static constexpr bool PERM = true;
    bf16_t* O; int ldc;
    __device__ __forceinline__ void operator()(const f32x4 (&acc)[2][2][4][2], const Unit& u, int wr, int wc, int fr, int fq) const {
        const int row0 = u.pm * BM + wr * 64 + fr, col0 = u.pn * BM + wc * 32 + 8 * fq;
#pragma unroll
        for (int ai = 0; ai < 2; ++ai)
#pragma unroll
            for (int m = 0; m < 4; ++m) { bf16_t* rowp = O + (size_t)(row0 + ai * HALF + m * 16) * ldc + col0;
#pragma unroll
                for (int bj = 0; bj < 2; ++bj) { const f32x4 v0 = acc[ai][bj][m][0], v1 = acc[ai][bj][m][1];
                    u32x4 w; w.x = cvt_pk_bf16(v0[0], v0[1]); w.y = cvt_pk_bf16(v0[2], v0[3]); w.z = cvt_pk_bf16(v1[0], v1[1]); w.w = cvt_pk_bf16(v1[2], v1[3]);
                    *(u32x4*)(rowp + bj * HALF) = w; } }
    }
};
struct EpiSiluMul {
    static constexpr bool PERM = true;
    bf16_t* O; int ldc;
    __device__ __forceinline__ void operator()(const f32x4 (&acc)[2][2][4][2], const Unit& u, int wr, int wc, int fr, int fq) const {
        const int row0 = u.pm * BM + wr * 64 + fr, col0 = u.pn * HALF + wc * 32 + 8 * fq;
#pragma unroll
        for (int ai = 0; ai < 2; ++ai)
#pragma unroll
            for (int m = 0; m < 4; ++m) { bf16_t* rowp = O + (size_t)(row0 + ai * HALF + m * 16) * ldc + col0;
                float h[8];
#pragma unroll
                for (int n = 0; n < 2; ++n)
#pragma unroll
                    for (int j = 0; j < 4; ++j) h[n * 4 + j] = siluf_(acc[ai][0][m][n][j]) * acc[ai][1][m][n][j];
                u32x4 w; w.x = cvt_pk_bf16(h[0], h[1]); w.y = cvt_pk_bf16(h[2], h[3]); w.z = cvt_pk_bf16(h[4], h[5]); w.w = cvt_pk_bf16(h[6], h[7]);
                *(u32x4*)rowp = w; }
    }
};
struct EpiGate2 {
    static constexpr bool PERM = false, AFTER_DRAIN = false;
    bf16_t* C; const bf16_t* gate;
    __device__ __forceinline__ void operator()(const f32x4 (&acc)[2][2][4][2], const Unit& u, int wr, int wc, int fr, int fq) const {
        const int row0 = u.pm * BM + wr * 64 + fr, col0 = u.pn * BM + wc * 32 + 4 * fq;
#pragma unroll
        for (int ai = 0; ai < 2; ++ai) {
            u32x2 gm[4][2][2];
#pragma unroll
            for (int m = 0; m < 4; ++m)
#pragma unroll
                for (int bj = 0; bj < 2; ++bj)
#pragma unroll
                    for (int n = 0; n < 2; ++n) gm[m][bj][n] = *(const u32x2*)(gate + (size_t)(row0 + ai * HALF + m * 16) * LDP + col0 + bj * HALF + n * 16);
#pragma unroll
            for (int m = 0; m < 4; ++m) { const size_t row = (size_t)(row0 + ai * HALF + m * 16);
#pragma unroll
                for (int bj = 0; bj < 2; ++bj)
#pragma unroll
                    for (int n = 0; n < 2; ++n) { const int col = col0 + bj * HALF + n * 16; const u32x2 g = gm[m][bj][n]; const f32x4 a = acc[ai][bj][m][n];
                        f32x4 o; o[0] = sigmoidf_(bflo(g.x)) * a[0]; o[1] = sigmoidf_(bfhi(g.x)) * a[1]; o[2] = sigmoidf_(bflo(g.y)) * a[2]; o[3] = sigmoidf_(bfhi(g.y)) * a[3];
                        u32x2 ow; ow.x = cvt_pk_bf16(o[0], o[1]); ow.y = cvt_pk_bf16(o[2], o[3]); *(u32x2*)(C + row * D + col) = ow; } }
        }
    }
};
struct EpiMerge {
    static constexpr bool PERM = true, AFTER_DRAIN = false;
    bf16_t* O; const bf16_t* gate; const bf16_t* G2;
    __device__ __forceinline__ void operator()(const f32x4 (&acc)[2][2][4][2], const Unit& u, int wr, int wc, int fr, int fq) const {
        const int row0 = u.pm * BM + wr * 64 + fr, col0 = u.pn * BM + wc * 32 + 8 * fq;
#pragma unroll
        for (int ai = 0; ai < 2; ++ai) {
            u32x4 gm[4][2], gq[4][2];
#pragma unroll
            for (int m = 0; m < 4; ++m)
#pragma unroll
                for (int bj = 0; bj < 2; ++bj) { const size_t row = (size_t)(row0 + ai * HALF + m * 16); const int col = col0 + bj * HALF;
                    gm[m][bj] = *(const u32x4*)(gate + row * LDP + col); gq[m][bj] = *(const u32x4*)(G2 + row * D + col); }
#pragma unroll
            for (int m = 0; m < 4; ++m) { const size_t row = (size_t)(row0 + ai * HALF + m * 16);
#pragma unroll
                for (int bj = 0; bj < 2; ++bj) { const int col = col0 + bj * HALF;
                    const u32x4 g = gm[m][bj], q = gq[m][bj];
                    const f32x4 v0 = acc[ai][bj][m][0], v1 = acc[ai][bj][m][1];
                    float o[8];
                    o[0] = sigmoidf_(bflo(g.x)) * v0[0] + bflo(q.x); o[1] = sigmoidf_(bfhi(g.x)) * v0[1] + bfhi(q.x); o[2] = sigmoidf_(bflo(g.y)) * v0[2] + bflo(q.y); o[3] = sigmoidf_(bfhi(g.y)) * v0[3] + bfhi(q.y);
                    o[4] = sigmoidf_(bflo(g.z)) * v1[0] + bflo(q.z); o[5] = sigmoidf_(bfhi(g.z)) * v1[1] + bfhi(q.z); o[6] = sigmoidf_(bflo(g.w)) * v1[2] + bflo(q.w); o[7] = sigmoidf_(bfhi(g.w)) * v1[3] + bfhi(q.w);
                    u32x4 w; w.x = cvt_pk_bf16(o[0], o[1]); w.y = cvt_pk_bf16(o[2], o[3]); w.z = cvt_pk_bf16(o[4], o[5]); w.w = cvt_pk_bf16(o[6], o[7]);
                    *(u32x4*)(O + row * D + col) = w; } }
        }
    }
};

template <class Epi, bool ALIGN_EPI = true>
__device__ __forceinline__ void gemm_phase(LAS uchar* lds, const Gemm g, const StaticOrder& S, const Epi& E) {
    const int tid = threadIdx.x, wid = __builtin_amdgcn_readfirstlane(tid >> 6), lane = tid & 63, wr = wid >> 2, wc = wid & 3, fr = lane & 15, fq = lane >> 4;
    const int K = g.K, nt = K / BK;
    unsigned voffA[2], voffB[2];
#pragma unroll
    for (int i = 0; i < 2; ++i) { int R, C; stage_rc(tid * 16 + i * 8192, R, C); const int Rb = Epi::PERM ? ((R & ~31) + perm32(R & 31)) : R;
        voffA[i] = (unsigned)(R * g.lda + C) * 2u; voffB[i] = (unsigned)(Rb * g.ldb + C) * 2u; }
    const size_t kstep = (size_t)(BK * 2);
    const size_t hstepA = (size_t)HALF * g.lda * 2, hstepB = (size_t)HALF * g.ldb * 2;
    const size_t tstepA = 2 * hstepA, tstepB = 2 * hstepB;
    const unsigned ldsw = (unsigned)wid * 1024u;
    const int aoff = lds_byte(wr * 64 + fr, fq * 8), boff = lds_byte(wc * 32 + fr, fq * 8);
#define PG8_SA(b, h) (((b) * 2 + (h)) * HTB)
#define PG8_SB(b, h) ((4 + (b) * 2 + (h)) * HTB)
#define PG8_STAGE(bufoff, gbase, voff) do { _Pragma("unroll") for (int _i = 0; _i < 2; ++_i) \
        __builtin_amdgcn_global_load_lds((const unsigned*)((const char*)(gbase) + (voff)[_i]), (LAS unsigned*)(lds + (bufoff) + ldsw + _i * 8192), 16, 0, 0); } while (0)
#define PG8_LDA(dst, b, h) do { _Pragma("unroll") for (int m = 0; m < 4; ++m) _Pragma("unroll") for (int k = 0; k < 2; ++k) dst[m][k] = *(const LAS bf16x8*)(lds + PG8_SA(b, h) + aoff + m * 2048 + k * 1024); } while (0)
#define PG8_LDB(dst, b, h) do { _Pragma("unroll") for (int n = 0; n < 2; ++n) _Pragma("unroll") for (int k = 0; k < 2; ++k) dst[n][k] = *(const LAS bf16x8*)(lds + PG8_SB(b, h) + boff + n * 2048 + k * 1024); } while (0)
#define PG8_MMA(ai, bj, At, Bt) do { __builtin_amdgcn_s_setprio(1); _Pragma("unroll") for (int m = 0; m < 4; ++m) _Pragma("unroll") for (int n = 0; n < 2; ++n) _Pragma("unroll") for (int k = 0; k < 2; ++k) \
        acc[ai][bj][m][n] = __builtin_amdgcn_mfma_f32_16x16x32_bf16(Bt[n][k], At[m][k], acc[ai][bj][m][n], 0, 0, 0); __builtin_amdgcn_s_setprio(0); } while (0)
#define PG8_WAIT_V(n) asm volatile("s_waitcnt vmcnt(" #n ")" ::: "memory")
#define PG8_WAIT_L(n) asm volatile("s_waitcnt lgkmcnt(" #n ")" ::: "memory")
#define PG8_BAR __builtin_amdgcn_s_barrier()
#define PG8_SCHED __builtin_amdgcn_sched_barrier(0)
    Unit cur, nxt; int ui = 0;
    if (!S.next(0, cur)) return;
    f32x4 acc[2][2][4][2];
#pragma unroll
    for (int a = 0; a < 2; ++a)
#pragma unroll
        for (int b = 0; b < 2; ++b)
#pragma unroll
            for (int m = 0; m < 4; ++m)
#pragma unroll
                for (int n = 0; n < 2; ++n) acc[a][b][m][n] = (f32x4){0.f, 0.f, 0.f, 0.f};
    bf16x8 At[4][2], B0[2][2], B1[2][2];
    const char* cA = (const char*)g.A + (size_t)cur.pm * tstepA; const char* cB = (const char*)g.Bt + (size_t)cur.pn * tstepB;
    PG8_STAGE(PG8_SB(0, 0), cB, voffB); PG8_STAGE(PG8_SB(0, 1), cB + hstepB, voffB); PG8_STAGE(PG8_SA(0, 0), cA, voffA); PG8_STAGE(PG8_SA(0, 1), cA + hstepA, voffA);
    if (wr == 1) PG8_BAR;
    PG8_WAIT_V(2); PG8_BAR;
    PG8_STAGE(PG8_SB(1, 0), cB + kstep, voffB); PG8_STAGE(PG8_SA(1, 0), cA + kstep, voffA); PG8_STAGE(PG8_SB(1, 1), cB + hstepB + kstep, voffB);
    PG8_WAIT_V(6); PG8_BAR;
    for (;;) {
        const bool has_next = S.next(ui + 1, nxt);
        const char* nA = has_next ? (const char*)g.A + (size_t)nxt.pm * tstepA : cA; const char* nB = has_next ? (const char*)g.Bt + (size_t)nxt.pn * tstepB : cB;
        for (int t = 0; t < nt; t += 2) {
            const bool last = (t == nt - 2);
            const char* a1 = cA + (size_t)(t + 1) * kstep;
            const char* a2 = last ? nA : cA + (size_t)(t + 2) * kstep; const char* b2 = last ? nB : cB + (size_t)(t + 2) * kstep;
            const char* a3 = a2 + kstep; const char* b3 = b2 + kstep;
            PG8_LDB(B0, 0, 0); PG8_LDB(B1, 0, 1); PG8_SCHED; PG8_LDA(At, 0, 0); PG8_STAGE(PG8_SA(1, 1), a1 + hstepA, voffA);
            PG8_WAIT_V(8); PG8_WAIT_L(0); PG8_BAR; PG8_MMA(0, 0, At, B0); PG8_MMA(0, 1, At, B1); PG8_BAR; PG8_SCHED;
            PG8_LDA(At, 0, 1); PG8_STAGE(PG8_SB(0, 0), b2, voffB); PG8_STAGE(PG8_SB(0, 1), b2 + hstepB, voffB); PG8_STAGE(PG8_SA(0, 0), a2, voffA);
            PG8_WAIT_V(8); PG8_WAIT_L(0); PG8_BAR; PG8_MMA(1, 0, At, B0); PG8_MMA(1, 1, At, B1); PG8_BAR; PG8_SCHED;
            PG8_LDB(B0, 1, 0); PG8_LDB(B1, 1, 1); PG8_SCHED; PG8_LDA(At, 1, 0); PG8_STAGE(PG8_SA(0, 1), a2 + hstepA, voffA);
            PG8_WAIT_V(8); PG8_WAIT_L(0); PG8_BAR; PG8_MMA(0, 0, At, B0); PG8_MMA(0, 1, At, B1); PG8_BAR; PG8_SCHED;
            PG8_LDA(At, 1, 1); PG8_STAGE(PG8_SB(1, 0), b3, voffB); PG8_STAGE(PG8_SB(1, 1), b3 + hstepB, voffB); PG8_STAGE(PG8_SA(1, 0), a3, voffA);
            PG8_WAIT_V(8); PG8_WAIT_L(0); PG8_BAR; PG8_MMA(1, 0, At, B0); PG8_MMA(1, 1, At, B1); PG8_BAR; PG8_SCHED;
        }
        if constexpr (ALIGN_EPI) { if (wr == 0) PG8_BAR; }
        E(acc, cur, wr, wc, fr, fq);
        if (!has_next) break;
#pragma unroll
        for (int a = 0; a < 2; ++a)
#pragma unroll
            for (int b = 0; b < 2; ++b)
#pragma unroll
                for (int m = 0; m < 4; ++m)
#pragma unroll
                    for (int n = 0; n < 2; ++n) acc[a][b][m][n] = (f32x4){0.f, 0.f, 0.f, 0.f};
        cur = nxt; cA = nA; cB = nB; ++ui;
        if constexpr (ALIGN_EPI) { if (wr == 1) PG8_BAR; }
    }
    PG8_WAIT_V(0);
    if constexpr (!ALIGN_EPI) { if (wr == 0) PG8_BAR; }
    PG8_BAR;
#undef PG8_SA
#undef PG8_SB
#undef PG8_STAGE
#undef PG8_LDA
#undef PG8_LDB
#undef PG8_MMA
#undef PG8_WAIT_V
#undef PG8_WAIT_L
#undef PG8_BAR
#undef PG8_SCHED
}
}

struct CvtJob { const float* src; int ld, K, col0, ntn, valid; bf16_t* dst; int row0, mul; };
__device__ __forceinline__ int cvt_job(const Params& p, int j, CvtJob& o) {
    uchar* ws = p.ws;
    const size_t FW = (size_t)D * DFF;
    switch (j) {
    case 0: o = {p.ffn_wg, DFF, D, 0, 44, 5632, (bf16_t*)(ws + WS_WGU1), 0, 256}; break;
    case 1: o = {p.ffn_wu, DFF, D, 0, 44, 5632, (bf16_t*)(ws + WS_WGU1), 128, 256}; break;
    case 2: o = {p.ffn_wd, D, DFF, 0, 16, 2048, (bf16_t*)(ws + WS_WD1), 0, 128}; break;
    case 3: o = {p.w_in, INW, D, 1024, 8, 1024, (bf16_t*)(ws + WS_WIN), OFF_K, 128}; break;
    case 4: o = {p.w_in, INW, D, 2048, 16, 2048, (bf16_t*)(ws + WS_WIN), OFF_V, 128}; break;
    case 5: o = {p.w_in, INW, D, 7200, 8, 1024, (bf16_t*)(ws + WS_WIN), OFF_NK, 128}; break;
    case 6: o = {p.w_in, INW, D, 8224, 8, 1024, (bf16_t*)(ws + WS_WIN), OFF_NV, 128}; break;
    case 7: o = {p.w_in, INW, D, 6144, 2, 32, (bf16_t*)(ws + WS_WIN), OFF_GF, 128}; break;
    case 8: o = {p.w_in, INW, D, 0, 8, 1024, (bf16_t*)(ws + WS_WIN), OFF_Q, 128}; break;
    case 9: o = {p.w_in, INW, D, 4096, 16, 2048, (bf16_t*)(ws + WS_WIN), OFF_R, 128}; break;
    case 10: o = {p.w_in, INW, D, 6176, 8, 1024, (bf16_t*)(ws + WS_WIN), OFF_NQ, 128}; break;
    case 11: o = {p.w_in, INW, D, 9248, 16, 2048, (bf16_t*)(ws + WS_WIN), OFF_M1, 128}; break;
    case 12: o = {p.w_in, INW, D, 11296, 16, 2048, (bf16_t*)(ws + WS_WIN), OFF_M2, 128}; break;
    case 13: o = {p.w_gla_o, D, D, 0, 16, 2048, (bf16_t*)(ws + WS_WGLAO), 0, 128}; break;
    case 14: o = {p.w_na_o, D, 1024, 0, 16, 2048, (bf16_t*)(ws + WS_WNAO), 0, 128}; break;
    case 15: o = {p.w_out, D, D, 0, 16, 2048, (bf16_t*)(ws + WS_WOUT), 0, 128}; break;
    case 16: o = {p.ffn_wg + FW, DFF, D, 0, 44, 5632, (bf16_t*)(ws + WS_WGU2), 0, 256}; break;
    case 17: o = {p.ffn_wu + FW, DFF, D, 0, 44, 5632, (bf16_t*)(ws + WS_WGU2), 128, 256}; break;
    default: o = {p.ffn_wd + FW, D, DFF, 0, 16, 2048, (bf16_t*)(ws + WS_WD2), 0, 128}; break;
    }
    return (o.K / 128) * o.ntn;
}
constexpr int N_CVT_JOBS = 19;
constexpr int N_CVT_TILES = 6 * 704 + 16 * 106 + 256 + 128 + 256;

struct CvtRegs { f32x4 a[4], b[4]; bf16_t* dst; int K; };
__device__ __forceinline__ void cvt_load(const CvtJob& J, int tl, CvtRegs& R) {
    const int tid = threadIdx.x;
    const int ktiles = J.K / 128, nt = tl / ktiles, kt = tl % ktiles;
    const int k0 = kt * 128, c0 = nt * 128;
    const int n4 = tid & 31, kp = tid >> 5;
    const int col = c0 + 4 * n4;
    R.dst = J.dst + (size_t)(J.row0 + nt * J.mul) * J.K + k0; R.K = J.K;
#pragma unroll
    for (int it = 0; it < 4; ++it) {
        const int kpair = kp + 16 * it;
        R.a[it] = (f32x4){0.f, 0.f, 0.f, 0.f}; R.b[it] = R.a[it];
        if (col < J.valid) { const float* sp = J.src + (size_t)(k0 + 2 * kpair) * J.ld + J.col0 + col; R.a[it] = __builtin_nontemporal_load((const f32x4*)sp); R.b[it] = __builtin_nontemporal_load((const f32x4*)(sp + J.ld)); }
    }
}
__device__ __forceinline__ void cvt_store(LAS uchar* lds, const CvtRegs& R) {
    LAS unsigned* T = (LAS unsigned*)lds;
    const int tid = threadIdx.x, n4 = tid & 31, kp = tid >> 5;
#pragma unroll
    for (int it = 0; it < 4; ++it) {
        const int kpair = kp + 16 * it;
#pragma unroll
        for (int i = 0; i < 4; ++i) T[(4 * n4 + i) * 65 + kpair] = cvt_pk_bf16(R.a[it][i], R.b[it][i]);
    }
    __syncthreads();
#pragma unroll
    for (int it = 0; it < 4; ++it) {
        const int ch = tid + 512 * it, n = ch >> 4, c16 = ch & 15;
        u32x4 v; v.x = T[n * 65 + 4 * c16]; v.y = T[n * 65 + 4 * c16 + 1]; v.z = T[n * 65 + 4 * c16 + 2]; v.w = T[n * 65 + 4 * c16 + 3];
        *(u32x4*)(R.dst + (size_t)n * R.K + 8 * c16) = v;
    }
    __syncthreads();
}

__device__ __forceinline__ void ada_item(LAS uchar* lds, const Params& p, int item) {
    LAS float* sv = (LAS float*)lds;
    LAS float* red = (LAS float*)(lds + 12288);
    const int tid = threadIdx.x, w = tid >> 6, lane = tid & 63;
    const int cb = item >> 1, kh = item & 1;
    for (int i = tid; i < 3 * 1024; i += NTHR) { const int s = i >> 10, k = kh * 1024 + (i & 1023); const float v = s < 2 ? p.c[s * D + k] : p.c_ctx[k]; sv[i] = siluf_(v); }
    __syncthreads();
    f32x4 a0 = (f32x4){0.f, 0.f, 0.f, 0.f}, a1 = a0, a2 = a0;
    const float* wp = p.w_ada + (size_t)(kh * 1024 + w * 128) * NMODC + cb * 256 + lane * 4;
#pragma unroll 8
    for (int k = 0; k < 128; ++k) {
        const f32x4 wv = *(const f32x4*)(wp + (size_t)k * NMODC);
        const int kk = w * 128 + k;
        a0 += sv[kk] * wv; a1 += sv[1024 + kk] * wv; a2 += sv[2048 + kk] * wv;
    }
    *(LAS f32x4*)(red + (w * 3 + 0) * 256 + lane * 4) = a0; *(LAS f32x4*)(red + (w * 3 + 1) * 256 + lane * 4) = a1; *(LAS f32x4*)(red + (w * 3 + 2) * 256 + lane * 4) = a2;
    __syncthreads();
    float* modp = (float*)(p.ws + WS_MODP);
    for (int i = tid; i < 768; i += NTHR) { const int s = i >> 8, col = i & 255; float v = 0.f;
#pragma unroll
        for (int ww = 0; ww < 8; ++ww) v += red[(ww * 3 + s) * 256 + col];
        const int gc = cb * 256 + col; if (kh == 0) v += p.b_ada[gc];
        modp[(size_t)(kh * 3 + s) * NMODC + gc] = v; }
    __syncthreads();
}

__device__ __forceinline__ void phase_prologue(LAS uchar* lds, const Params& p) {
    const int G = gridDim.x, bx = blockIdx.x;
    int t_lo, t_hi;
    if (G == 256) {
        if (bx < 144) { ada_item(lds, p, bx); t_lo = (bx * 89) / 4; t_hi = ((bx + 1) * 89) / 4; }
        else { t_lo = 3204 + (bx - 144) * 30; t_hi = t_lo + 30; }
        if (t_hi > N_CVT_TILES) t_hi = N_CVT_TILES;
    } else {
        for (int i = bx; i < 144; i += G) ada_item(lds, p, i);
        const int per = (N_CVT_TILES + G - 1) / G; t_lo = bx * per; t_hi = t_lo + per; if (t_hi > N_CVT_TILES) t_hi = N_CVT_TILES;
    }
    int j = 0, base = 0; CvtJob J; int cnt = cvt_job(p, 0, J);
    if (t_lo < t_hi) {
        CvtRegs cur, nxt;
        while (t_lo >= base + cnt) { base += cnt; ++j; cnt = cvt_job(p, j, J); }
        cvt_load(J, t_lo - base, cur);
        for (int t = t_lo; t < t_hi; ++t) {
            if (t + 1 < t_hi) { while (t + 1 >= base + cnt) { base += cnt; ++j; cnt = cvt_job(p, j, J); } cvt_load(J, t + 1 - base, nxt); }
            cvt_store(lds, cur);
            cur = nxt;
        }
    }
}

__device__ __forceinline__ f32x4 ld_mod(const float* modp, int s, int idx, int col) {
    const float* a = modp + (size_t)s * NMODC + idx * D + col; const float* b = a + (size_t)3 * NMODC;
    return *(const f32x4*)a + *(const f32x4*)b;
}
__device__ __forceinline__ void st_bf16x4(bf16_t* dst, f32x4 v) { u32x2 w; w.x = cvt_pk_bf16(v[0], v[1]); w.y = cvt_pk_bf16(v[2], v[3]); *(u32x2*)dst = w; }

__device__ __forceinline__ void phase_prenorm1(const Params& p) {
    const int w = threadIdx.x >> 6, lane = threadIdx.x & 63;
    const float* modp = (const float*)(p.ws + WS_MODP); bf16_t* A = (bf16_t*)(p.ws + WS_A);
    for (int item = blockIdx.x; item < NTOK / 8; item += gridDim.x) {
        const int row = item * 8 + w; const int s = row < NLAT ? row / SEQ : 2;
        const float* src = row < NLAT ? p.x + (size_t)row * D : p.ctx + (size_t)(row - NLAT) * D;
        f32x4 v[8]; float ss = 0.f;
#pragma unroll
        for (int j = 0; j < 8; ++j) { v[j] = *(const f32x4*)(src + j * 256 + lane * 4); ss += v[j][0] * v[j][0] + v[j][1] * v[j][1] + v[j][2] * v[j][2] + v[j][3] * v[j][3]; }
        ss = wave_sum(ss); const float rstd = rsqrtf(ss * (1.0f / D) + EPS);
#pragma unroll
        for (int j = 0; j < 8; ++j) { const int col = j * 256 + lane * 4;
            const f32x4 g = *(const f32x4*)(p.norm_g + 0 * D + col), sh = ld_mod(modp, s, 0, col), sc = ld_mod(modp, s, 1, col);
            st_bf16x4(A + (size_t)row * D + col, (v[j] * rstd * g) * (1.0f + sc) + sh); }
    }
}
template <int MODE>
__device__ __forceinline__ void phase_post(const Params& p) {
    const int w = threadIdx.x >> 6, lane = threadIdx.x & 63;
    const float* modp = (const float*)(p.ws + WS_MODP); bf16_t* A = (bf16_t*)(p.ws + WS_A);
    const bf16_t* Y = (const bf16_t*)(p.ws + WS_Y); const bf16_t* YC = (const bf16_t*)(p.ws + WS_YC);
    constexpr int NROWS = MODE == 0 ? NTOK : NLAT;
    constexpr int GI = MODE == 0 ? 2 : (MODE == 1 ? 5 : 8), GP = MODE == 0 ? 1 : (MODE == 1 ? 3 : 5), GN = MODE == 0 ? 2 : 4, SI = MODE == 0 ? 3 : 6;
    constexpr float WRES = MODE == 1 ? 1.0f : 0.5f;
    for (int item = blockIdx.x; item < NROWS / 8; item += gridDim.x) {
        const int row = item * 8 + w; const int s = row < NLAT ? row / SEQ : 2;
        const float* xin = MODE == 0 ? (row < NLAT ? p.x + (size_t)row * D : p.ctx + (size_t)(row - NLAT) * D) : p.out + (size_t)row * D;
        f32x4 y[8], xv8[8]; float ss = 0.f;
#pragma unroll
        for (int j = 0; j < 8; ++j) xv8[j] = *(const f32x4*)(xin + j * 256 + lane * 4);
#pragma unroll
        for (int j = 0; j < 8; ++j) { const int col = j * 256 + lane * 4;
            if (MODE == 0 && row >= NLAT) { const bf16_t* yc = YC + (size_t)(row - NLAT) * D + col; f32x4 a = (f32x4){0.f, 0.f, 0.f, 0.f};
#pragma unroll
                for (int sp = 0; sp < 4; ++sp) { const u32x2 t = *(const u32x2*)(yc + (size_t)sp * NCTX * D); a += (f32x4){bflo(t.x), bfhi(t.x), bflo(t.y), bfhi(t.y)}; }
                y[j] = a; }
            else { const u32x2 t = *(const u32x2*)(Y + (size_t)row * D + col); y[j] = (f32x4){bflo(t.x), bfhi(t.x), bflo(t.y), bfhi(t.y)}; }
            ss += y[j][0] * y[j][0] + y[j][1] * y[j][1] + y[j][2] * y[j][2] + y[j][3] * y[j][3]; }
        ss = wave_sum(ss); const float rstd = rsqrtf(ss * (1.0f / D) + EPS);
        float ss2 = 0.f;
#pragma unroll
        for (int j = 0; j < 8; ++j) { const int col = j * 256 + lane * 4;
            const f32x4 g = *(const f32x4*)(p.norm_g + GP * D + col), gt = ld_mod(modp, s, GI, col), xv = xv8[j];
            const f32x4 x1 = xv + WRES * gt * (y[j] * rstd * g);
            y[j] = x1; ss2 += x1[0] * x1[0] + x1[1] * x1[1] + x1[2] * x1[2] + x1[3] * x1[3];
            if (row < NLAT) *(f32x4*)(p.out + (size_t)row * D + col) = x1; }
        if (MODE == 2) continue;
        ss2 = wave_sum(ss2); const float rstd2 = rsqrtf(ss2 * (1.0f / D) + EPS);
#pragma unroll
        for (int j = 0; j < 8; ++j) { const int col = j * 256 + lane * 4;
            const f32x4 g = *(const f32x4*)(p.norm_g + GN * D + col), sh = ld_mod(modp, s, SI, col), sc = ld_mod(modp, s, SI + 1, col);
            st_bf16x4(A + (size_t)row * D + col, (y[j] * rstd2 * g) * (1.0f + sc) + sh); }
    }
}

constexpr int PREP_PITCH = 264;
constexpr int PREP_TILE = 64 * PREP_PITCH * 2;
__device__ __forceinline__ size_t gla_idx(int b, int h, int dir, int cid) { return (size_t)(((b * 4 + h) * 2 + dir) * NCH + cid); }

__device__ __forceinline__ void gla_prep_item(LAS uchar* lds, const Params& p, int item) {
    const int tid = threadIdx.x, wv = tid >> 6, lane = tid & 63;
    int h, cid, b;
    if (item < NB * 64 * 4) { h = item & 3; const int bc = item >> 2; cid = 4 + (bc & 63); b = bc >> 6; }
    else { const int it2 = item - NB * 64 * 4; h = it2 & 3; const int bc = it2 >> 2; cid = bc & 3; b = bc >> 2; }
    const bool lat = cid >= 4;
    const int rowbase = lat ? b * SEQ + (cid - 4) * 64 : NLAT + b * CTXL + cid * 64;
    const bf16_t* PROJ = (const bf16_t*)(p.ws + WS_PROJ);
    LAS float* Gs = (LAS float*)lds;
    {
        const int i = tid >> 3, c4 = (tid & 7) * 4;
        const u32x2 g = *(const u32x2*)(PROJ + (size_t)(rowbase + i) * LDP + OFF_GF + c4);
        *(LAS f32x4*)(Gs + i * 32 + c4) = (f32x4){bflo(g.x), bfhi(g.x), bflo(g.y), bfhi(g.y)};
    }
    __syncthreads();
    const int wvu = __builtin_amdgcn_readfirstlane(tid >> 6);
    const int d = tid & 255, dir = wvu >> 2;
    float wg[16];
#pragma unroll
    for (int r = 0; r < 16; ++r) wg[r] = p.gla_wg[(size_t)(dir * 16 + r) * 1024 + h * 256 + d] * LOG2E;
    const float bg = p.gla_bg[dir * 1024 + h * 256 + d] * LOG2E;
    const int axis = (wvu >> 1) & 1, fi = d & 63; const bool first = (wvu & 1) == 0;
    const int dpart = first ? d + 64 : d - 64;
    const float freq = __expf(-(float)fi * (9.210340371976184f / 64.0f));
    const float ang_row = (float)(cid - 4) * freq;
    float cs_row, sn_row; __sincosf(ang_row, &sn_row, &cs_row);
    if (!first) sn_row = -sn_row; sn_row = -sn_row;
    const float freq_rev = (first ? -freq : freq) * 0.15915494309189535f;
    bf16_t* QD = (bf16_t*)(p.ws + WS_QD) + gla_idx(b, h, dir, cid) * (64 * 256);
    bf16_t* KET = (bf16_t*)(p.ws + WS_KET) + gla_idx(b, h, dir, cid) * (256 * 64);
    LAS bf16_t* QDs = (LAS bf16_t*)(lds + 8192 + dir * 2 * PREP_TILE);
    LAS bf16_t* KIs = (LAS bf16_t*)(lds + 8192 + dir * 2 * PREP_TILE + PREP_TILE);
    float cum = 0.f;
    unsigned short rk[8], rkp[8], rq[8], rqp[8], nk_[8], nkp[8], nq_[8], nqp[8];
    const bf16_t* pbase = PROJ + (size_t)rowbase * LDP + h * 256;
    const unsigned ok_ = OFF_K + d, okp_ = OFF_K + dpart, oq_ = OFF_Q + d, oqp_ = OFF_Q + dpart;
#define PREP_LOAD(dk_, dkp_, dq_, dqp_, n8_) do { _Pragma("unroll") for (int jj = 0; jj < 8; ++jj) { const int n_ = (n8_) * 8 + jj, i_ = dir ? 63 - n_ : n_; \
        const unsigned to_ = (unsigned)i_ * (unsigned)LDP; dk_[jj] = pbase[to_ + ok_]; \
        if (lat) { dkp_[jj] = pbase[to_ + okp_]; dq_[jj] = pbase[to_ + oq_]; dqp_[jj] = pbase[to_ + oqp_]; } else { dkp_[jj] = 0; dq_[jj] = 0; dqp_[jj] = 0; } } } while (0)
    PREP_LOAD(rk, rkp, rq, rqp, 0);
    for (int n8 = 0; n8 < 8; ++n8) {
        if (n8 < 7) PREP_LOAD(nk_, nkp, nq_, nqp, n8 + 1);
        float ke[8];
#pragma unroll
        for (int jj = 0; jj < 8; ++jj) {
            const int n = n8 * 8 + jj, i = dir ? 63 - n : n;
            const LAS f32x4* gp = (const LAS f32x4*)(Gs + i * 32 + dir * 16);
            float z = bg;
#pragma unroll
            for (int q4 = 0; q4 < 4; ++q4) { const f32x4 gv = gp[q4]; z += gv[0] * wg[q4 * 4] + gv[1] * wg[q4 * 4 + 1] + gv[2] * wg[q4 * 4 + 2] + gv[3] * wg[q4 * 4 + 3]; }
            cum += (fminf(z, 0.f) - __builtin_amdgcn_logf(1.0f + __builtin_amdgcn_exp2f(-fabsf(z)))) * (1.0f / 16.0f);
            float kv = bf2f(rk[jj]);
            if (lat) {
                float cs, sn;
                if (axis == 0) { cs = cs_row; sn = sn_row; } else { const float a = (float)i * freq_rev; cs = __builtin_amdgcn_cosf(a); sn = __builtin_amdgcn_sinf(a); }
                const float kp2 = bf2f(rkp[jj]);
                kv = kv * cs + kp2 * sn;
                float qv = bf2f(rq[jj]); const float qp2 = bf2f(rqp[jj]);
                qv = (qv * cs + qp2 * sn) * 0.0625f;
                const float qd = qv * __builtin_amdgcn_exp2f(cum);
                const bf16_t qb = (bf16_t)(cvt_pk_bf16(qd, 0.f) & 0xffffu);
                QD[(size_t)i * 256 + d] = qb; QDs[i * PREP_PITCH + d] = qb;
            }
            const float ki = kv * __builtin_amdgcn_exp2f(-cum);
            if (lat) KIs[i * PREP_PITCH + d] = (bf16_t)(cvt_pk_bf16(ki, 0.f) & 0xffffu);
            ke[jj] = ki;
        }
        u32x4 o;
        if (dir == 0) { o.x = cvt_pk_bf16(ke[0], ke[1]); o.y = cvt_pk_bf16(ke[2], ke[3]); o.z = cvt_pk_bf16(ke[4], ke[5]); o.w = cvt_pk_bf16(ke[6], ke[7]); *(u32x4*)(KET + (size_t)d * 64 + n8 * 8) = o; }
        else { o.x = cvt_pk_bf16(ke[7], ke[6]); o.y = cvt_pk_bf16(ke[5], ke[4]); o.z = cvt_pk_bf16(ke[3], ke[2]); o.w = cvt_pk_bf16(ke[1], ke[0]); *(u32x4*)(KET + (size_t)d * 64 + (7 - n8) * 8) = o; }
#pragma unroll
        for (int jj = 0; jj < 8; ++jj) { rk[jj] = nk_[jj]; rkp[jj] = nkp[jj]; rq[jj] = nq_[jj]; rqp[jj] = nqp[jj]; }
    }
#undef PREP_LOAD
    ((float*)(p.ws + WS_DEC))[gla_idx(b, h, dir, cid) * 256 + d] = __builtin_amdgcn_exp2f(cum);
    {
        bf16_t* VT = (bf16_t*)(p.ws + WS_VT) + (size_t)((b * 4 + h) * NCH + cid) * (512 * 64);
        const bf16_t* vsrc = PROJ + (size_t)rowbase * LDP + OFF_V + h * 512 + tid;
        unsigned short e[64];
#pragma unroll
        for (int t = 0; t < 64; ++t) e[t] = vsrc[(size_t)t * LDP];
#pragma unroll
        for (int n8 = 0; n8 < 8; ++n8) {
            u32x4 o; o.x = e[n8 * 8] | ((unsigned)e[n8 * 8 + 1] << 16); o.y = e[n8 * 8 + 2] | ((unsigned)e[n8 * 8 + 3] << 16); o.z = e[n8 * 8 + 4] | ((unsigned)e[n8 * 8 + 5] << 16); o.w = e[n8 * 8 + 6] | ((unsigned)e[n8 * 8 + 7] << 16);
            *(u32x4*)(VT + (size_t)tid * 64 + n8 * 8) = o;
        }
    }
    __syncthreads();
    if (lat) {
        const int wdir = wv >> 2, ib = wv & 3, fr = lane & 15, g = lane >> 4;
        const LAS bf16_t* Qs = (const LAS bf16_t*)(lds + 8192 + wdir * 2 * PREP_TILE);
        const LAS bf16_t* Ks = (const LAS bf16_t*)(lds + 8192 + wdir * 2 * PREP_TILE + PREP_TILE);
        f32x4 acc[4];
#pragma unroll
        for (int nb = 0; nb < 4; ++nb) acc[nb] = (f32x4){0.f, 0.f, 0.f, 0.f};
        bf16x8 qf[8];
#pragma unroll
        for (int kk = 0; kk < 8; ++kk) qf[kk] = *(const LAS bf16x8*)(Qs + (16 * ib + fr) * PREP_PITCH + 32 * kk + 8 * g);
#pragma unroll
        for (int nb = 0; nb < 4; ++nb) {
            bf16x8 kf[8];
#pragma unroll
            for (int kk = 0; kk < 8; ++kk) kf[kk] = *(const LAS bf16x8*)(Ks + (16 * nb + fr) * PREP_PITCH + 32 * kk + 8 * g);
            __builtin_amdgcn_sched_barrier(0);
#pragma unroll
            for (int kk = 0; kk < 8; ++kk) acc[nb] = __builtin_amdgcn_mfma_f32_16x16x32_bf16(kf[kk], qf[kk], acc[nb], 0, 0, 0);
        }
        bf16_t* PM = (bf16_t*)(p.ws + WS_PM) + gla_idx(b, h, wdir, cid) * 4096;
        const int i = 16 * ib + fr;
#pragma unroll
        for (int nb = 0; nb < 4; ++nb) {
            float v[4];
#pragma unroll
            for (int r = 0; r < 4; ++r) { const int j = 16 * nb + 4 * g + r; const bool keep = wdir ? (j >= i) : (j <= i); v[r] = keep ? acc[nb][r] : 0.f; }
            u32x2 o; o.x = cvt_pk_bf16(v[0], v[1]); o.y = cvt_pk_bf16(v[2], v[3]);
            *(u32x2*)(PM + (size_t)i * 64 + 16 * nb + 4 * g) = o;
        }
    }
    __syncthreads();
}
__device__ __forceinline__ void na_vt_item(const Params& p, int item) {
    const int tid = threadIdx.x; const int blk = item % NCH, b = item / NCH; const bool lat = blk >= 4;
    const int rowbase = lat ? b * SEQ + (blk - 4) * 64 : NLAT + b * CTXL + blk * 64;
    const bf16_t* PROJ = (const bf16_t*)(p.ws + WS_PROJ);
    const int c = 2 * tid, h = c >> 6, dv = c & 63;
    const bf16_t* src = PROJ + (size_t)rowbase * LDP + OFF_NV + c;
    bf16_t* dst; int pitch;
    if (lat) { dst = (bf16_t*)(p.ws + WS_NVTL) + ((size_t)((b * 16 + h) * 64 + (blk - 4)) * 64 + dv) * 64; pitch = 64; }
    else { dst = (bf16_t*)(p.ws + WS_NVTC) + ((size_t)(b * 16 + h) * 64 + dv) * 256 + blk * 64; pitch = 256; }
    unsigned e[64];
#pragma unroll
    for (int t = 0; t < 64; ++t) e[t] = *(const unsigned*)(src + (size_t)t * LDP);
#pragma unroll
    for (int n8 = 0; n8 < 8; ++n8) {
        const unsigned* q = e + n8 * 8;
        u32x4 lo, hi;
        lo.x = (q[0] & 0xffffu) | (q[1] << 16); lo.y = (q[2] & 0xffffu) | (q[3] << 16); lo.z = (q[4] & 0xffffu) | (q[5] << 16); lo.w = (q[6] & 0xffffu) | (q[7] << 16);
        hi.x = (q[0] >> 16) | (q[1] & 0xffff0000u); hi.y = (q[2] >> 16) | (q[3] & 0xffff0000u); hi.z = (q[4] >> 16) | (q[5] & 0xffff0000u); hi.w = (q[6] >> 16) | (q[7] & 0xffff0000u);
        *(u32x4*)(dst + n8 * 8) = lo; *(u32x4*)(dst + pitch + n8 * 8) = hi;
    }
}

constexpr int ST_PITCH = 264, VT_PITCH = 72;
constexpr int SC_ST = 0, SC_QD = 64 * ST_PITCH * 2, SC_VT = 2 * 64 * ST_PITCH * 2, SC_PM = SC_VT + 64 * VT_PITCH * 2, SC_KT = SC_PM + 64 * VT_PITCH * 2, SC_DC = SC_KT + 256 * VT_PITCH * 2;
__device__ __forceinline__ int scan_cid(int n, int dir) { return n < 4 ? (dir ? 3 - n : n) : (dir ? 67 - (n - 4) : n); }

__device__ __forceinline__ void gla_scan_task(LAS uchar* lds, const Params& p, int task) {
    const int tid = threadIdx.x, w = __builtin_amdgcn_readfirstlane(tid >> 6), lane = tid & 63;
    const int xcd = task & 7, jj = task >> 3, combo = xcd * 2 + (jj >> 3), sl = jj & 7;
    const int b = combo >> 3, h = (combo >> 1) & 3, dir = combo & 1, dv0 = sl * 64;
    const int l32 = lane & 31, hf = lane >> 5;
    const bool isU = w >= 4; const int u = w & 3;
    const int dvb = u >> 1, ibk = u & 1;
    LAS bf16_t* ST = (LAS bf16_t*)(lds + SC_ST); LAS bf16_t* QDs = (LAS bf16_t*)(lds + SC_QD); LAS bf16_t* VTs = (LAS bf16_t*)(lds + SC_VT); LAS bf16_t* PMs = (LAS bf16_t*)(lds + SC_PM);
    LAS bf16_t* KTs = (LAS bf16_t*)(lds + SC_KT); LAS float* DCs = (LAS float*)(lds + SC_DC);
    for (int i = tid; i < 64 * ST_PITCH / 2; i += NTHR) ((LAS unsigned*)lds)[i] = 0u;
    const bf16_t* QDb = (const bf16_t*)(p.ws + WS_QD); const bf16_t* KITb = (const bf16_t*)(p.ws + WS_KET); const bf16_t* PMb = (const bf16_t*)(p.ws + WS_PM);
    const float* DECb = (const float*)(p.ws + WS_DEC); const bf16_t* VTb = (const bf16_t*)(p.ws + WS_VT);
    bf16_t* Ob = (bf16_t*)(p.ws + (dir ? WS_OB : WS_OF));
    f32x16 S00, S01, S10, S11;
#pragma unroll
    for (int i = 0; i < 16; ++i) { S00[i] = 0.f; S01[i] = 0.f; S10[i] = 0.f; S11[i] = 0.f; }
    const int vrow = tid >> 3, vc = (tid & 7) * 8;
    u32x4 qd_r[4], vt_r, pm_r, kt_r[4]; f32x4 dc_r;
#define SC_FETCH(n_) do { const int cid_ = scan_cid((n_), dir); const size_t gi_ = gla_idx(b, h, dir, cid_); \
        vt_r = *(const u32x4*)(VTb + (size_t)((b * 4 + h) * NCH + cid_) * (512 * 64) + (size_t)(dv0 + vrow) * 64 + vc); \
        _Pragma("unroll") for (int k4 = 0; k4 < 4; ++k4) kt_r[k4] = *(const u32x4*)(KITb + gi_ * (256 * 64) + (size_t)(tid + 512 * k4) * 8); \
        if (tid < 64) dc_r = *(const f32x4*)(DECb + gi_ * 256 + 4 * tid); \
        if ((n_) >= 4) { pm_r = *(const u32x4*)(PMb + gi_ * 4096 + vrow * 64 + vc); \
            _Pragma("unroll") for (int k4 = 0; k4 < 4; ++k4) { const int ch_ = tid + 512 * k4; qd_r[k4] = *(const u32x4*)(QDb + gi_ * (64 * 256) + (size_t)(ch_ >> 5) * 256 + (ch_ & 31) * 8); } } } while (0)
#define SC_COMMIT(n_) do { *(LAS u32x4*)(VTs + vrow * VT_PITCH + vc) = vt_r; \
        _Pragma("unroll") for (int k4 = 0; k4 < 4; ++k4) { const int ch_ = tid + 512 * k4; *(LAS u32x4*)(KTs + (ch_ >> 3) * VT_PITCH + (ch_ & 7) * 8) = kt_r[k4]; } \
        if (tid < 64) *(LAS f32x4*)(DCs + 4 * tid) = dc_r; \
        if ((n_) >= 4) { *(LAS u32x4*)(PMs + vrow * VT_PITCH + vc) = pm_r; \
            _Pragma("unroll") for (int k4 = 0; k4 < 4; ++k4) { const int ch_ = tid + 512 * k4; *(LAS u32x4*)(QDs + (ch_ >> 5) * ST_PITCH + (ch_ & 31) * 8) = qd_r[k4]; } } } while (0)
    SC_FETCH(0);
    SC_COMMIT(0);
    __syncthreads();
    for (int n = 0; n < NCH; ++n) {
        if (n + 1 < NCH) SC_FETCH(n + 1);
        if (isU) {
            f32x4 dec[2][4]; bf16x8 kit[8];
#pragma unroll
            for (int rb = 0; rb < 2; ++rb)
#pragma unroll
                for (int j4 = 0; j4 < 4; ++j4) dec[rb][j4] = *(const LAS f32x4*)(DCs + 64 * u + 32 * rb + 8 * j4 + 4 * hf);
#pragma unroll
            for (int rb = 0; rb < 2; ++rb)
#pragma unroll
                for (int kk = 0; kk < 4; ++kk) kit[rb * 4 + kk] = *(const LAS bf16x8*)(KTs + (64 * u + 32 * rb + l32) * VT_PITCH + 16 * kk + 8 * hf);
            const LAS bf16_t* vb0 = VTs + l32 * VT_PITCH + 8 * hf; const LAS bf16_t* vb1 = vb0 + 32 * VT_PITCH;
            bf16x8 ua[4], ub[4];
#pragma unroll
            for (int kk = 0; kk < 4; ++kk) { ua[kk] = *(const LAS bf16x8*)(vb0 + 16 * kk); ub[kk] = *(const LAS bf16x8*)(vb1 + 16 * kk); }
#pragma unroll
            for (int kk = 0; kk < 4; ++kk) {
                S00 = __builtin_amdgcn_mfma_f32_32x32x16_bf16(kit[kk], ua[kk], S00, 0, 0, 0);
                S01 = __builtin_amdgcn_mfma_f32_32x32x16_bf16(kit[kk], ub[kk], S01, 0, 0, 0);
                S10 = __builtin_amdgcn_mfma_f32_32x32x16_bf16(kit[4 + kk], ua[kk], S10, 0, 0, 0);
                S11 = __builtin_amdgcn_mfma_f32_32x32x16_bf16(kit[4 + kk], ub[kk], S11, 0, 0, 0); }
#pragma unroll
            for (int j4 = 0; j4 < 4; ++j4)
#pragma unroll
                for (int r = 0; r < 4; ++r) { S00[j4 * 4 + r] *= dec[0][j4][r]; S01[j4 * 4 + r] *= dec[0][j4][r]; S10[j4 * 4 + r] *= dec[1][j4][r]; S11[j4 * 4 + r] *= dec[1][j4][r]; }
        } else if (n >= 4) {
            const int cid = scan_cid(n, dir);
            f32x16 o;
#pragma unroll
            for (int i = 0; i < 16; ++i) o[i] = 0.f;
            const LAS bf16_t* sa = ST + (32 * dvb + l32) * ST_PITCH + 8 * hf; const LAS bf16_t* qb_ = QDs + (32 * ibk + l32) * ST_PITCH + 8 * hf;
            const LAS bf16_t* va = VTs + (32 * dvb + l32) * VT_PITCH + 8 * hf; const LAS bf16_t* pb = PMs + (32 * ibk + l32) * VT_PITCH + 8 * hf;
#pragma unroll
            for (int half = 0; half < 2; ++half) {
                bf16x8 fa[8], fb[8];
#pragma unroll
                for (int kk = 0; kk < 8; ++kk) { fa[kk] = *(const LAS bf16x8*)(sa + 16 * (half * 8 + kk)); fb[kk] = *(const LAS bf16x8*)(qb_ + 16 * (half * 8 + kk)); }
#pragma unroll
                for (int kk = 0; kk < 8; ++kk) o = __builtin_amdgcn_mfma_f32_32x32x16_bf16(fa[kk], fb[kk], o, 0, 0, 0);
            }
            {
                bf16x8 fa[4], fb[4];
#pragma unroll
                for (int q = 0; q < 4; ++q) { fa[q] = *(const LAS bf16x8*)(va + 16 * q); fb[q] = *(const LAS bf16x8*)(pb + 16 * q); }
#pragma unroll
                for (int q = 0; q < 4; ++q) o = __builtin_amdgcn_mfma_f32_32x32x16_bf16(fa[q], fb[q], o, 0, 0, 0);
            }
            bf16_t* op = Ob + (size_t)(b * SEQ + (cid - 4) * 64 + 32 * ibk + l32) * D + h * 512 + dv0 + 32 * dvb + 4 * hf;
#pragma unroll
            for (int j4 = 0; j4 < 4; ++j4) { u32x2 ov; ov.x = cvt_pk_bf16(o[j4 * 4], o[j4 * 4 + 1]); ov.y = cvt_pk_bf16(o[j4 * 4 + 2], o[j4 * 4 + 3]); *(u32x2*)(op + 8 * j4) = ov; }
        }
        __syncthreads();
        if (isU) {
            LAS bf16_t* stw = ST + l32 * ST_PITCH + 64 * u + 4 * hf;
#pragma unroll
            for (int j4 = 0; j4 < 4; ++j4) { u32x2 sv;
                sv.x = cvt_pk_bf16(S00[j4 * 4], S00[j4 * 4 + 1]); sv.y = cvt_pk_bf16(S00[j4 * 4 + 2], S00[j4 * 4 + 3]); *(LAS u32x2*)(stw + 8 * j4) = sv;
                sv.x = cvt_pk_bf16(S01[j4 * 4], S01[j4 * 4 + 1]); sv.y = cvt_pk_bf16(S01[j4 * 4 + 2], S01[j4 * 4 + 3]); *(LAS u32x2*)(stw + 32 * ST_PITCH + 8 * j4) = sv;
                sv.x = cvt_pk_bf16(S10[j4 * 4], S10[j4 * 4 + 1]); sv.y = cvt_pk_bf16(S10[j4 * 4 + 2], S10[j4 * 4 + 3]); *(LAS u32x2*)(stw + 32 + 8 * j4) = sv;
                sv.x = cvt_pk_bf16(S11[j4 * 4], S11[j4 * 4 + 1]); sv.y = cvt_pk_bf16(S11[j4 * 4 + 2], S11[j4 * 4 + 3]); *(LAS u32x2*)(stw + 32 * ST_PITCH + 32 + 8 * j4) = sv; }
        }
        if (n + 1 < NCH) SC_COMMIT(n + 1);
        __syncthreads();
    }
#undef SC_FETCH
#undef SC_COMMIT
}

constexpr int NA_KV = 24576, NA_KP = 72, NA_CP = 264;
constexpr int NA_QW = 20480;
__device__ __forceinline__ void na_item(LAS uchar* lds, const Params& p, int it) {
    const int tid = threadIdx.x, w = tid >> 6, lane = tid & 63, fr = lane & 15, g = lane >> 4;
    const int r = it & 63, h = (it >> 6) & 15, b = it >> 10;
    const int qb = w & 3, kind = w >> 2;
    LAS float* rpbS = (LAS float*)lds;
    LAS float* CBm = (LAS float*)(lds + 2048);
    LAS float* CBl = (LAS float*)(lds + 2048 + 256);
    LAS float* CBo = (LAS float*)(lds + 4096);
    LAS bf16_t* KL = (LAS bf16_t*)(lds + NA_KV);
    LAS bf16_t* KC = (LAS bf16_t*)(lds + NA_KV + 512 * NA_KP * 2);
    const bf16_t* PROJ = (const bf16_t*)(p.ws + WS_PROJ);
    const int rs = min(max(r - 4, 0), 56);
    u32x4 st[12];
    {
        const int c8 = (tid & 7) * 8;
#pragma unroll
        for (int k = 0; k < 8; ++k) { const int key = (tid >> 3) + 64 * k; st[k] = *(const u32x4*)(PROJ + (size_t)(b * SEQ + (rs + k) * 64 + (tid >> 3)) * LDP + OFF_NK + h * 64 + c8); (void)key; }
#pragma unroll
        for (int k = 0; k < 4; ++k) st[8 + k] = *(const u32x4*)(PROJ + (size_t)(NLAT + b * CTXL + (tid >> 3) + 64 * k) * LDP + OFF_NK + h * 64 + c8);
    }
    const int c0 = qb == 0 ? 0 : (qb == 1 ? 8 : (qb == 2 ? 24 : 32));
    const int j = 16 * qb + fr;
    const int cs = min(max(j - 8, 0), 48);
    const bf16_t* qrow = PROJ + (size_t)(b * SEQ + r * 64 + j) * LDP + OFF_NQ + h * 64 + 8 * g;
    const bf16x8 q0 = *(const bf16x8*)qrow, q1 = *(const bf16x8*)(qrow + 32);
    if (tid < 480) { const int rw = tid >> 5, cc = tid & 31; rpbS[tid] = cc < 31 ? p.na_rpb[h * 465 + rw * 31 + cc] * LOG2E : -1e30f; }
    {
        const int c8 = (tid & 7) * 8, kr = tid >> 3;
#pragma unroll
        for (int k = 0; k < 8; ++k) *(LAS u32x4*)(KL + (kr + 64 * k) * NA_KP + c8) = st[k];
#pragma unroll
        for (int k = 0; k < 4; ++k) *(LAS u32x4*)(KC + (kr + 64 * k) * NA_KP + c8) = st[8 + k];
    }
    __syncthreads();
    {
        const bf16_t* vl = (const bf16_t*)(p.ws + WS_NVTL) + (size_t)((b * 16 + h) * 64 + rs) * (64 * 64);
#pragma unroll
        for (int k = 0; k < 8; ++k) st[k] = *(const u32x4*)(vl + (size_t)(tid + 512 * k) * 8);
        const bf16_t* vc = (const bf16_t*)(p.ws + WS_NVTC) + (size_t)(b * 16 + h) * (64 * 256);
#pragma unroll
        for (int k = 0; k < 4; ++k) st[8 + k] = *(const u32x4*)(vc + (size_t)(tid + 512 * k) * 8);
    }
    const int mk = 8 * (fr >> 2) + (fr & 3);
    f32x4 s[16];
#pragma unroll
    for (int kb = 0; kb < 16; ++kb) {
        const int pp = kb >> 1, e = kb & 1;
        const LAS bf16_t* krow = kind == 0 ? KL + (pp * 64 + c0 + mk + 4 * e) * NA_KP + 8 * g : KC + (32 * pp + mk + 4 * e) * NA_KP + 8 * g;
        const bf16x8 k0 = *(const LAS bf16x8*)krow, k1 = *(const LAS bf16x8*)(krow + 32);
        f32x4 a = (f32x4){0.f, 0.f, 0.f, 0.f};
        a = __builtin_amdgcn_mfma_f32_16x16x32_bf16(k0, q0, a, 0, 0, 0);
        a = __builtin_amdgcn_mfma_f32_16x16x32_bf16(k1, q1, a, 0, 0, 0);
        s[kb] = a;
    }
    const float sc = 0.125f * LOG2E;
    float mx = -1e30f;
    if (kind == 0) {
        int colb[8];
        const int rowbase = (rs - r + 7) * 32;
#pragma unroll
        for (int x = 0; x < 8; ++x) { const int kc = c0 + 8 * g + x; const bool ok = (kc >= cs) && (kc < cs + 16); colb[x] = rowbase + (ok ? kc - j + 15 : 31); }
#pragma unroll
        for (int kb = 0; kb < 16; ++kb) {
            const int pp = kb >> 1, e = kb & 1;
#pragma unroll
            for (int i = 0; i < 4; ++i) { const float t = s[kb][i] * sc + rpbS[colb[4 * e + i] + pp * 32]; s[kb][i] = t; mx = fmaxf(mx, t); }
        }
    } else {
#pragma unroll
        for (int kb = 0; kb < 16; ++kb)
#pragma unroll
            for (int i = 0; i < 4; ++i) { const float t = s[kb][i] * sc; s[kb][i] = t; mx = fmaxf(mx, t); }
    }
    mx = fmaxf(mx, __shfl_xor(mx, 16)); mx = fmaxf(mx, __shfl_xor(mx, 32));
    float l = 0.f;
#pragma unroll
    for (int kb = 0; kb < 16; ++kb)
#pragma unroll
        for (int i = 0; i < 4; ++i) { const float e2 = __builtin_amdgcn_exp2f(s[kb][i] - mx); s[kb][i] = e2; l += e2; }
    l += __shfl_xor(l, 16); l += __shfl_xor(l, 32);
    __syncthreads();
    {
#pragma unroll
        for (int k = 0; k < 8; ++k) { const int ch = tid + 512 * k; *(LAS u32x4*)(KL + (ch >> 3) * NA_KP + (ch & 7) * 8) = st[k]; }
#pragma unroll
        for (int k = 0; k < 4; ++k) { const int ch = tid + 512 * k; *(LAS u32x4*)(KC + (ch >> 5) * NA_CP + (ch & 31) * 8) = st[8 + k]; }
    }
    __syncthreads();
    f32x4 o[4];
#pragma unroll
    for (int dvb = 0; dvb < 4; ++dvb) o[dvb] = (f32x4){0.f, 0.f, 0.f, 0.f};
#pragma unroll
    for (int pp = 0; pp < 8; ++pp) {
        u32x4 pk; pk.x = cvt_pk_bf16(s[2 * pp][0], s[2 * pp][1]); pk.y = cvt_pk_bf16(s[2 * pp][2], s[2 * pp][3]); pk.z = cvt_pk_bf16(s[2 * pp + 1][0], s[2 * pp + 1][1]); pk.w = cvt_pk_bf16(s[2 * pp + 1][2], s[2 * pp + 1][3]);
        const bf16x8 pf = as_bf16x8(pk);
#pragma unroll
        for (int dvb = 0; dvb < 4; ++dvb) {
            const LAS bf16_t* vp = kind == 0 ? KL + (pp * 64 + 16 * dvb + fr) * NA_KP + c0 + 8 * g : KC + (16 * dvb + fr) * NA_CP + 32 * pp + 8 * g;
            o[dvb] = __builtin_amdgcn_mfma_f32_16x16x32_bf16(*(const LAS bf16x8*)vp, pf, o[dvb], 0, 0, 0);
        }
    }
    if (kind == 1) {
        if (g == 0) { CBm[qb * 16 + fr] = mx; CBl[qb * 16 + fr] = l; }
#pragma unroll
        for (int dvb = 0; dvb < 4; ++dvb) *(LAS f32x4*)(CBo + (qb * 64 + lane) * 16 + dvb * 4) = o[dvb];
    }
    __syncthreads();
    if (kind == 0) {
        const float m2 = CBm[qb * 16 + fr], l2 = CBl[qb * 16 + fr];
        const float M = fmaxf(mx, m2), a1 = __builtin_amdgcn_exp2f(mx - M), a2 = __builtin_amdgcn_exp2f(m2 - M);
        const float inv = fast_rcp(l * a1 + l2 * a2);
        bf16_t* op = (bf16_t*)(p.ws + WS_NAO) + (size_t)(b * SEQ + r * 64 + j) * 1024 + h * 64 + 4 * g;
#pragma unroll
        for (int dvb = 0; dvb < 4; ++dvb) {
            const f32x4 o2 = *(const LAS f32x4*)(CBo + (qb * 64 + lane) * 16 + dvb * 4);
            const f32x4 v = (o[dvb] * a1 + o2 * a2) * inv;
            u32x2 ov; ov.x = cvt_pk_bf16(v[0], v[1]); ov.y = cvt_pk_bf16(v[2], v[3]); *(u32x2*)(op + 16 * dvb) = ov;
        }
    }
    __syncthreads();
}

__device__ __forceinline__ void phase_readout(const Params& p) {
    const int w = threadIdx.x >> 6, lane = threadIdx.x & 63;
    const bf16_t* OF = (const bf16_t*)(p.ws + WS_OF); const bf16_t* OB = (const bf16_t*)(p.ws + WS_OB); const bf16_t* PROJ = (const bf16_t*)(p.ws + WS_PROJ);
    bf16_t* AG = (bf16_t*)(p.ws + WS_AG);
    for (int item = blockIdx.x; item < NLAT / 8; item += gridDim.x) {
        const int row = item * 8 + w;
        u32x4 av[4], bv[4], rv4[4];
#pragma unroll
        for (int h = 0; h < 4; ++h) { const int col = h * 512 + lane * 8;
            av[h] = *(const u32x4*)(OF + (size_t)row * D + col); bv[h] = *(const u32x4*)(OB + (size_t)row * D + col); rv4[h] = *(const u32x4*)(PROJ + (size_t)row * LDP + OFF_R + col); }
        const f32x4 g0 = *(const f32x4*)(p.gla_norm_g + lane * 8), g1 = *(const f32x4*)(p.gla_norm_g + lane * 8 + 4);
#pragma unroll
        for (int h = 0; h < 4; ++h) {
            const int col = h * 512 + lane * 8;
            const u32x4 a = av[h], bq = bv[h], rr = rv4[h];
            float o[8];
            o[0] = bflo(a.x) + bflo(bq.x); o[1] = bfhi(a.x) + bfhi(bq.x); o[2] = bflo(a.y) + bflo(bq.y); o[3] = bfhi(a.y) + bfhi(bq.y);
            o[4] = bflo(a.z) + bflo(bq.z); o[5] = bfhi(a.z) + bfhi(bq.z); o[6] = bflo(a.w) + bflo(bq.w); o[7] = bfhi(a.w) + bfhi(bq.w);
            float ss = 0.f;
#pragma unroll
            for (int i = 0; i < 8; ++i) ss += o[i] * o[i];
            ss = wave_sum(ss); const float rstd = rsqrtf(ss * (1.0f / 512.0f) + EPS);
            const float rv[8] = {bflo(rr.x), bfhi(rr.x), bflo(rr.y), bfhi(rr.y), bflo(rr.z), bfhi(rr.z), bflo(rr.w), bfhi(rr.w)};
            float v[8];
#pragma unroll
            for (int i = 0; i < 8; ++i) v[i] = o[i] * rstd * (i < 4 ? g0[i] : g1[i - 4]) * siluf_(rv[i]);
            u32x4 ov; ov.x = cvt_pk_bf16(v[0], v[1]); ov.y = cvt_pk_bf16(v[2], v[3]); ov.z = cvt_pk_bf16(v[4], v[5]); ov.w = cvt_pk_bf16(v[6], v[7]);
            *(u32x4*)(AG + (size_t)row * D + col) = ov;
        }
    }
}

constexpr int N_PHASES = 15;
__global__ void __launch_bounds__(NTHR, 2) mk_fwd(Params p) {
    extern __shared__ __attribute__((aligned(16))) uchar lds_raw[];
    LAS uchar* lds = (LAS uchar*)lds_raw;
    const int G = gridDim.x, bx = blockIdx.x;
    uchar* ws = p.ws;
#define IN(k) (p.ph_lo <= (k) && (k) < p.ph_hi)
    LAS unsigned* xbst = (LAS unsigned*)(lds + LDS_BYTES - 16);
    if (threadIdx.x == 0) { xbst[0] = 0u; xbst[1] = 0u; xbst[2] = 0u; xbst[3] = 0u; }
    __syncthreads();
    const XcdBarrier xbar = xcd_barrier_post((unsigned*)(ws + WS_BAR), (volatile LAS unsigned*)xbst);
    if (p.ph_lo < 0) cg::this_grid().sync();
#define SEAM(k) do { if (IN(k) && IN((k) + 1)) { xcd_barrier(xbar); for (int xs_ = 0; xs_ < MK_EXTRA_SYNC; ++xs_) xcd_barrier(xbar); } } while (0)
#define REPS(k) for (int rep_ = 0; rep_ < 1 + ((MK_REP_MASK >> (k)) & 1); ++rep_)
    bf16_t* A = (bf16_t*)(ws + WS_A); bf16_t* H = (bf16_t*)(ws + WS_H); bf16_t* Y = (bf16_t*)(ws + WS_Y); bf16_t* YC = (bf16_t*)(ws + WS_YC);
    bf16_t* PROJ = (bf16_t*)(ws + WS_PROJ);

    if (IN(0)) REPS(0) { phase_prologue(lds, p); } SEAM(0);
    if (IN(1)) REPS(1) { phase_prenorm1(p); } SEAM(1);
    if (IN(2)) REPS(2) {
        { pg8::Gemm g{A, (const bf16_t*)(ws + WS_WGU1), NLAT, 2 * DFF, D, D, D}; pg8::StaticOrder S; S.init(NLAT, 2 * DFF, G, bx); pg8::EpiSiluMul E{H, DFF}; pg8::gemm_phase(lds, g, S, E); }
        { pg8::Gemm g{A + (size_t)NLAT * D, (const bf16_t*)(ws + WS_WGU1), NCTX, 2 * DFF, D, D, D}; pg8::StaticOrder S; S.init(NCTX, 2 * DFF, G, G - 1 - bx); pg8::EpiSiluMul E{H + (size_t)NLAT * DFF, DFF}; pg8::gemm_phase(lds, g, S, E); }
    } SEAM(2);
    if (IN(3)) REPS(3) {
        { pg8::Gemm g{H, (const bf16_t*)(ws + WS_WD1), NLAT, D, DFF, DFF, DFF}; pg8::StaticOrder S; S.init(NLAT, D, G, bx); pg8::EpiBf16 E{Y, D}; pg8::gemm_phase(lds, g, S, E); }
        for (int sp = 0; sp < 4; ++sp) { pg8::Gemm g{H + (size_t)NLAT * DFF + sp * 1408, (const bf16_t*)(ws + WS_WD1) + sp * 1408, NCTX, D, 1408, DFF, DFF}; pg8::StaticOrder S; S.init(NCTX, D, G, (bx + G - 16 * sp) % G);
            pg8::EpiBf16 E{YC + (size_t)sp * NCTX * D, D}; pg8::gemm_phase(lds, g, S, E); }
    } SEAM(3);
    if (IN(4)) REPS(4) { phase_post<0>(p); } SEAM(4);
    if (IN(5)) REPS(5) {
        { pg8::Gemm g{A, (const bf16_t*)(ws + WS_WIN), NLAT, LDP, D, D, D}; pg8::StaticOrder S; S.init(NLAT, LDP, G, bx); pg8::EpiBf16 E{PROJ, LDP}; pg8::gemm_phase(lds, g, S, E); }
        { pg8::Gemm g{A + (size_t)NLAT * D, (const bf16_t*)(ws + WS_WIN), NCTX, NCTXCOLS, D, D, D}; pg8::StaticOrder S; S.init(NCTX, NCTXCOLS, G, G - 1 - bx); pg8::EpiBf16 E{PROJ + (size_t)NLAT * LDP, LDP}; pg8::gemm_phase(lds, g, S, E); }
    } SEAM(5);
    if (IN(6)) REPS(6) {
        const int n_items = NB * NCH * 4 + NB * NCH;
        for (int it = bx; it < n_items; it += G) { if (it < NB * NCH * 4) gla_prep_item(lds, p, it); else na_vt_item(p, it - NB * NCH * 4); }
    } SEAM(6);
    if (IN(7)) REPS(7) {
        for (int t = bx; t < 128; t += G) gla_scan_task(lds, p, t);
        __syncthreads();
        {
            unsigned* qhead = (unsigned*)(ws + WS_CTR);
            if (threadIdx.x == 0) *(LAS unsigned*)(lds + NA_QW) = atomicAdd(qhead, 1u);
            __syncthreads();
            unsigned it = *(LAS unsigned*)(lds + NA_QW);
            __syncthreads();
            while (it < (unsigned)(NB * 16 * 64)) {
                unsigned nxt = 0u;
                if (threadIdx.x == 0) nxt = atomicAdd(qhead, 1u);
                na_item(lds, p, (int)it);
                if (threadIdx.x == 0) *(LAS unsigned*)(lds + NA_QW) = nxt;
                __syncthreads();
                it = *(LAS unsigned*)(lds + NA_QW);
                __syncthreads();
            }
        }
    } SEAM(7);
    if (IN(8)) REPS(8) {
        phase_readout(p);
        { pg8::Gemm g{(const bf16_t*)(ws + WS_NAO), (const bf16_t*)(ws + WS_WNAO), NLAT, D, 1024, 1024, 1024}; pg8::StaticOrder S; S.init(NLAT, D, G, bx); pg8::EpiGate2 E{(bf16_t*)(ws + WS_G2), PROJ + OFF_M2}; pg8::gemm_phase(lds, g, S, E); }
    } SEAM(8);
    if (IN(9)) REPS(9) { pg8::Gemm g{(const bf16_t*)(ws + WS_AG), (const bf16_t*)(ws + WS_WGLAO), NLAT, D, D, D, D}; pg8::StaticOrder S; S.init(NLAT, D, G, bx); pg8::EpiMerge E{(bf16_t*)(ws + WS_MG), PROJ + OFF_M1, (const bf16_t*)(ws + WS_G2)}; pg8::gemm_phase(lds, g, S, E); } SEAM(9);
    if (IN(10)) REPS(10) { pg8::Gemm g{(const bf16_t*)(ws + WS_MG), (const bf16_t*)(ws + WS_WOUT), NLAT, D, D, D, D}; pg8::StaticOrder S; S.init(NLAT, D, G, bx); pg8::EpiBf16 E{Y, D}; pg8::gemm_phase(lds, g, S, E); } SEAM(10);
    if (IN(11)) REPS(11) { phase_post<1>(p); } SEAM(11);
    if (IN(12)) REPS(12) { pg8::Gemm g{A, (const bf16_t*)(ws + WS_WGU2), NLAT, 2 * DFF, D, D, D}; pg8::StaticOrder S; S.init(NLAT, 2 * DFF, G, bx); pg8::EpiSiluMul E{H, DFF}; pg8::gemm_phase(lds, g, S, E); } SEAM(12);
    if (IN(13)) REPS(13) { pg8::Gemm g{H, (const bf16_t*)(ws + WS_WD2), NLAT, D, DFF, DFF, DFF}; pg8::StaticOrder S; S.init(NLAT, D, G, bx); pg8::EpiBf16 E{Y, D}; pg8::gemm_phase(lds, g, S, E); } SEAM(13);
    if (IN(14)) REPS(14) { phase_post<2>(p); }
#undef IN
#undef SEAM
}


#ifndef MK_RUN
#define MK_RUN N_PHASES
#endif
#ifndef MK_COOP
#define MK_COOP 1
#endif
extern "C" void kernel_launch(void* const* d_in, const int* in_sizes, int n_in, void* d_out, int out_size, void* d_ws, size_t ws_size, hipStream_t stream) {
    static int grid = 0;
    if (grid == 0) {
        if (n_in != 18 || ws_size < WS_END) { fprintf(stderr, "kernel_launch: need 18 inputs and %zu bytes of workspace (got %d, %zu)\n", (size_t)WS_END, n_in, ws_size); grid = -1; return; }
        int dev = 0, cus = 0, per_cu = 0;
        hipGetDevice(&dev); hipDeviceGetAttribute(&cus, hipDeviceAttributeMultiprocessorCount, dev);
        if (hipFuncSetAttribute((const void*)mk_fwd, hipFuncAttributeMaxDynamicSharedMemorySize, LDS_BYTES) != hipSuccess) { fprintf(stderr, "kernel_launch: hipFuncSetAttribute failed\n"); grid = -1; return; }
        if (hipOccupancyMaxActiveBlocksPerMultiprocessor(&per_cu, (const void*)mk_fwd, NTHR, LDS_BYTES) != hipSuccess || per_cu < 1) { fprintf(stderr, "kernel_launch: occupancy query gave %d\n", per_cu); per_cu = 1; }
        (void)hipGetLastError();
        grid = cus * 1;
    }
    if (grid < 0) return;
    if (hipMemsetAsync((char*)d_ws + WS_CTR, 0, 16384, stream) != hipSuccess) { fprintf(stderr, "kernel_launch: memset failed\n"); return; }
    Params p{};
    const float** f = (const float**)&p;
    for (int i = 0; i < 18; ++i) f[i] = (const float*)d_in[i];
    p.out = (float*)d_out; p.ws = (uchar*)d_ws;
#if MK_COOP
    p.ph_lo = 0; p.ph_hi = MK_RUN;
    void* args[] = {&p};
    hipError_t e = hipLaunchCooperativeKernel((const void*)mk_fwd, dim3(grid), dim3(NTHR), args, LDS_BYTES, stream);
    if (e != hipSuccess) fprintf(stderr, "cooperative launch failed: %s (grid %d)\n", hipGetErrorString(e), grid);
#else
    for (int ph = 0; ph < MK_RUN; ++ph) { p.ph_lo = ph; p.ph_hi = ph + 1; hipLaunchKernelGGL(mk_fwd, dim3(grid), dim3(NTHR), LDS_BYTES, stream, p); }
#endif
}
```

```cpp
#include <hip/hip_runtime.h>
#ifndef MK_REP_MASK
#define MK_REP_MASK 0
#endif
#ifndef MK_EXTRA_SYNC
#define MK_EXTRA_SYNC 0
#endif
#include <hip/hip_cooperative_groups.h>
#include <cstdio>
namespace cg = cooperative_groups;

#define LAS __attribute__((address_space(3)))
typedef unsigned short bf16_t;
typedef unsigned char uchar;
typedef short bf16x8 __attribute__((ext_vector_type(8)));
typedef float f32x4 __attribute__((ext_vector_type(4)));
typedef float f32x16 __attribute__((ext_vector_type(16)));
typedef unsigned u32x4 __attribute__((ext_vector_type(4)));
typedef unsigned u32x2 __attribute__((ext_vector_type(2)));

constexpr int D = 2048, NB = 2, SEQ = 4096, CTXL = 256, DFF = 5632, NMODC = 9 * D;
constexpr int NLAT = NB * SEQ, NCTX = NB * CTXL, NTOK = NLAT + NCTX;
constexpr int INW = 13344;
constexpr int LDP = 13568;
constexpr int OFF_K = 0, OFF_V = 1024, OFF_NK = 3072, OFF_NV = 4096, OFF_GF = 5120, OFF_GB = 5136, OFF_Q = 5376, OFF_R = 6400, OFF_NQ = 8448, OFF_M1 = 9472, OFF_M2 = 11520;
constexpr int NCTXCOLS = 5376;
constexpr int NCH = 68;
constexpr float EPS = 1e-6f, LOG2E = 1.4426950408889634f;
constexpr int LDS_BYTES = 147456;
constexpr int NTHR = 512;

constexpr size_t SZ_WGU = (size_t)2 * DFF * D * 2, SZ_WD = (size_t)D * DFF * 2;
constexpr size_t WS_WGU2 = 0, WS_WD2 = WS_WGU2 + SZ_WGU, WS_WGLAO = WS_WD2 + SZ_WD, WS_WNAO = WS_WGLAO + (size_t)D * D * 2, WS_WOUT = WS_WNAO + (size_t)D * 1024 * 2,
                 WS_MODP = WS_WOUT + (size_t)D * D * 2, WS_CTR = WS_MODP + (size_t)2 * 3 * NMODC * 4, WS_BAR = WS_CTR + 256, WS_R1 = WS_BAR + 16384 - 256;
constexpr size_t WS_WGU1 = WS_R1, WS_WD1 = WS_WGU1 + SZ_WGU, WS_R2 = WS_WD1 + SZ_WD;
constexpr size_t WS_OF = WS_R1, WS_OB = WS_R1 + (size_t)NLAT * D * 2;
constexpr size_t WS_WIN = WS_R2, WS_R4 = WS_WIN + (size_t)LDP * D * 2;
constexpr size_t SZ_QD = (size_t)NB * 4 * 2 * NCH * 64 * 256 * 2;
constexpr size_t WS_QD = WS_R2, WS_NVTL = WS_QD + SZ_QD, WS_NVTC = WS_NVTL + (size_t)NB * 16 * 64 * 64 * 64 * 2, WS_AG = WS_R2;
constexpr size_t WS_PROJ = WS_R4, WS_R5 = WS_PROJ + (size_t)NTOK * LDP * 2;
constexpr size_t WS_Y = WS_R4, WS_YC = WS_Y + (size_t)NLAT * D * 4;
constexpr size_t WS_H = WS_R5, WS_R8 = WS_H + (size_t)NTOK * DFF * 2;
constexpr size_t WS_KET = WS_R5, WS_VT = WS_KET + SZ_QD, WS_PM = WS_VT + (size_t)NB * 4 * NCH * 512 * 64 * 2, WS_DEC = WS_PM + (size_t)NB * 4 * 2 * NCH * 4096 * 2, WS_G2 = WS_R5;
constexpr size_t WS_A = WS_R8, WS_NAO = WS_R8, WS_MG = WS_R8, WS_END = WS_A + (size_t)NTOK * D * 2;
static_assert(WS_DEC + (size_t)NB * 4 * 2 * NCH * 256 * 4 <= WS_R8, "R5 overlay");
static_assert(WS_NVTC + (size_t)NB * 16 * 64 * 256 * 2 <= WS_R4, "R2 overlay");
static_assert(WS_OB + (size_t)NLAT * D * 2 <= WS_R2, "R1 overlay");

struct Params {
    const float *x, *c, *ctx, *c_ctx, *w_ada, *b_ada, *norm_g, *ffn_wg, *ffn_wu, *ffn_wd, *w_in, *gla_wg, *gla_bg, *gla_norm_g, *w_gla_o, *na_rpb, *w_na_o, *w_out;
    float* out; uchar* ws; int ph_lo, ph_hi;
};

typedef float f32x2_t __attribute__((ext_vector_type(2)));
typedef __bf16 bf16x2_t __attribute__((ext_vector_type(2)));
__device__ __forceinline__ unsigned cvt_pk_bf16(float lo, float hi) { const f32x2_t v = {lo, hi}; union { bf16x2_t b; unsigned u; } x; x.b = __builtin_convertvector(v, bf16x2_t); return x.u; }
__device__ __forceinline__ float bf2f(bf16_t b) { return __uint_as_float(((unsigned)b) << 16); }
__device__ __forceinline__ float bflo(unsigned u) { return __uint_as_float(u << 16); }
__device__ __forceinline__ float bfhi(unsigned u) { return __uint_as_float(u & 0xffff0000u); }
__device__ __forceinline__ float fast_rcp(float x) { return __builtin_amdgcn_rcpf(x); }
__device__ __forceinline__ float sigmoidf_(float x) { return fast_rcp(1.0f + __builtin_amdgcn_exp2f(x * -LOG2E)); }
__device__ __forceinline__ float siluf_(float x) { return x * sigmoidf_(x); }
__device__ __forceinline__ float wave_sum(float v) {
#pragma unroll
    for (int o = 32; o >= 1; o >>= 1) v += __shfl_xor(v, o);
    return v;
}
__device__ __forceinline__ bf16x8 as_bf16x8(u32x4 v) { union { u32x4 u; bf16x8 b; } x; x.u = v; return x.b; }


#define XB_TMO      128
#define XB_XCNT(j)  (256  + 64 * (j))
#define XB_XSUB(j)  (1280 + 64 * (j))
#define XB_XGEN(j)  (2304 + 64 * (j))
#define XB_TOP      3328
#define XB_TOPGEN   3392
#define XCD_BAR_WORDS 3456
#define XB_SPIN_CAP (1u << 20)
__device__ __forceinline__ unsigned xb_ld(unsigned* p)              { return __hip_atomic_load(p, __ATOMIC_RELAXED, __HIP_MEMORY_SCOPE_AGENT); }
__device__ __forceinline__ unsigned xb_add(unsigned* p, unsigned v) { return __hip_atomic_fetch_add(p, v, __ATOMIC_RELAXED, __HIP_MEMORY_SCOPE_AGENT); }
__device__ __forceinline__ unsigned xb_xcc_id() { return (unsigned)__builtin_amdgcn_s_getreg((3 << 11) | 20) & 0xFu; }
#define XB_SPIN(cond, bar) do { unsigned _sp = 0; while (cond) { __builtin_amdgcn_s_sleep(1); \
    if ((++_sp & 255u) == 0u) { if (xb_ld(&(bar)[XB_TMO])) break; if (_sp > XB_SPIN_CAP) { atomicAdd(&(bar)[XB_TMO], 1u); break; } } } } while (0)
struct XcdBarrier { unsigned* bar; unsigned x; volatile LAS unsigned* st; };
__device__ __forceinline__ XcdBarrier xcd_barrier_post(unsigned* bar, volatile LAS unsigned* st) {
    XcdBarrier b; b.bar = bar; b.x = xb_xcc_id(); b.st = st;
    if (threadIdx.x == 0) (void)xb_add(&bar[XB_XCNT(b.x)], 1u);
    return b;
}
__device__ __forceinline__ void xcd_barrier_complete(unsigned* bar, unsigned x, unsigned& nloc, unsigned& nx) {
    const unsigned G = gridDim.x * gridDim.y * gridDim.z;
    unsigned sum, cnt, mine, sp = 0u;
    for (;;) {
        sum = 0u; cnt = 0u; mine = 0u;
#pragma unroll
        for (unsigned j = 0; j < 16; ++j) { const unsigned c = xb_ld(&bar[XB_XCNT(j)]); sum += c; cnt += (c > 0u) ? 1u : 0u; mine = (j == x) ? c : mine; }
        if (sum == G) break;
        __builtin_amdgcn_s_sleep(1);
        if ((++sp & 255u) == 0u) { if (xb_ld(&bar[XB_TMO])) break; if (sp > XB_SPIN_CAP) { atomicAdd(&bar[XB_TMO], 1u); break; } }
    }
    nloc = mine > 0u ? mine : 1u; nx = cnt > 0u ? cnt : 1u;
}
__device__ __forceinline__ void xcd_barrier(const XcdBarrier& b) {
    asm volatile("s_waitcnt vmcnt(0)" ::: "memory");
    __syncthreads();
    if (threadIdx.x == 0) {
        unsigned* bar = b.bar;
        __builtin_amdgcn_s_waitcnt(0);
        unsigned nloc = b.st[0], nx = b.st[1];
        if (nloc == 0u) { xcd_barrier_complete(bar, b.x, nloc, nx); b.st[0] = nloc; b.st[1] = nx; }
        const unsigned old = xb_add(&bar[XB_XSUB(b.x)], 1u);
        const unsigned gen = old / nloc;
        if (old + 1u == (gen + 1u) * nloc) {
            __builtin_amdgcn_fence(__ATOMIC_RELEASE, "agent");
            asm volatile("s_waitcnt vmcnt(0)" ::: "memory");
            const unsigned og = xb_add(&bar[XB_TOP], 1u);
            const unsigned tg = og / nx;
            if (og + 1u == (tg + 1u) * nx) xb_add(&bar[XB_TOPGEN], 1u);
            else XB_SPIN(xb_ld(&bar[XB_TOPGEN]) == tg, bar);
            __builtin_amdgcn_fence(__ATOMIC_ACQUIRE, "agent");
            xb_add(&bar[XB_XGEN(b.x)], 1u);
            asm volatile("s_waitcnt vmcnt(0)" ::: "memory");
        } else {
            XB_SPIN(xb_ld(&bar[XB_XGEN(b.x)]) == gen, bar);
            __builtin_amdgcn_fence(__ATOMIC_ACQUIRE, "agent");
            asm volatile("s_waitcnt vmcnt(0)" ::: "memory");
        }
    }
    __syncthreads();
}

namespace pg8 {
constexpr int BM = 256, BK = 64, HALF = 128, HTB = HALF * BK * 2, NXCD = 8, WGM = 8;
__device__ __forceinline__ int lds_byte(int r, int c) { const int st = (r >> 4) * 2 + (c >> 5), rr = r & 15, cc = c & 31, ob = rr * 64 + cc * 2; return st * 1024 + (ob ^ (((ob >> 9) & 1) << 5)); }
__device__ __forceinline__ void stage_rc(int b, int& R, int& C) { const int st = b / 1024, sb = b % 1024, swz = sb ^ (((sb >> 9) & 1) << 5); R = (st >> 1) * 16 + swz / 64; C = (st & 1) * 32 + (swz % 64) / 2; }
__device__ __forceinline__ int perm32(int rho) { const int n = rho >> 4, i = rho & 15; return 8 * (i >> 2) + 4 * n + (i & 3); }
struct Unit { int pm, pn; };
struct Gemm { const bf16_t* A; const bf16_t* Bt; int M, N, K, lda, ldb; };
struct StaticOrder {
    int nM, nN, nwg, G, c;
    __device__ void init(int M, int N, int G_, int c_) { nM = M / BM; nN = N / BM; nwg = nM * nN; G = G_; c = c_; }
    __device__ bool next(int i, Unit& u) const {
        const long L = (long)i * G + c; if (L >= nwg) return false;
        int wgid = (int)L; { const int q = nwg / NXCD, r = nwg % NXCD, xcd = wgid % NXCD, off = wgid / NXCD; wgid = (xcd < r ? xcd * (q + 1) : r * (q + 1) + (xcd - r) * q) + off; }
        const int nig = WGM * nN, gid = wgid / nig, fm = gid * WGM, gsz = (nM - fm) < WGM ? (nM - fm) : WGM;
        u.pm = fm + ((wgid % nig) % gsz); u.pn = (wgid % nig) / gsz; return true;
    }
};
struct EpiF32 {
    static constexpr bool PERM = false;
    float* C; int ldc;
    __device__ __forceinline__ void operator()(const f32x4 (&acc)[2][2][4][2], const Unit& u, int wr, int wc, int fr, int fq) const {
        const int row0 = u.pm * BM + wr * 64 + fr, col0 = u.pn * BM + wc * 32 + 4 * fq;
#pragma unroll
        for (int ai = 0; ai < 2; ++ai)
#pragma unroll
            for (int m = 0; m < 4; ++m) { float* rowp = C + (size_t)(row0 + ai * HALF + m * 16) * ldc + col0;
#pragma unroll
                for (int bj = 0; bj < 2; ++bj)
#pragma unroll
                    for (int n = 0; n < 2; ++n) *(f32x4*)(rowp + bj * HALF + n * 16) = acc[ai][bj][m][n]; }
    }
};
struct EpiBf16 {
    static constexpr bool PERM = true;
    bf16_t* O; int ldc;
    __device__ __forceinline__ void operator()(const f32x4 (&acc)[2][2][4][2], const Unit& u, int wr, int wc, int fr, int fq) const {
        const int row0 = u.pm * BM + wr * 64 + fr, col0 = u.pn * BM + wc * 32 + 8 * fq;
#pragma unroll
        for (int ai = 0; ai < 2; ++ai)
#pragma unroll
            for (int m = 0; m < 4; ++m) { bf16_t* rowp = O + (size_t)(row0 + ai * HALF + m * 16) * ldc + col0;
#pragma unroll
                for (int bj = 0; bj < 2; ++bj) { const f32x4 v0 = acc[ai][bj][m][0], v1 = acc[ai][bj][m][1];
                    u32x4 w; w.x = cvt_pk_bf16(v0[0], v0[1]); w.y = cvt_pk_bf16(v0[2], v0[3]); w.z = cvt_pk_bf16(v1[0], v1[1]); w.w = cvt_pk_bf16(v1[2], v1[3]);
                    *(u32x4*)(rowp + bj * HALF) = w; } }
    }
};
struct EpiSiluMul {
    static constexpr bool PERM = true;
    bf16_t* O; int ldc;
    __device__ __forceinline__ void operator()(const f32x4 (&acc)[2][2][4][2], const Unit& u, int wr, int wc, int fr, int fq) const {
        const int row0 = u.pm * BM + wr * 64 + fr, col0 = u.pn * HALF + wc * 32 + 8 * fq;
#pragma unroll
        for (int ai = 0; ai < 2; ++ai)
#pragma unroll
            for (int m = 0; m < 4; ++m) { bf16_t* rowp = O + (size_t)(row0 + ai * HALF + m * 16) * ldc + col0;
                float h[8];
#pragma unroll
                for (int n = 0; n < 2; ++n)
#pragma unroll
                    for (int j = 0; j < 4; ++j) h[n * 4 + j] = siluf_(acc[ai][0][m][n][j]) * acc[ai][1][m][n][j];
                u32x4 w; w.x = cvt_pk_bf16(h[0], h[1]); w.y = cvt_pk_bf16(h[2], h[3]); w.z = cvt_pk_bf16(h[4], h[5]); w.w = cvt_pk_bf16(h[6], h[7]);
                *(u32x4*)rowp = w; }
    }
};
struct EpiGate2 {
    static constexpr bool PERM = false, AFTER_DRAIN = false;
    bf16_t* C; const bf16_t* gate;
    __device__ __forceinline__ void operator()(const f32x4 (&acc)[2][2][4][2], const Unit& u, int wr, int wc, int fr, int fq) const {
        const int row0 = u.pm * BM + wr * 64 + fr, col0 = u.pn * BM + wc * 32 + 4 * fq;
#pragma unroll
        for (int ai = 0; ai < 2; ++ai) {
            u32x2 gm[4][2][2];
#pragma unroll
            for (int m = 0; m < 4; ++m)
#pragma unroll
                for (int bj = 0; bj < 2; ++bj)
#pragma unroll
                    for (int n = 0; n < 2; ++n) gm[m][bj][n] = *(const u32x2*)(gate + (size_t)(row0 + ai * HALF + m * 16) * LDP + col0 + bj * HALF + n * 16);
#pragma unroll
            for (int m = 0; m < 4; ++m) { const size_t row = (size_t)(row0 + ai * HALF + m * 16);
#pragma unroll
                for (int bj = 0; bj < 2; ++bj)
#pragma unroll
                    for (int n = 0; n < 2; ++n) { const int col = col0 + bj * HALF + n * 16; const u32x2 g = gm[m][bj][n]; const f32x4 a = acc[ai][bj][m][n];
                        f32x4 o; o[0] = sigmoidf_(bflo(g.x)) * a[0]; o[1] = sigmoidf_(bfhi(g.x)) * a[1]; o[2] = sigmoidf_(bflo(g.y)) * a[2]; o[3] = sigmoidf_(bfhi(g.y)) * a[3];
                        u32x2 ow; ow.x = cvt_pk_bf16(o[0], o[1]); ow.y = cvt_pk_bf16(o[2], o[3]); *(u32x2*)(C + row * D + col) = ow; } }
        }
    }
};
struct EpiMerge {
    static constexpr bool PERM = true, AFTER_DRAIN = false;
    bf16_t* O; const bf16_t* gate; const bf16_t* G2;
    __device__ __forceinline__ void operator()(const f32x4 (&acc)[2][2][4][2], const Unit& u, int wr, int wc, int fr, int fq) const {
        const int row0 = u.pm * BM + wr * 64 + fr, col0 = u.pn * BM + wc * 32 + 8 * fq;
#pragma unroll
        for (int ai = 0; ai < 2; ++ai) {
            u32x4 gm[4][2], gq[4][2];
#pragma unroll
            for (int m = 0; m < 4; ++m)
#pragma unroll
                for (int bj = 0; bj < 2; ++bj) { const size_t row = (size_t)(row0 + ai * HALF + m * 16); const int col = col0 + bj * HALF;
                    gm[m][bj] = *(const u32x4*)(gate + row * LDP + col); gq[m][bj] = *(const u32x4*)(G2 + row * D + col); }
#pragma unroll
            for (int m = 0; m < 4; ++m) { const size_t row = (size_t)(row0 + ai * HALF + m * 16);
#pragma unroll
                for (int bj = 0; bj < 2; ++bj) { const int col = col0 + bj * HALF;
                    const u32x4 g = gm[m][bj], q = gq[m][bj];
                    const f32x4 v0 = acc[ai][bj][m][0], v1 = acc[ai][bj][m][1];
                    float o[8];
                    o[0] = sigmoidf_(bflo(g.x)) * v0[0] + bflo(q.x); o[1] = sigmoidf_(bfhi(g.x)) * v0[1] + bfhi(q.x); o[2] = sigmoidf_(bflo(g.y)) * v0[2] + bflo(q.y); o[3] = sigmoidf_(bfhi(g.y)) * v0[3] + bfhi(q.y);
                    o[4] = sigmoidf_(bflo(g.z)) * v1[0] + bflo(q.z); o[5] = sigmoidf_(bfhi(g.z)) * v1[1] + bfhi(q.z); o[6] = sigmoidf_(bflo(g.w)) * v1[2] + bflo(q.w); o[7] = sigmoidf_(bfhi(g.w)) * v1[3] + bfhi(q.w);
                    u32x4 w; w.x = cvt_pk_bf16(o[0], o[1]); w.y = cvt_pk_bf16(o[2], o[3]); w.z = cvt_pk_bf16(o[4], o[5]); w.w = cvt_pk_bf16(o[6], o[7]);
                    *(u32x4*)(O + row * D + col) = w; } }
        }
    }
};

template <class Epi, bool ALIGN_EPI = true>
__device__ __forceinline__ void gemm_phase(LAS uchar* lds, const Gemm g, const StaticOrder& S, const Epi& E) {
    const int tid = threadIdx.x, wid = __builtin_amdgcn_readfirstlane(tid >> 6), lane = tid & 63, wr = wid >> 2, wc = wid & 3, fr = lane & 15, fq = lane >> 4;
    const int K = g.K, nt = K / BK;
    unsigned voffA[2], voffB[2];
#pragma unroll
    for (int i = 0; i < 2; ++i) { int R, C; stage_rc(tid * 16 + i * 8192, R, C); const int Rb = Epi::PERM ? ((R & ~31) + perm32(R & 31)) : R;
        voffA[i] = (unsigned)(R * g.lda + C) * 2u; voffB[i] = (unsigned)(Rb * g.ldb + C) * 2u; }
    const size_t kstep = (size_t)(BK * 2);
    const size_t hstepA = (size_t)HALF * g.lda * 2, hstepB = (size_t)HALF * g.ldb * 2;
    const size_t tstepA = 2 * hstepA, tstepB = 2 * hstepB;
    const unsigned ldsw = (unsigned)wid * 1024u;
    const int aoff = lds_byte(wr * 64 + fr, fq * 8), boff = lds_byte(wc * 32 + fr, fq * 8);
#define PG8_SA(b, h) (((b) * 2 + (h)) * HTB)
#define PG8_SB(b, h) ((4 + (b) * 2 + (h)) * HTB)
#define PG8_STAGE(bufoff, gbase, voff) do { _Pragma("unroll") for (int _i = 0; _i < 2; ++_i) \
        __builtin_amdgcn_global_load_lds((const unsigned*)((const char*)(gbase) + (voff)[_i]), (LAS unsigned*)(lds + (bufoff) + ldsw + _i * 8192), 16, 0, 0); } while (0)
#define PG8_LDA(dst, b, h) do { _Pragma("unroll") for (int m = 0; m < 4; ++m) _Pragma("unroll") for (int k = 0; k < 2; ++k) dst[m][k] = *(const LAS bf16x8*)(lds + PG8_SA(b, h) + aoff + m * 2048 + k * 1024); } while (0)
#define PG8_LDB(dst, b, h) do { _Pragma("unroll") for (int n = 0; n < 2; ++n) _Pragma("unroll") for (int k = 0; k < 2; ++k) dst[n][k] = *(const LAS bf16x8*)(lds + PG8_SB(b, h) + boff + n * 2048 + k * 1024); } while (0)
#define PG8_MMA(ai, bj, At, Bt) do { __builtin_amdgcn_s_setprio(1); _Pragma("unroll") for (int m = 0; m < 4; ++m) _Pragma("unroll") for (int n = 0; n < 2; ++n) _Pragma("unroll") for (int k = 0; k < 2; ++k) \
        acc[ai][bj][m][n] = __builtin_amdgcn_mfma_f32_16x16x32_bf16(Bt[n][k], At[m][k], acc[ai][bj][m][n], 0, 0, 0); __builtin_amdgcn_s_setprio(0); } while (0)
#define PG8_WAIT_V(n) asm volatile("s_waitcnt vmcnt(" #n ")" ::: "memory")
#define PG8_WAIT_L(n) asm volatile("s_waitcnt lgkmcnt(" #n ")" ::: "memory")
#define PG8_BAR __builtin_amdgcn_s_barrier()
#define PG8_SCHED __builtin_amdgcn_sched_barrier(0)
    Unit cur, nxt; int ui = 0;
    if (!S.next(0, cur)) return;
    f32x4 acc[2][2][4][2];
#pragma unroll
    for (int a = 0; a < 2; ++a)
#pragma unroll
        for (int b = 0; b < 2; ++b)
#pragma unroll
            for (int m = 0; m < 4; ++m)
#pragma unroll
                for (int n = 0; n < 2; ++n) acc[a][b][m][n] = (f32x4){0.f, 0.f, 0.f, 0.f};
    bf16x8 At[4][2], B0[2][2], B1[2][2];
    const char* cA = (const char*)g.A + (size_t)cur.pm * tstepA; const char* cB = (const char*)g.Bt + (size_t)cur.pn * tstepB;
    PG8_STAGE(PG8_SB(0, 0), cB, voffB); PG8_STAGE(PG8_SB(0, 1), cB + hstepB, voffB); PG8_STAGE(PG8_SA(0, 0), cA, voffA); PG8_STAGE(PG8_SA(0, 1), cA + hstepA, voffA);
    if (wr == 1) PG8_BAR;
    PG8_WAIT_V(2); PG8_BAR;
    PG8_STAGE(PG8_SB(1, 0), cB + kstep, voffB); PG8_STAGE(PG8_SA(1, 0), cA + kstep, voffA); PG8_STAGE(PG8_SB(1, 1), cB + hstepB + kstep, voffB);
    PG8_WAIT_V(6); PG8_BAR;
    for (;;) {
        const bool has_next = S.next(ui + 1, nxt);
        const char* nA = has_next ? (const char*)g.A + (size_t)nxt.pm * tstepA : cA; const char* nB = has_next ? (const char*)g.Bt + (size_t)nxt.pn * tstepB : cB;
        for (int t = 0; t < nt; t += 2) {
            const bool last = (t == nt - 2);
            const char* a1 = cA + (size_t)(t + 1) * kstep;
            const char* a2 = last ? nA : cA + (size_t)(t + 2) * kstep; const char* b2 = last ? nB : cB + (size_t)(t + 2) * kstep;
            const char* a3 = a2 + kstep; const char* b3 = b2 + kstep;
            PG8_LDB(B0, 0, 0); PG8_LDB(B1, 0, 1); PG8_SCHED; PG8_LDA(At, 0, 0); PG8_STAGE(PG8_SA(1, 1), a1 + hstepA, voffA);
            PG8_WAIT_V(8); PG8_WAIT_L(0); PG8_BAR; PG8_MMA(0, 0, At, B0); PG8_MMA(0, 1, At, B1); PG8_BAR; PG8_SCHED;
            PG8_LDA(At, 0, 1); PG8_STAGE(PG8_SB(0, 0), b2, voffB); PG8_STAGE(PG8_SB(0, 1), b2 + hstepB, voffB); PG8_STAGE(PG8_SA(0, 0), a2, voffA);
            PG8_WAIT_V(8); PG8_WAIT_L(0); PG8_BAR; PG8_MMA(1, 0, At, B0); PG8_MMA(1, 1, At, B1); PG8_BAR; PG8_SCHED;
            PG8_LDB(B0, 1, 0); PG8_LDB(B1, 1, 1); PG8_SCHED; PG8_LDA(At, 1, 0); PG8_STAGE(PG8_SA(0, 1), a2 + hstepA, voffA);
            PG8_WAIT_V(8); PG8_WAIT_L(0); PG8_BAR; PG8_MMA(0, 0, At, B0); PG8_MMA(0, 1, At, B1); PG8_BAR; PG8_SCHED;
            PG8_LDA(At, 1, 1); PG8_STAGE(PG8_SB(1, 0), b3, voffB); PG8_STAGE(PG8_SB(1, 1), b3 + hstepB, voffB); PG8_STAGE(PG8_SA(1, 0), a3, voffA);
            PG8_WAIT_V(8); PG8_WAIT_L(0); PG8_BAR; PG8_MMA(1, 0, At, B0); PG8_MMA(1, 1, At, B1); PG8_BAR; PG8_SCHED;
        }
        if constexpr (ALIGN_EPI) { if (wr == 0) PG8_BAR; }
        E(acc, cur, wr, wc, fr, fq);
        if (!has_next) break;
#pragma unroll
        for (int a = 0; a < 2; ++a)
#pragma unroll
            for (int b = 0; b < 2; ++b)
#pragma unroll
                for (int m = 0; m < 4; ++m)
#pragma unroll
                    for (int n = 0; n < 2; ++n) acc[a][b][m][n] = (f32x4){0.f, 0.f, 0.f, 0.f};
        cur = nxt; cA = nA; cB = nB; ++ui;
        if constexpr (ALIGN_EPI) { if (wr == 1) PG8_BAR; }
    }
    PG8_WAIT_V(0);
    if constexpr (!ALIGN_EPI) { if (wr == 0) PG8_BAR; }
    PG8_BAR;
#undef PG8_SA
#undef PG8_SB
#undef PG8_STAGE
#undef PG8_LDA
#undef PG8_LDB
#undef PG8_MMA
#undef PG8_WAIT_V
#undef PG8_WAIT_L
#undef PG8_BAR
#undef PG8_SCHED
}
}

struct CvtJob { const float* src; int ld, K, col0, ntn, valid; bf16_t* dst; int row0, mul; };
__device__ __forceinline__ int cvt_job(const Params& p, int j, CvtJob& o) {
    uchar* ws = p.ws;
    const size_t FW = (size_t)D * DFF;
    switch (j) {
    case 0: o = {p.ffn_wg, DFF, D, 0, 44, 5632, (bf16_t*)(ws + WS_WGU1), 0, 256}; break;
    case 1: o = {p.ffn_wu, DFF, D, 0, 44, 5632, (bf16_t*)(ws + WS_WGU1), 128, 256}; break;
    case 2: o = {p.ffn_wd, D, DFF, 0, 16, 2048, (bf16_t*)(ws + WS_WD1), 0, 128}; break;
    case 3: o = {p.w_in, INW, D, 1024, 8, 1024, (bf16_t*)(ws + WS_WIN), OFF_K, 128}; break;
    case 4: o = {p.w_in, INW, D, 2048, 16, 2048, (bf16_t*)(ws + WS_WIN), OFF_V, 128}; break;
    case 5: o = {p.w_in, INW, D, 7200, 8, 1024, (bf16_t*)(ws + WS_WIN), OFF_NK, 128}; break;
    case 6: o = {p.w_in, INW, D, 8224, 8, 1024, (bf16_t*)(ws + WS_WIN), OFF_NV, 128}; break;
    case 7: o = {p.w_in, INW, D, 6144, 2, 32, (bf16_t*)(ws + WS_WIN), OFF_GF, 128}; break;
    case 8: o = {p.w_in, INW, D, 0, 8, 1024, (bf16_t*)(ws + WS_WIN), OFF_Q, 128}; break;
    case 9: o = {p.w_in, INW, D, 4096, 16, 2048, (bf16_t*)(ws + WS_WIN), OFF_R, 128}; break;
    case 10: o = {p.w_in, INW, D, 6176, 8, 1024, (bf16_t*)(ws + WS_WIN), OFF_NQ, 128}; break;
    case 11: o = {p.w_in, INW, D, 9248, 16, 2048, (bf16_t*)(ws + WS_WIN), OFF_M1, 128}; break;
    case 12: o = {p.w_in, INW, D, 11296, 16, 2048, (bf16_t*)(ws + WS_WIN), OFF_M2, 128}; break;
    case 13: o = {p.w_gla_o, D, D, 0, 16, 2048, (bf16_t*)(ws + WS_WGLAO), 0, 128}; break;
    case 14: o = {p.w_na_o, D, 1024, 0, 16, 2048, (bf16_t*)(ws + WS_WNAO), 0, 128}; break;
    case 15: o = {p.w_out, D, D, 0, 16, 2048, (bf16_t*)(ws + WS_WOUT), 0, 128}; break;
    case 16: o = {p.ffn_wg + FW, DFF, D, 0, 44, 5632, (bf16_t*)(ws + WS_WGU2), 0, 256}; break;
    case 17: o = {p.ffn_wu + FW, DFF, D, 0, 44, 5632, (bf16_t*)(ws + WS_WGU2), 128, 256}; break;
    default: o = {p.ffn_wd + FW, D, DFF, 0, 16, 2048, (bf16_t*)(ws + WS_WD2), 0, 128}; break;
    }
    return (o.K / 128) * o.ntn;
}
constexpr int N_CVT_JOBS = 19;
constexpr int N_CVT_TILES = 6 * 704 + 16 * 106 + 256 + 128 + 256;

struct CvtRegs { f32x4 a[4], b[4]; bf16_t* dst; int K; };
__device__ __forceinline__ void cvt_load(const CvtJob& J, int tl, CvtRegs& R) {
    const int tid = threadIdx.x;
    const int ktiles = J.K / 128, nt = tl / ktiles, kt = tl % ktiles;
    const int k0 = kt * 128, c0 = nt * 128;
    const int n4 = tid & 31, kp = tid >> 5;
    const int col = c0 + 4 * n4;
    R.dst = J.dst + (size_t)(J.row0 + nt * J.mul) * J.K + k0; R.K = J.K;
#pragma unroll
    for (int it = 0; it < 4; ++it) {
        const int kpair = kp + 16 * it;
        R.a[it] = (f32x4){0.f, 0.f, 0.f, 0.f}; R.b[it] = R.a[it];
        if (col < J.valid) { const float* sp = J.src + (size_t)(k0 + 2 * kpair) * J.ld + J.col0 + col; R.a[it] = __builtin_nontemporal_load((const f32x4*)sp); R.b[it] = __builtin_nontemporal_load((const f32x4*)(sp + J.ld)); }
    }
}
__device__ __forceinline__ void cvt_store(LAS uchar* lds, const CvtRegs& R) {
    LAS unsigned* T = (LAS unsigned*)lds;
    const int tid = threadIdx.x, n4 = tid & 31, kp = tid >> 5;
#pragma unroll
    for (int it = 0; it < 4; ++it) {
        const int kpair = kp + 16 * it;
#pragma unroll
        for (int i = 0; i < 4; ++i) T[(4 * n4 + i) * 65 + kpair] = cvt_pk_bf16(R.a[it][i], R.b[it][i]);
    }
    __syncthreads();
#pragma unroll
    for (int it = 0; it < 4; ++it) {
        const int ch = tid + 512 * it, n = ch >> 4, c16 = ch & 15;
        u32x4 v; v.x = T[n * 65 + 4 * c16]; v.y = T[n * 65 + 4 * c16 + 1]; v.z = T[n * 65 + 4 * c16 + 2]; v.w = T[n * 65 + 4 * c16 + 3];
        *(u32x4*)(R.dst + (size_t)n * R.K + 8 * c16) = v;
    }
    __syncthreads();
}

__device__ __forceinline__ void ada_item(LAS uchar* lds, const Params& p, int item) {
    LAS float* sv = (LAS float*)lds;
    LAS float* red = (LAS float*)(lds + 12288);
    const int tid = threadIdx.x, w = tid >> 6, lane = tid & 63;
    const int cb = item >> 1, kh = item & 1;
    for (int i = tid; i < 3 * 1024; i += NTHR) { const int s = i >> 10, k = kh * 1024 + (i & 1023); const float v = s < 2 ? p.c[s * D + k] : p.c_ctx[k]; sv[i] = siluf_(v); }
    __syncthreads();
    f32x4 a0 = (f32x4){0.f, 0.f, 0.f, 0.f}, a1 = a0, a2 = a0;
    const float* wp = p.w_ada + (size_t)(kh * 1024 + w * 128) * NMODC + cb * 256 + lane * 4;
#pragma unroll 8
    for (int k = 0; k < 128; ++k) {
        const f32x4 wv = *(const f32x4*)(wp + (size_t)k * NMODC);
        const int kk = w * 128 + k;
        a0 += sv[kk] * wv; a1 += sv[1024 + kk] * wv; a2 += sv[2048 + kk] * wv;
    }
    *(LAS f32x4*)(red + (w * 3 + 0) * 256 + lane * 4) = a0; *(LAS f32x4*)(red + (w * 3 + 1) * 256 + lane * 4) = a1; *(LAS f32x4*)(red + (w * 3 + 2) * 256 + lane * 4) = a2;
    __syncthreads();
    float* modp = (float*)(p.ws + WS_MODP);
    for (int i = tid; i < 768; i += NTHR) { const int s = i >> 8, col = i & 255; float v = 0.f;
#pragma unroll
        for (int ww = 0; ww < 8; ++ww) v += red[(ww * 3 + s) * 256 + col];
        const int gc = cb * 256 + col; if (kh == 0) v += p.b_ada[gc];
        modp[(size_t)(kh * 3 + s) * NMODC + gc] = v; }
    __syncthreads();
}

__device__ __forceinline__ void phase_prologue(LAS uchar* lds, const Params& p) {
    const int G = gridDim.x, bx = blockIdx.x;
    int t_lo, t_hi;
    if (G == 256) {
        if (bx < 144) { ada_item(lds, p, bx); t_lo = (bx * 89) / 4; t_hi = ((bx + 1) * 89) / 4; }
        else { t_lo = 3204 + (bx - 144) * 30; t_hi = t_lo + 30; }
        if (t_hi > N_CVT_TILES) t_hi = N_CVT_TILES;
    } else {
        for (int i = bx; i < 144; i += G) ada_item(lds, p, i);
        const int per = (N_CVT_TILES + G - 1) / G; t_lo = bx * per; t_hi = t_lo + per; if (t_hi > N_CVT_TILES) t_hi = N_CVT_TILES;
    }
    int j = 0, base = 0; CvtJob J; int cnt = cvt_job(p, 0, J);
    if (t_lo < t_hi) {
        CvtRegs cur, nxt;
        while (t_lo >= base + cnt) { base += cnt; ++j; cnt = cvt_job(p, j, J); }
        cvt_load(J, t_lo - base, cur);
        for (int t = t_lo; t < t_hi; ++t) {
            if (t + 1 < t_hi) { while (t + 1 >= base + cnt) { base += cnt; ++j; cnt = cvt_job(p, j, J); } cvt_load(J, t + 1 - base, nxt); }
            cvt_store(lds, cur);
            cur = nxt;
        }
    }
}

__device__ __forceinline__ f32x4 ld_mod(const float* modp, int s, int idx, int col) {
    const float* a = modp + (size_t)s * NMODC + idx * D + col; const float* b = a + (size_t)3 * NMODC;
    return *(const f32x4*)a + *(const f32x4*)b;
}
__device__ __forceinline__ void st_bf16x4(bf16_t* dst, f32x4 v) { u32x2 w; w.x = cvt_pk_bf16(v[0], v[1]); w.y = cvt_pk_bf16(v[2], v[3]); *(u32x2*)dst = w; }

__device__ __forceinline__ void phase_prenorm1(const Params& p) {
    const int w = threadIdx.x >> 6, lane = threadIdx.x & 63;
    const float* modp = (const float*)(p.ws + WS_MODP); bf16_t* A = (bf16_t*)(p.ws + WS_A);
    for (int item = blockIdx.x; item < NTOK / 8; item += gridDim.x) {
        const int row = item * 8 + w; const int s = row < NLAT ? row / SEQ : 2;
        const float* src = row < NLAT ? p.x + (size_t)row * D : p.ctx + (size_t)(row - NLAT) * D;
        f32x4 v[8]; float ss = 0.f;
#pragma unroll
        for (int j = 0; j < 8; ++j) { v[j] = *(const f32x4*)(src + j * 256 + lane * 4); ss += v[j][0] * v[j][0] + v[j][1] * v[j][1] + v[j][2] * v[j][2] + v[j][3] * v[j][3]; }
        ss = wave_sum(ss); const float rstd = rsqrtf(ss * (1.0f / D) + EPS);
#pragma unroll
        for (int j = 0; j < 8; ++j) { const int col = j * 256 + lane * 4;
            const f32x4 g = *(const f32x4*)(p.norm_g + 0 * D + col), sh = ld_mod(modp, s, 0, col), sc = ld_mod(modp, s, 1, col);
            st_bf16x4(A + (size_t)row * D + col, (v[j] * rstd * g) * (1.0f + sc) + sh); }
    }
}
template <int MODE>
__device__ __forceinline__ void phase_post(const Params& p) {
    const int w = threadIdx.x >> 6, lane = threadIdx.x & 63;
    const float* modp = (const float*)(p.ws + WS_MODP); bf16_t* A = (bf16_t*)(p.ws + WS_A);
    const bf16_t* Y = (const bf16_t*)(p.ws + WS_Y); const bf16_t* YC = (const bf16_t*)(p.ws + WS_YC);
    constexpr int NROWS = MODE == 0 ? NTOK : NLAT;
    constexpr int GI = MODE == 0 ? 2 : (MODE == 1 ? 5 : 8), GP = MODE == 0 ? 1 : (MODE == 1 ? 3 : 5), GN = MODE == 0 ? 2 : 4, SI = MODE == 0 ? 3 : 6;
    constexpr float WRES = MODE == 1 ? 1.0f : 0.5f;
    for (int item = blockIdx.x; item < NROWS / 8; item += gridDim.x) {
        const int row = item * 8 + w; const int s = row < NLAT ? row / SEQ : 2;
        const float* xin = MODE == 0 ? (row < NLAT ? p.x + (size_t)row * D : p.ctx + (size_t)(row - NLAT) * D) : p.out + (size_t)row * D;
        f32x4 y[8], xv8[8]; float ss = 0.f;
#pragma unroll
        for (int j = 0; j < 8; ++j) xv8[j] = *(const f32x4*)(xin + j * 256 + lane * 4);
#pragma unroll
        for (int j = 0; j < 8; ++j) { const int col = j * 256 + lane * 4;
            if (MODE == 0 && row >= NLAT) { const bf16_t* yc = YC + (size_t)(row - NLAT) * D + col; f32x4 a = (f32x4){0.f, 0.f, 0.f, 0.f};
#pragma unroll
                for (int sp = 0; sp < 4; ++sp) { const u32x2 t = *(const u32x2*)(yc + (size_t)sp * NCTX * D); a += (f32x4){bflo(t.x), bfhi(t.x), bflo(t.y), bfhi(t.y)}; }
                y[j] = a; }
            else { const u32x2 t = *(const u32x2*)(Y + (size_t)row * D + col); y[j] = (f32x4){bflo(t.x), bfhi(t.x), bflo(t.y), bfhi(t.y)}; }
            ss += y[j][0] * y[j][0] + y[j][1] * y[j][1] + y[j][2] * y[j][2] + y[j][3] * y[j][3]; }
        ss = wave_sum(ss); const float rstd = rsqrtf(ss * (1.0f / D) + EPS);
        float ss2 = 0.f;
#pragma unroll
        for (int j = 0; j < 8; ++j) { const int col = j * 256 + lane * 4;
            const f32x4 g = *(const f32x4*)(p.norm_g + GP * D + col), gt = ld_mod(modp, s, GI, col), xv = xv8[j];
            const f32x4 x1 = xv + WRES * gt * (y[j] * rstd * g);
            y[j] = x1; ss2 += x1[0] * x1[0] + x1[1] * x1[1] + x1[2] * x1[2] + x1[3] * x1[3];
            if (row < NLAT) *(f32x4*)(p.out + (size_t)row * D + col) = x1; }
        if (MODE == 2) continue;
        ss2 = wave_sum(ss2); const float rstd2 = rsqrtf(ss2 * (1.0f / D) + EPS);
#pragma unroll
        for (int j = 0; j < 8; ++j) { const int col = j * 256 + lane * 4;
            const f32x4 g = *(const f32x4*)(p.norm_g + GN * D + col), sh = ld_mod(modp, s, SI, col), sc = ld_mod(modp, s, SI + 1, col);
            st_bf16x4(A + (size_t)row * D + col, (y[j] * rstd2 * g) * (1.0f + sc) + sh); }
    }
}

constexpr int PREP_PITCH = 264;
constexpr int PREP_TILE = 64 * PREP_PITCH * 2;
__device__ __forceinline__ size_t gla_idx(int b, int h, int dir, int cid) { return (size_t)(((b * 4 + h) * 2 + dir) * NCH + cid); }

__device__ __forceinline__ void gla_prep_item(LAS uchar* lds, const Params& p, int item) {
    const int tid = threadIdx.x, wv = tid >> 6, lane = tid & 63;
    int h, cid, b;
    if (item < NB * 64 * 4) { h = item & 3; const int bc = item >> 2; cid = 4 + (bc & 63); b = bc >> 6; }
    else { const int it2 = item - NB * 64 * 4; h = it2 & 3; const int bc = it2 >> 2; cid = bc & 3; b = bc >> 2; }
    const bool lat = cid >= 4;
    const int rowbase = lat ? b * SEQ + (cid - 4) * 64 : NLAT + b * CTXL + cid * 64;
    const bf16_t* PROJ = (const bf16_t*)(p.ws + WS_PROJ);
    LAS float* Gs = (LAS float*)lds;
    {
        const int i = tid >> 3, c4 = (tid & 7) * 4;
        const u32x2 g = *(const u32x2*)(PROJ + (size_t)(rowbase + i) * LDP + OFF_GF + c4);
        *(LAS f32x4*)(Gs + i * 32 + c4) = (f32x4){bflo(g.x), bfhi(g.x), bflo(g.y), bfhi(g.y)};
    }
    __syncthreads();
    const int wvu = __builtin_amdgcn_readfirstlane(tid >> 6);
    const int d = tid & 255, dir = wvu >> 2;
    float wg[16];
#pragma unroll
    for (int r = 0; r < 16; ++r) wg[r] = p.gla_wg[(size_t)(dir * 16 + r) * 1024 + h * 256 + d] * LOG2E;
    const float bg = p.gla_bg[dir * 1024 + h * 256 + d] * LOG2E;
    const int axis = (wvu >> 1) & 1, fi = d & 63; const bool first = (wvu & 1) == 0;
    const int dpart = first ? d + 64 : d - 64;
    const float freq = __expf(-(float)fi * (9.210340371976184f / 64.0f));
    const float ang_row = (float)(cid - 4) * freq;
    float cs_row, sn_row; __sincosf(ang_row, &sn_row, &cs_row);
    if (!first) sn_row = -sn_row; sn_row = -sn_row;
    const float freq_rev = (first ? -freq : freq) * 0.15915494309189535f;
    bf16_t* QD = (bf16_t*)(p.ws + WS_QD) + gla_idx(b, h, dir, cid) * (64 * 256);
    bf16_t* KET = (bf16_t*)(p.ws + WS_KET) + gla_idx(b, h, dir, cid) * (256 * 64);
    LAS bf16_t* QDs = (LAS bf16_t*)(lds + 8192 + dir * 2 * PREP_TILE);
    LAS bf16_t* KIs = (LAS bf16_t*)(lds + 8192 + dir * 2 * PREP_TILE + PREP_TILE);
    float cum = 0.f;
    unsigned short rk[8], rkp[8], rq[8], rqp[8], nk_[8], nkp[8], nq_[8], nqp[8];
    const bf16_t* pbase = PROJ + (size_t)rowbase * LDP + h * 256;
    const unsigned ok_ = OFF_K + d, okp_ = OFF_K + dpart, oq_ = OFF_Q + d, oqp_ = OFF_Q + dpart;
#define PREP_LOAD(dk_, dkp_, dq_, dqp_, n8_) do { _Pragma("unroll") for (int jj = 0; jj < 8; ++jj) { const int n_ = (n8_) * 8 + jj, i_ = dir ? 63 - n_ : n_; \
        const unsigned to_ = (unsigned)i_ * (unsigned)LDP; dk_[jj] = pbase[to_ + ok_]; \
        if (lat) { dkp_[jj] = pbase[to_ + okp_]; dq_[jj] = pbase[to_ + oq_]; dqp_[jj] = pbase[to_ + oqp_]; } else { dkp_[jj] = 0; dq_[jj] = 0; dqp_[jj] = 0; } } } while (0)
    PREP_LOAD(rk, rkp, rq, rqp, 0);
    for (int n8 = 0; n8 < 8; ++n8) {
        if (n8 < 7) PREP_LOAD(nk_, nkp, nq_, nqp, n8 + 1);
        float ke[8];
#pragma unroll
        for (int jj = 0; jj < 8; ++jj) {
            const int n = n8 * 8 + jj, i = dir ? 63 - n : n;
            const LAS f32x4* gp = (const LAS f32x4*)(Gs + i * 32 + dir * 16);
            float z = bg;
#pragma unroll
            for (int q4 = 0; q4 < 4; ++q4) { const f32x4 gv = gp[q4]; z += gv[0] * wg[q4 * 4] + gv[1] * wg[q4 * 4 + 1] + gv[2] * wg[q4 * 4 + 2] + gv[3] * wg[q4 * 4 + 3]; }
            cum += (fminf(z, 0.f) - __builtin_amdgcn_logf(1.0f + __builtin_amdgcn_exp2f(-fabsf(z)))) * (1.0f / 16.0f);
            float kv = bf2f(rk[jj]);
            if (lat) {
                float cs, sn;
                if (axis == 0) { cs = cs_row; sn = sn_row; } else { const float a = (float)i * freq_rev; cs = __builtin_amdgcn_cosf(a); sn = __builtin_amdgcn_sinf(a); }
                const float kp2 = bf2f(rkp[jj]);
                kv = kv * cs + kp2 * sn;
                float qv = bf2f(rq[jj]); const float qp2 = bf2f(rqp[jj]);
                qv = (qv * cs + qp2 * sn) * 0.0625f;
                const float qd = qv * __builtin_amdgcn_exp2f(cum);
                const bf16_t qb = (bf16_t)(cvt_pk_bf16(qd, 0.f) & 0xffffu);
                QD[(size_t)i * 256 + d] = qb; QDs[i * PREP_PITCH + d] = qb;
            }
            const float ki = kv * __builtin_amdgcn_exp2f(-cum);
            if (lat) KIs[i * PREP_PITCH + d] = (bf16_t)(cvt_pk_bf16(ki, 0.f) & 0xffffu);
            ke[jj] = ki;
        }
        u32x4 o;
        if (dir == 0) { o.x = cvt_pk_bf16(ke[0], ke[1]); o.y = cvt_pk_bf16(ke[2], ke[3]); o.z = cvt_pk_bf16(ke[4], ke[5]); o.w = cvt_pk_bf16(ke[6], ke[7]); *(u32x4*)(KET + (size_t)d * 64 + n8 * 8) = o; }
        else { o.x = cvt_pk_bf16(ke[7], ke[6]); o.y = cvt_pk_bf16(ke[5], ke[4]); o.z = cvt_pk_bf16(ke[3], ke[2]); o.w = cvt_pk_bf16(ke[1], ke[0]); *(u32x4*)(KET + (size_t)d * 64 + (7 - n8) * 8) = o; }
#pragma unroll
        for (int jj = 0; jj < 8; ++jj) { rk[jj] = nk_[jj]; rkp[jj] = nkp[jj]; rq[jj] = nq_[jj]; rqp[jj] = nqp[jj]; }
    }
#undef PREP_LOAD
    ((float*)(p.ws + WS_DEC))[gla_idx(b, h, dir, cid) * 256 + d] = __builtin_amdgcn_exp2f(cum);
    {
        bf16_t* VT = (bf16_t*)(p.ws + WS_VT) + (size_t)((b * 4 + h) * NCH + cid) * (512 * 64);
        const bf16_t* vsrc = PROJ + (size_t)rowbase * LDP + OFF_V + h * 512 + tid;
        unsigned short e[64];
#pragma unroll
        for (int t = 0; t < 64; ++t) e[t] = vsrc[(size_t)t * LDP];
#pragma unroll
        for (int n8 = 0; n8 < 8; ++n8) {
            u32x4 o; o.x = e[n8 * 8] | ((unsigned)e[n8 * 8 + 1] << 16); o.y = e[n8 * 8 + 2] | ((unsigned)e[n8 * 8 + 3] << 16); o.z = e[n8 * 8 + 4] | ((unsigned)e[n8 * 8 + 5] << 16); o.w = e[n8 * 8 + 6] | ((unsigned)e[n8 * 8 + 7] << 16);
            *(u32x4*)(VT + (size_t)tid * 64 + n8 * 8) = o;
        }
    }
    __syncthreads();
    if (lat) {
        const int wdir = wv >> 2, ib = wv & 3, fr = lane & 15, g = lane >> 4;
        const LAS bf16_t* Qs = (const LAS bf16_t*)(lds + 8192 + wdir * 2 * PREP_TILE);
        const LAS bf16_t* Ks = (const LAS bf16_t*)(lds + 8192 + wdir * 2 * PREP_TILE + PREP_TILE);
        f32x4 acc[4];
#pragma unroll
        for (int nb = 0; nb < 4; ++nb) acc[nb] = (f32x4){0.f, 0.f, 0.f, 0.f};
        bf16x8 qf[8];
#pragma unroll
        for (int kk = 0; kk < 8; ++kk) qf[kk] = *(const LAS bf16x8*)(Qs + (16 * ib + fr) * PREP_PITCH + 32 * kk + 8 * g);
#pragma unroll
        for (int nb = 0; nb < 4; ++nb) {
            bf16x8 kf[8];
#pragma unroll
            for (int kk = 0; kk < 8; ++kk) kf[kk] = *(const LAS bf16x8*)(Ks + (16 * nb + fr) * PREP_PITCH + 32 * kk + 8 * g);
            __builtin_amdgcn_sched_barrier(0);
#pragma unroll
            for (int kk = 0; kk < 8; ++kk) acc[nb] = __builtin_amdgcn_mfma_f32_16x16x32_bf16(kf[kk], qf[kk], acc[nb], 0, 0, 0);
        }
        bf16_t* PM = (bf16_t*)(p.ws + WS_PM) + gla_idx(b, h, wdir, cid) * 4096;
        const int i = 16 * ib + fr;
#pragma unroll
        for (int nb = 0; nb < 4; ++nb) {
            float v[4];
#pragma unroll
            for (int r = 0; r < 4; ++r) { const int j = 16 * nb + 4 * g + r; const bool keep = wdir ? (j >= i) : (j <= i); v[r] = keep ? acc[nb][r] : 0.f; }
            u32x2 o; o.x = cvt_pk_bf16(v[0], v[1]); o.y = cvt_pk_bf16(v[2], v[3]);
            *(u32x2*)(PM + (size_t)i * 64 + 16 * nb + 4 * g) = o;
        }
    }
    __syncthreads();
}
__device__ __forceinline__ void na_vt_item(const Params& p, int item) {
    const int tid = threadIdx.x; const int blk = item % NCH, b = item / NCH; const bool lat = blk >= 4;
    const int rowbase = lat ? b * SEQ + (blk - 4) * 64 : NLAT + b * CTXL + blk * 64;
    const bf16_t* PROJ = (const bf16_t*)(p.ws + WS_PROJ);
    const int c = 2 * tid, h = c >> 6, dv = c & 63;
    const bf16_t* src = PROJ + (size_t)rowbase * LDP + OFF_NV + c;
    bf16_t* dst; int pitch;
    if (lat) { dst = (bf16_t*)(p.ws + WS_NVTL) + ((size_t)((b * 16 + h) * 64 + (blk - 4)) * 64 + dv) * 64; pitch = 64; }
    else { dst = (bf16_t*)(p.ws + WS_NVTC) + ((size_t)(b * 16 + h) * 64 + dv) * 256 + blk * 64; pitch = 256; }
    unsigned e[64];
#pragma unroll
    for (int t = 0; t < 64; ++t) e[t] = *(const unsigned*)(src + (size_t)t * LDP);
#pragma unroll
    for (int n8 = 0; n8 < 8; ++n8) {
        const unsigned* q = e + n8 * 8;
        u32x4 lo, hi;
        lo.x = (q[0] & 0xffffu) | (q[1] << 16); lo.y = (q[2] & 0xffffu) | (q[3] << 16); lo.z = (q[4] & 0xffffu) | (q[5] << 16); lo.w = (q[6] & 0xffffu) | (q[7] << 16);
        hi.x = (q[0] >> 16) | (q[1] & 0xffff0000u); hi.y = (q[2] >> 16) | (q[3] & 0xffff0000u); hi.z = (q[4] >> 16) | (q[5] & 0xffff0000u); hi.w = (q[6] >> 16) | (q[7] & 0xffff0000u);
        *(u32x4*)(dst + n8 * 8) = lo; *(u32x4*)(dst + pitch + n8 * 8) = hi;
    }
}

constexpr int ST_PITCH = 264, VT_PITCH = 72;
constexpr int SC_ST = 0, SC_QD = 64 * ST_PITCH * 2, SC_VT = 2 * 64 * ST_PITCH * 2, SC_PM = SC_VT + 64 * VT_PITCH * 2, SC_KT = SC_PM + 64 * VT_PITCH * 2, SC_DC = SC_KT + 256 * VT_PITCH * 2;
__device__ __forceinline__ int scan_cid(int n, int dir) { return n < 4 ? (dir ? 3 - n : n) : (dir ? 67 - (n - 4) : n); }

__device__ __forceinline__ void gla_scan_task(LAS uchar* lds, const Params& p, int task) {
    const int tid = threadIdx.x, w = __builtin_amdgcn_readfirstlane(tid >> 6), lane = tid & 63;
    const int xcd = task & 7, jj = task >> 3, combo = xcd * 2 + (jj >> 3), sl = jj & 7;
    const int b = combo >> 3, h = (combo >> 1) & 3, dir = combo & 1, dv0 = sl * 64;
    const int l32 = lane & 31, hf = lane >> 5;
    const bool isU = w >= 4; const int u = w & 3;
    const int dvb = u >> 1, ibk = u & 1;
    LAS bf16_t* ST = (LAS bf16_t*)(lds + SC_ST); LAS bf16_t* QDs = (LAS bf16_t*)(lds + SC_QD); LAS bf16_t* VTs = (LAS bf16_t*)(lds + SC_VT); LAS bf16_t* PMs = (LAS bf16_t*)(lds + SC_PM);
    LAS bf16_t* KTs = (LAS bf16_t*)(lds + SC_KT); LAS float* DCs = (LAS float*)(lds + SC_DC);
    for (int i = tid; i < 64 * ST_PITCH / 2; i += NTHR) ((LAS unsigned*)lds)[i] = 0u;
    const bf16_t* QDb = (const bf16_t*)(p.ws + WS_QD); const bf16_t* KITb = (const bf16_t*)(p.ws + WS_KET); const bf16_t* PMb = (const bf16_t*)(p.ws + WS_PM);
    const float* DECb = (const float*)(p.ws + WS_DEC); const bf16_t* VTb = (const bf16_t*)(p.ws + WS_VT);
    bf16_t* Ob = (bf16_t*)(p.ws + (dir ? WS_OB : WS_OF));
    f32x16 S00, S01, S10, S11;
#pragma unroll
    for (int i = 0; i < 16; ++i) { S00[i] = 0.f; S01[i] = 0.f; S10[i] = 0.f; S11[i] = 0.f; }
    const int vrow = tid >> 3, vc = (tid & 7) * 8;
    u32x4 qd_r[4], vt_r, pm_r, kt_r[4]; f32x4 dc_r;
#define SC_FETCH(n_) do { const int cid_ = scan_cid((n_), dir); const size_t gi_ = gla_idx(b, h, dir, cid_); \
        vt_r = *(const u32x4*)(VTb + (size_t)((b * 4 + h) * NCH + cid_) * (512 * 64) + (size_t)(dv0 + vrow) * 64 + vc); \
        _Pragma("unroll") for (int k4 = 0; k4 < 4; ++k4) kt_r[k4] = *(const u32x4*)(KITb + gi_ * (256 * 64) + (size_t)(tid + 512 * k4) * 8); \
        if (tid < 64) dc_r = *(const f32x4*)(DECb + gi_ * 256 + 4 * tid); \
        if ((n_) >= 4) { pm_r = *(const u32x4*)(PMb + gi_ * 4096 + vrow * 64 + vc); \
            _Pragma("unroll") for (int k4 = 0; k4 < 4; ++k4) { const int ch_ = tid + 512 * k4; qd_r[k4] = *(const u32x4*)(QDb + gi_ * (64 * 256) + (size_t)(ch_ >> 5) * 256 + (ch_ & 31) * 8); } } } while (0)
#define SC_COMMIT(n_) do { *(LAS u32x4*)(VTs + vrow * VT_PITCH + vc) = vt_r; \
        _Pragma("unroll") for (int k4 = 0; k4 < 4; ++k4) { const int ch_ = tid + 512 * k4; *(LAS u32x4*)(KTs + (ch_ >> 3) * VT_PITCH + (ch_ & 7) * 8) = kt_r[k4]; } \
        if (tid < 64) *(LAS f32x4*)(DCs + 4 * tid) = dc_r; \
        if ((n_) >= 4) { *(LAS u32x4*)(PMs + vrow * VT_PITCH + vc) = pm_r; \
            _Pragma("unroll") for (int k4 = 0; k4 < 4; ++k4) { const int ch_ = tid + 512 * k4; *(LAS u32x4*)(QDs + (ch_ >> 5) * ST_PITCH + (ch_ & 31) * 8) = qd_r[k4]; } } } while (0)
    if (isU) __builtin_amdgcn_s_setprio(2);
    SC_FETCH(0);
    SC_COMMIT(0);
    __syncthreads();
    for (int n = 0; n < NCH; ++n) {
        if (n + 1 < NCH) SC_FETCH(n + 1);
        if (isU) {
            f32x4 dec[2][4]; bf16x8 kit[8];
#pragma unroll
            for (int rb = 0; rb < 2; ++rb)
#pragma unroll
                for (int j4 = 0; j4 < 4; ++j4) dec[rb][j4] = *(const LAS f32x4*)(DCs + 64 * u + 32 * rb + 8 * j4 + 4 * hf);
#pragma unroll
            for (int rb = 0; rb < 2; ++rb)
#pragma unroll
                for (int kk = 0; kk < 4; ++kk) kit[rb * 4 + kk] = *(const LAS bf16x8*)(KTs + (64 * u + 32 * rb + l32) * VT_PITCH + 16 * kk + 8 * hf);
            const LAS bf16_t* vb0 = VTs + l32 * VT_PITCH + 8 * hf; const LAS bf16_t* vb1 = vb0 + 32 * VT_PITCH;
            bf16x8 ua[4], ub[4];
#pragma unroll
            for (int kk = 0; kk < 4; ++kk) { ua[kk] = *(const LAS bf16x8*)(vb0 + 16 * kk); ub[kk] = *(const LAS bf16x8*)(vb1 + 16 * kk); }
#pragma unroll
            for (int kk = 0; kk < 4; ++kk) {
                S00 = __builtin_amdgcn_mfma_f32_32x32x16_bf16(kit[kk], ua[kk], S00, 0, 0, 0);
                S01 = __builtin_amdgcn_mfma_f32_32x32x16_bf16(kit[kk], ub[kk], S01, 0, 0, 0);
                S10 = __builtin_amdgcn_mfma_f32_32x32x16_bf16(kit[4 + kk], ua[kk], S10, 0, 0, 0);
                S11 = __builtin_amdgcn_mfma_f32_32x32x16_bf16(kit[4 + kk], ub[kk], S11, 0, 0, 0); }
#pragma unroll
            for (int j4 = 0; j4 < 4; ++j4)
#pragma unroll
                for (int r = 0; r < 4; ++r) { S00[j4 * 4 + r] *= dec[0][j4][r]; S01[j4 * 4 + r] *= dec[0][j4][r]; S10[j4 * 4 + r] *= dec[1][j4][r]; S11[j4 * 4 + r] *= dec[1][j4][r]; }
        } else if (n >= 4) {
            const int cid = scan_cid(n, dir);
            f32x16 o;
#pragma unroll
            for (int i = 0; i < 16; ++i) o[i] = 0.f;
            const LAS bf16_t* sa = ST + (32 * dvb + l32) * ST_PITCH + 8 * hf; const LAS bf16_t* qb_ = QDs + (32 * ibk + l32) * ST_PITCH + 8 * hf;
            const LAS bf16_t* va = VTs + (32 * dvb + l32) * VT_PITCH + 8 * hf; const LAS bf16_t* pb = PMs + (32 * ibk + l32) * VT_PITCH + 8 * hf;
#pragma unroll
            for (int half = 0; half < 2; ++half) {
                bf16x8 fa[8], fb[8];
#pragma unroll
                for (int kk = 0; kk < 8; ++kk) { fa[kk] = *(const LAS bf16x8*)(sa + 16 * (half * 8 + kk)); fb[kk] = *(const LAS bf16x8*)(qb_ + 16 * (half * 8 + kk)); }
#pragma unroll
                for (int kk = 0; kk < 8; ++kk) o = __builtin_amdgcn_mfma_f32_32x32x16_bf16(fa[kk], fb[kk], o, 0, 0, 0);
            }
            {
                bf16x8 fa[4], fb[4];
#pragma unroll
                for (int q = 0; q < 4; ++q) { fa[q] = *(const LAS bf16x8*)(va + 16 * q); fb[q] = *(const LAS bf16x8*)(pb + 16 * q); }
#pragma unroll
                for (int q = 0; q < 4; ++q) o = __builtin_amdgcn_mfma_f32_32x32x16_bf16(fa[q], fb[q], o, 0, 0, 0);
            }
            bf16_t* op = Ob + (size_t)(b * SEQ + (cid - 4) * 64 + 32 * ibk + l32) * D + h * 512 + dv0 + 32 * dvb + 4 * hf;
#pragma unroll
            for (int j4 = 0; j4 < 4; ++j4) { u32x2 ov; ov.x = cvt_pk_bf16(o[j4 * 4], o[j4 * 4 + 1]); ov.y = cvt_pk_bf16(o[j4 * 4 + 2], o[j4 * 4 + 3]); *(u32x2*)(op + 8 * j4) = ov; }
        }
        __syncthreads();
        if (isU) {
            LAS bf16_t* stw = ST + l32 * ST_PITCH + 64 * u + 4 * hf;
#pragma unroll
            for (int j4 = 0; j4 < 4; ++j4) { u32x2 sv;
                sv.x = cvt_pk_bf16(S00[j4 * 4], S00[j4 * 4 + 1]); sv.y = cvt_pk_bf16(S00[j4 * 4 + 2], S00[j4 * 4 + 3]); *(LAS u32x2*)(stw + 8 * j4) = sv;
                sv.x = cvt_pk_bf16(S01[j4 * 4], S01[j4 * 4 + 1]); sv.y = cvt_pk_bf16(S01[j4 * 4 + 2], S01[j4 * 4 + 3]); *(LAS u32x2*)(stw + 32 * ST_PITCH + 8 * j4) = sv;
                sv.x = cvt_pk_bf16(S10[j4 * 4], S10[j4 * 4 + 1]); sv.y = cvt_pk_bf16(S10[j4 * 4 + 2], S10[j4 * 4 + 3]); *(LAS u32x2*)(stw + 32 + 8 * j4) = sv;
                sv.x = cvt_pk_bf16(S11[j4 * 4], S11[j4 * 4 + 1]); sv.y = cvt_pk_bf16(S11[j4 * 4 + 2], S11[j4 * 4 + 3]); *(LAS u32x2*)(stw + 32 * ST_PITCH + 32 + 8 * j4) = sv; }
        }
        if (n + 1 < NCH) SC_COMMIT(n + 1);
        __syncthreads();
    }
    __builtin_amdgcn_s_setprio(0);
#undef SC_FETCH
#undef SC_COMMIT
}

constexpr int NA_KV = 24576, NA_KP = 72, NA_CP = 264;
constexpr int NA_QW = 20480;
__device__ __forceinline__ void na_item(LAS uchar* lds, const Params& p, int it) {
    const int tid = threadIdx.x, w = tid >> 6, lane = tid & 63, fr = lane & 15, g = lane >> 4;
    const int r = it & 63, h = (it >> 6) & 15, b = it >> 10;
    const int qb = w & 3, kind = w >> 2;
    if (__builtin_amdgcn_readfirstlane(kind) == 0) __builtin_amdgcn_s_setprio(1); else __builtin_amdgcn_s_setprio(0);
    LAS float* rpbS = (LAS float*)lds;
    LAS float* CBm = (LAS float*)(lds + 2048);
    LAS float* CBl = (LAS float*)(lds + 2048 + 256);
    LAS float* CBo = (LAS float*)(lds + 4096);
    LAS bf16_t* KL = (LAS bf16_t*)(lds + NA_KV);
    LAS bf16_t* KC = (LAS bf16_t*)(lds + NA_KV + 512 * NA_KP * 2);
    const bf16_t* PROJ = (const bf16_t*)(p.ws + WS_PROJ);
    const int rs = min(max(r - 4, 0), 56);
    u32x4 st[12];
    {
        const int c8 = (tid & 7) * 8;
#pragma unroll
        for (int k = 0; k < 8; ++k) { const int key = (tid >> 3) + 64 * k; st[k] = *(const u32x4*)(PROJ + (size_t)(b * SEQ + (rs + k) * 64 + (tid >> 3)) * LDP + OFF_NK + h * 64 + c8); (void)key; }
#pragma unroll
        for (int k = 0; k < 4; ++k) st[8 + k] = *(const u32x4*)(PROJ + (size_t)(NLAT + b * CTXL + (tid >> 3) + 64 * k) * LDP + OFF_NK + h * 64 + c8);
    }
    const int c0 = qb == 0 ? 0 : (qb == 1 ? 8 : (qb == 2 ? 24 : 32));
    const int j = 16 * qb + fr;
    const int cs = min(max(j - 8, 0), 48);
    const bf16_t* qrow = PROJ + (size_t)(b * SEQ + r * 64 + j) * LDP + OFF_NQ + h * 64 + 8 * g;
    const bf16x8 q0 = *(const bf16x8*)qrow, q1 = *(const bf16x8*)(qrow + 32);
    if (tid < 480) { const int rw = tid >> 5, cc = tid & 31; rpbS[tid] = cc < 31 ? p.na_rpb[h * 465 + rw * 31 + cc] * LOG2E : -1e30f; }
    {
        const int c8 = (tid & 7) * 8, kr = tid >> 3;
#pragma unroll
        for (int k = 0; k < 8; ++k) *(LAS u32x4*)(KL + (kr + 64 * k) * NA_KP + c8) = st[k];
#pragma unroll
        for (int k = 0; k < 4; ++k) *(LAS u32x4*)(KC + (kr + 64 * k) * NA_KP + c8) = st[8 + k];
    }
    __syncthreads();
    {
        const bf16_t* vl = (const bf16_t*)(p.ws + WS_NVTL) + (size_t)((b * 16 + h) * 64 + rs) * (64 * 64);
#pragma unroll
        for (int k = 0; k < 8; ++k) st[k] = *(const u32x4*)(vl + (size_t)(tid + 512 * k) * 8);
        const bf16_t* vc = (const bf16_t*)(p.ws + WS_NVTC) + (size_t)(b * 16 + h) * (64 * 256);
#pragma unroll
        for (int k = 0; k < 4; ++k) st[8 + k] = *(const u32x4*)(vc + (size_t)(tid + 512 * k) * 8);
    }
    const int mk = 8 * (fr >> 2) + (fr & 3);
    f32x4 s[16];
#pragma unroll
    for (int kb = 0; kb < 16; ++kb) {
        const int pp = kb >> 1, e = kb & 1;
        const LAS bf16_t* krow = kind == 0 ? KL + (pp * 64 + c0 + mk + 4 * e) * NA_KP + 8 * g : KC + (32 * pp + mk + 4 * e) * NA_KP + 8 * g;
        const bf16x8 k0 = *(const LAS bf16x8*)krow, k1 = *(const LAS bf16x8*)(krow + 32);
        f32x4 a = (f32x4){0.f, 0.f, 0.f, 0.f};
        a = __builtin_amdgcn_mfma_f32_16x16x32_bf16(k0, q0, a, 0, 0, 0);
        a = __builtin_amdgcn_mfma_f32_16x16x32_bf16(k1, q1, a, 0, 0, 0);
        s[kb] = a;
    }
    const float sc = 0.125f * LOG2E;
    float mx = -1e30f;
    if (kind == 0) {
        int colb[8];
        const int rowbase = (rs - r + 7) * 32;
#pragma unroll
        for (int x = 0; x < 8; ++x) { const int kc = c0 + 8 * g + x; const bool ok = (kc >= cs) && (kc < cs + 16); colb[x] = rowbase + (ok ? kc - j + 15 : 31); }
#pragma unroll
        for (int kb = 0; kb < 16; ++kb) {
            const int pp = kb >> 1, e = kb & 1;
#pragma unroll
            for (int i = 0; i < 4; ++i) { const float t = s[kb][i] * sc + rpbS[colb[4 * e + i] + pp * 32]; s[kb][i] = t; mx = fmaxf(mx, t); }
        }
    } else {
#pragma unroll
        for (int kb = 0; kb < 16; ++kb)
#pragma unroll
            for (int i = 0; i < 4; ++i) { const float t = s[kb][i] * sc; s[kb][i] = t; mx = fmaxf(mx, t); }
    }
    mx = fmaxf(mx, __shfl_xor(mx, 16)); mx = fmaxf(mx, __shfl_xor(mx, 32));
    float l = 0.f;
#pragma unroll
    for (int kb = 0; kb < 16; ++kb)
#pragma unroll
        for (int i = 0; i < 4; ++i) { const float e2 = __builtin_amdgcn_exp2f(s[kb][i] - mx); s[kb][i] = e2; l += e2; }
    l += __shfl_xor(l, 16); l += __shfl_xor(l, 32);
    __syncthreads();
    {
#pragma unroll
        for (int k = 0; k < 8; ++k) { const int ch = tid + 512 * k; *(LAS u32x4*)(KL + (ch >> 3) * NA_KP + (ch & 7) * 8) = st[k]; }
#pragma unroll
        for (int k = 0; k < 4; ++k) { const int ch = tid + 512 * k; *(LAS u32x4*)(KC + (ch >> 5) * NA_CP + (ch & 31) * 8) = st[8 + k]; }
    }
    __syncthreads();
    f32x4 o[4];
#pragma unroll
    for (int dvb = 0; dvb < 4; ++dvb) o[dvb] = (f32x4){0.f, 0.f, 0.f, 0.f};
#pragma unroll
    for (int pp = 0; pp < 8; ++pp) {
        u32x4 pk; pk.x = cvt_pk_bf16(s[2 * pp][0], s[2 * pp][1]); pk.y = cvt_pk_bf16(s[2 * pp][2], s[2 * pp][3]); pk.z = cvt_pk_bf16(s[2 * pp + 1][0], s[2 * pp + 1][1]); pk.w = cvt_pk_bf16(s[2 * pp + 1][2], s[2 * pp + 1][3]);
        const bf16x8 pf = as_bf16x8(pk);
#pragma unroll
        for (int dvb = 0; dvb < 4; ++dvb) {
            const LAS bf16_t* vp = kind == 0 ? KL + (pp * 64 + 16 * dvb + fr) * NA_KP + c0 + 8 * g : KC + (16 * dvb + fr) * NA_CP + 32 * pp + 8 * g;
            o[dvb] = __builtin_amdgcn_mfma_f32_16x16x32_bf16(*(const LAS bf16x8*)vp, pf, o[dvb], 0, 0, 0);
        }
    }
    if (kind == 1) {
        if (g == 0) { CBm[qb * 16 + fr] = mx; CBl[qb * 16 + fr] = l; }
#pragma unroll
        for (int dvb = 0; dvb < 4; ++dvb) *(LAS f32x4*)(CBo + (qb * 64 + lane) * 16 + dvb * 4) = o[dvb];
    }
    __syncthreads();
    if (kind == 0) {
        const float m2 = CBm[qb * 16 + fr], l2 = CBl[qb * 16 + fr];
        const float M = fmaxf(mx, m2), a1 = __builtin_amdgcn_exp2f(mx - M), a2 = __builtin_amdgcn_exp2f(m2 - M);
        const float inv = fast_rcp(l * a1 + l2 * a2);
        bf16_t* op = (bf16_t*)(p.ws + WS_NAO) + (size_t)(b * SEQ + r * 64 + j) * 1024 + h * 64 + 4 * g;
#pragma unroll
        for (int dvb = 0; dvb < 4; ++dvb) {
            const f32x4 o2 = *(const LAS f32x4*)(CBo + (qb * 64 + lane) * 16 + dvb * 4);
            const f32x4 v = (o[dvb] * a1 + o2 * a2) * inv;
            u32x2 ov; ov.x = cvt_pk_bf16(v[0], v[1]); ov.y = cvt_pk_bf16(v[2], v[3]); *(u32x2*)(op + 16 * dvb) = ov;
        }
    }
    __syncthreads();
}

__device__ __forceinline__ void phase_readout(const Params& p) {
    const int w = threadIdx.x >> 6, lane = threadIdx.x & 63;
    const bf16_t* OF = (const bf16_t*)(p.ws + WS_OF); const bf16_t* OB = (const bf16_t*)(p.ws + WS_OB); const bf16_t* PROJ = (const bf16_t*)(p.ws + WS_PROJ);
    bf16_t* AG = (bf16_t*)(p.ws + WS_AG);
    for (int item = blockIdx.x; item < NLAT / 8; item += gridDim.x) {
        const int row = item * 8 + w;
        u32x4 av[4], bv[4], rv4[4];
#pragma unroll
        for (int h = 0; h < 4; ++h) { const int col = h * 512 + lane * 8;
            av[h] = *(const u32x4*)(OF + (size_t)row * D + col); bv[h] = *(const u32x4*)(OB + (size_t)row * D + col); rv4[h] = *(const u32x4*)(PROJ + (size_t)row * LDP + OFF_R + col); }
        const f32x4 g0 = *(const f32x4*)(p.gla_norm_g + lane * 8), g1 = *(const f32x4*)(p.gla_norm_g + lane * 8 + 4);
#pragma unroll
        for (int h = 0; h < 4; ++h) {
            const int col = h * 512 + lane * 8;
            const u32x4 a = av[h], bq = bv[h], rr = rv4[h];
            float o[8];
            o[0] = bflo(a.x) + bflo(bq.x); o[1] = bfhi(a.x) + bfhi(bq.x); o[2] = bflo(a.y) + bflo(bq.y); o[3] = bfhi(a.y) + bfhi(bq.y);
            o[4] = bflo(a.z) + bflo(bq.z); o[5] = bfhi(a.z) + bfhi(bq.z); o[6] = bflo(a.w) + bflo(bq.w); o[7] = bfhi(a.w) + bfhi(bq.w);
            float ss = 0.f;
#pragma unroll
            for (int i = 0; i < 8; ++i) ss += o[i] * o[i];
            ss = wave_sum(ss); const float rstd = rsqrtf(ss * (1.0f / 512.0f) + EPS);
            const float rv[8] = {bflo(rr.x), bfhi(rr.x), bflo(rr.y), bfhi(rr.y), bflo(rr.z), bfhi(rr.z), bflo(rr.w), bfhi(rr.w)};
            float v[8];
#pragma unroll
            for (int i = 0; i < 8; ++i) v[i] = o[i] * rstd * (i < 4 ? g0[i] : g1[i - 4]) * siluf_(rv[i]);
            u32x4 ov; ov.x = cvt_pk_bf16(v[0], v[1]); ov.y = cvt_pk_bf16(v[2], v[3]); ov.z = cvt_pk_bf16(v[4], v[5]); ov.w = cvt_pk_bf16(v[6], v[7]);
            *(u32x4*)(AG + (size_t)row * D + col) = ov;
        }
    }
}

constexpr int N_PHASES = 15;
__global__ void __launch_bounds__(NTHR, 2) mk_fwd(Params p) {
    extern __shared__ __attribute__((aligned(16))) uchar lds_raw[];
    LAS uchar* lds = (LAS uchar*)lds_raw;
    const int G = gridDim.x, bx = blockIdx.x;
    uchar* ws = p.ws;
#define IN(k) (p.ph_lo <= (k) && (k) < p.ph_hi)
    LAS unsigned* xbst = (LAS unsigned*)(lds + LDS_BYTES - 16);
    if (threadIdx.x == 0) { xbst[0] = 0u; xbst[1] = 0u; xbst[2] = 0u; xbst[3] = 0u; }
    __syncthreads();
    const XcdBarrier xbar = xcd_barrier_post((unsigned*)(ws + WS_BAR), (volatile LAS unsigned*)xbst);
    if (p.ph_lo < 0) cg::this_grid().sync();
#define SEAM(k) do { if (IN(k) && IN((k) + 1)) { xcd_barrier(xbar); for (int xs_ = 0; xs_ < MK_EXTRA_SYNC; ++xs_) xcd_barrier(xbar); } } while (0)
#define REPS(k) for (int rep_ = 0; rep_ < 1 + ((MK_REP_MASK >> (k)) & 1); ++rep_)
    bf16_t* A = (bf16_t*)(ws + WS_A); bf16_t* H = (bf16_t*)(ws + WS_H); bf16_t* Y = (bf16_t*)(ws + WS_Y); bf16_t* YC = (bf16_t*)(ws + WS_YC);
    bf16_t* PROJ = (bf16_t*)(ws + WS_PROJ);

    if (IN(0)) REPS(0) { phase_prologue(lds, p); } SEAM(0);
    if (IN(1)) REPS(1) { phase_prenorm1(p); } SEAM(1);
    if (IN(2)) REPS(2) {
        { pg8::Gemm g{A, (const bf16_t*)(ws + WS_WGU1), NLAT, 2 * DFF, D, D, D}; pg8::StaticOrder S; S.init(NLAT, 2 * DFF, G, bx); pg8::EpiSiluMul E{H, DFF}; pg8::gemm_phase(lds, g, S, E); }
        { pg8::Gemm g{A + (size_t)NLAT * D, (const bf16_t*)(ws + WS_WGU1), NCTX, 2 * DFF, D, D, D}; pg8::StaticOrder S; S.init(NCTX, 2 * DFF, G, G - 1 - bx); pg8::EpiSiluMul E{H + (size_t)NLAT * DFF, DFF}; pg8::gemm_phase(lds, g, S, E); }
    } SEAM(2);
    if (IN(3)) REPS(3) {
        { pg8::Gemm g{H, (const bf16_t*)(ws + WS_WD1), NLAT, D, DFF, DFF, DFF}; pg8::StaticOrder S; S.init(NLAT, D, G, bx); pg8::EpiBf16 E{Y, D}; pg8::gemm_phase(lds, g, S, E); }
        for (int sp = 0; sp < 4; ++sp) { pg8::Gemm g{H + (size_t)NLAT * DFF + sp * 1408, (const bf16_t*)(ws + WS_WD1) + sp * 1408, NCTX, D, 1408, DFF, DFF}; pg8::StaticOrder S; S.init(NCTX, D, G, (bx + G - 16 * sp) % G);
            pg8::EpiBf16 E{YC + (size_t)sp * NCTX * D, D}; pg8::gemm_phase(lds, g, S, E); }
    } SEAM(3);
    if (IN(4)) REPS(4) { phase_post<0>(p); } SEAM(4);
    if (IN(5)) REPS(5) {
        { pg8::Gemm g{A, (const bf16_t*)(ws + WS_WIN), NLAT, LDP, D, D, D}; pg8::StaticOrder S; S.init(NLAT, LDP, G, bx); pg8::EpiBf16 E{PROJ, LDP}; pg8::gemm_phase(lds, g, S, E); }
        { pg8::Gemm g{A + (size_t)NLAT * D, (const bf16_t*)(ws + WS_WIN), NCTX, NCTXCOLS, D, D, D}; pg8::StaticOrder S; S.init(NCTX, NCTXCOLS, G, G - 1 - bx); pg8::EpiBf16 E{PROJ + (size_t)NLAT * LDP, LDP}; pg8::gemm_phase(lds, g, S, E); }
    } SEAM(5);
    if (IN(6)) REPS(6) {
        const int n_items = NB * NCH * 4 + NB * NCH;
        for (int it = bx; it < n_items; it += G) { if (it < NB * NCH * 4) gla_prep_item(lds, p, it); else na_vt_item(p, it - NB * NCH * 4); }
    } SEAM(6);
    if (IN(7)) REPS(7) {
        for (int t = bx; t < 128; t += G) gla_scan_task(lds, p, t);
        __syncthreads();
        {
            unsigned* qhead = (unsigned*)(ws + WS_CTR);
            if (threadIdx.x == 0) *(LAS unsigned*)(lds + NA_QW) = atomicAdd(qhead, 1u);
            __syncthreads();
            unsigned it = *(LAS unsigned*)(lds + NA_QW);
            __syncthreads();
            while (it < (unsigned)(NB * 16 * 64)) {
                unsigned nxt = 0u;
                if (threadIdx.x == 0) nxt = atomicAdd(qhead, 1u);
                na_item(lds, p, (int)it);
                if (threadIdx.x == 0) *(LAS unsigned*)(lds + NA_QW) = nxt;
                __syncthreads();
                it = *(LAS unsigned*)(lds + NA_QW);
                __syncthreads();
            }
        }
    } SEAM(7);
    if (IN(8)) REPS(8) {
        phase_readout(p);
        { pg8::Gemm g{(const bf16_t*)(ws + WS_NAO), (const bf16_t*)(ws + WS_WNAO), NLAT, D, 1024, 1024, 1024}; pg8::StaticOrder S; S.init(NLAT, D, G, bx); pg8::EpiGate2 E{(bf16_t*)(ws + WS_G2), PROJ + OFF_M2}; pg8::gemm_phase(lds, g, S, E); }
    } SEAM(8);
    if (IN(9)) REPS(9) { pg8::Gemm g{(const bf16_t*)(ws + WS_AG), (const bf16_t*)(ws + WS_WGLAO), NLAT, D, D, D, D}; pg8::StaticOrder S; S.init(NLAT, D, G, bx); pg8::EpiMerge E{(bf16_t*)(ws + WS_MG), PROJ + OFF_M1, (const bf16_t*)(ws + WS_G2)}; pg8::gemm_phase(lds, g, S, E); } SEAM(9);
    if (IN(10)) REPS(10) { pg8::Gemm g{(const bf16_t*)(ws + WS_MG), (const bf16_t*)(ws + WS_WOUT), NLAT, D, D, D, D}; pg8::StaticOrder S; S.init(NLAT, D, G, bx); pg8::EpiBf16 E{Y, D}; pg8::gemm_phase(lds, g, S, E); } SEAM(10);
    if (IN(11)) REPS(11) { phase_post<1>(p); } SEAM(11);
    if (IN(12)) REPS(12) { pg8::Gemm g{A, (const bf16_t*)(ws + WS_WGU2), NLAT, 2 * DFF, D, D, D}; pg8::StaticOrder S; S.init(NLAT, 2 * DFF, G, bx); pg8::EpiSiluMul E{H, DFF}; pg8::gemm_phase(lds, g, S, E); } SEAM(12);
    if (IN(13)) REPS(13) { pg8::Gemm g{H, (const bf16_t*)(ws + WS_WD2), NLAT, D, DFF, DFF, DFF}; pg8::StaticOrder S; S.init(NLAT, D, G, bx); pg8::EpiBf16 E{Y, D}; pg8::gemm_phase(lds, g, S, E); } SEAM(13);
    if (IN(14)) REPS(14) { phase_post<2>(p); }
#undef IN
#undef SEAM
}


#ifndef MK_RUN
#define MK_RUN N_PHASES
#endif
#ifndef MK_COOP
#define MK_COOP 1
#endif
extern "C" void kernel_launch(void* const* d_in, const int* in_sizes, int n_in, void* d_out, int out_size, void* d_ws, size_t ws_size, hipStream_t stream) {
    static int grid = 0;
    if (grid == 0) {
        if (n_in != 18 || ws_size < WS_END) { fprintf(stderr, "kernel_launch: need 18 inputs and %zu bytes of workspace (got %d, %zu)\n", (size_t)WS_END, n_in, ws_size); grid = -1; return; }
        int dev = 0, cus = 0, per_cu = 0;
        hipGetDevice(&dev); hipDeviceGetAttribute(&cus, hipDeviceAttributeMultiprocessorCount, dev);
        if (hipFuncSetAttribute((const void*)mk_fwd, hipFuncAttributeMaxDynamicSharedMemorySize, LDS_BYTES) != hipSuccess) { fprintf(stderr, "kernel_launch: hipFuncSetAttribute failed\n"); grid = -1; return; }
        if (hipOccupancyMaxActiveBlocksPerMultiprocessor(&per_cu, (const void*)mk_fwd, NTHR, LDS_BYTES) != hipSuccess || per_cu < 1) { fprintf(stderr, "kernel_launch: occupancy query gave %d\n", per_cu); per_cu = 1; }
        (void)hipGetLastError();
        grid = cus * 1;
    }
    if (grid < 0) return;
    if (hipMemsetAsync((char*)d_ws + WS_CTR, 0, 16384, stream) != hipSuccess) { fprintf(stderr, "kernel_launch: memset failed\n"); return; }
    Params p{};
    const float** f = (const float**)&p;
    for (int i = 0; i < 18; ++i) f[i] = (const float*)d_in[i];
    p.out = (float*)d_out; p.ws = (uchar*)d_ws;
#if MK_COOP
    p.ph_lo = 0; p.ph_hi = MK_RUN;
    void* args[] = {&p};
    hipError_t e = hipLaunchCooperativeKernel((const void*)mk_fwd, dim3(grid), dim3(NTHR), args, LDS_BYTES, stream);
    if (e != hipSuccess) fprintf(stderr, "cooperative launch failed: %s (grid %d)\n", hipGetErrorString(e), grid);
#else
    for (int ph = 0; ph < MK_RUN; ++ph) { p.ph_lo = ph; p.ph_hi = ph + 1; hipLaunchKernelGGL(mk_fwd, dim3(grid), dim3(NTHR), LDS_BYTES, stream, p); }
#endif
}
```
